# Optimizing an MI355X kernel written in HIP

```python
import jax, jax.numpy as jnp
from jax import lax
import numpy as np

D_MODEL = 2048
BATCH = 2
SEQ = 8192
DEPTH = 4

GRID_W = 64
CTX_LEN = 256
N_MIXERS = 2
N_POOL_LAYERS = (DEPTH + 1) // 2
N_MLA_LAYERS = DEPTH // 2
POOL_WINDOWS = (2, 4, 8, 16)
POOL_GROUPS = len(POOL_WINDOWS)
POOL_GW = D_MODEL // POOL_GROUPS
N_HEADS = 16
Q_LORA = 512
KV_LORA = 512
QK_NOPE = 128
ROPE_DIM = 64
AXIS_DIM = ROPE_DIM // 2
V_DIM = 128
QK_DIM = QK_NOPE + ROPE_DIM
ATTN_SCALE = QK_DIM ** -0.5
ROPE_BASE = 10000.0
Q_BLOCK = 128
D_FF = ((8 * D_MODEL // 3 + 255) // 256) * 256
RMS_EPS = 1e-6
N_MOD = 6

kernel_name = "interleaved_pool_mla_prefix_dit"


def rmsnorm(x, g):
    xf = x.astype(jnp.float32)
    xf = xf * lax.rsqrt(jnp.mean(xf * xf, axis=-1, keepdims=True) + RMS_EPS)
    return (xf * g.astype(jnp.float32)).astype(x.dtype)


def modulate(h, shift, scale):
    return h * (1.0 + scale) + shift


def swiglu(u, w1, w3, w2):
    return (jax.nn.silu(u @ w1) * (u @ w3)) @ w2


def axial_rope_tables(L):
    rows = L // GRID_W
    row = jnp.repeat(jnp.arange(rows, dtype=jnp.float32), GRID_W)
    col = jnp.tile(jnp.arange(GRID_W, dtype=jnp.float32), rows)
    inv = ROPE_BASE ** (-jnp.arange(0, AXIS_DIM, 2, dtype=jnp.float32) / AXIS_DIM)
    ang = jnp.stack([row[:, None] * inv, col[:, None] * inv], axis=1)
    return jnp.cos(ang), jnp.sin(ang)


def apply_axial_rope(x, cos, sin):
    extra = x.ndim - 3
    half = AXIS_DIM // 2
    xs = x.reshape(x.shape[:-1] + (2, 2, half))
    bshape = (cos.shape[0],) + (1,) * extra + (2, half)
    c = cos.reshape(bshape).astype(x.dtype)
    s = sin.reshape(bshape).astype(x.dtype)
    x1, x2 = xs[..., 0, :], xs[..., 1, :]
    out = jnp.stack([x1 * c - x2 * s, x2 * c + x1 * s], axis=-2)
    return out.reshape(x.shape)


def pool_mixer(u, w, scale):
    B, L, D = u.shape
    t = jnp.arange(L)
    uf = u.astype(jnp.float32)
    csum = jnp.concatenate([jnp.zeros((B, 1, D), jnp.float32), lax.cumsum(uf, axis=1)], axis=1)
    outs = []
    for g, win in enumerate(POOL_WINDOWS):
        lo = jnp.clip(t - win // 2, 0, L)
        hi = jnp.clip(t + win // 2, 0, L)
        cs_g = csum[..., g * POOL_GW:(g + 1) * POOL_GW]
        cnt = (hi - lo).astype(jnp.float32)[None, :, None]
        outs.append((cs_g[:, hi] - cs_g[:, lo]) / cnt - uf[..., g * POOL_GW:(g + 1) * POOL_GW])
    pooled = jnp.stack(outs, axis=2).astype(u.dtype)
    y = jnp.einsum('blgc,gcd->blgd', pooled, w).reshape(B, L, D)
    return y * scale


def mla_queries(u, w_dq, q_norm, w_uq):
    B, L, _ = u.shape
    q = (rmsnorm(u @ w_dq, q_norm) @ w_uq).reshape(B, L, N_HEADS, QK_DIM)
    return q[..., :QK_NOPE], q[..., QK_NOPE:]


def mla_keys_values(u, w_dkv, kv_norm, w_ukv):
    B, L, _ = u.shape
    ckv = u @ w_dkv
    c_kv, k_rope = ckv[..., :KV_LORA], ckv[..., KV_LORA:]
    kv = (rmsnorm(c_kv, kv_norm) @ w_ukv).reshape(B, L, N_HEADS, QK_NOPE + V_DIM)
    return kv[..., :QK_NOPE], k_rope, kv[..., QK_NOPE:]


def attend(q_nope, q_rope, k_nope, k_rope, v):
    s = jnp.einsum('bqhd,bkhd->bhqk', q_nope, k_nope) + jnp.einsum('bqhr,bkr->bhqk', q_rope, k_rope)
    p = jax.nn.softmax(s.astype(jnp.float32) * ATTN_SCALE, axis=-1).astype(v.dtype)
    return jnp.einsum('bhqk,bkhd->bqhd', p, v)


def blocked_attention(q_nope, q_rope, k_nope, k_rope, v):
    B, L = q_nope.shape[:2]
    nb = L // Q_BLOCK

    def blocks(a):
        return jnp.moveaxis(a.reshape((B, nb, Q_BLOCK) + a.shape[2:]), 1, 0)

    out = lax.map(lambda qs: attend(qs[0], qs[1], k_nope, k_rope, v), (blocks(q_nope), blocks(q_rope)))
    return jnp.moveaxis(out, 0, 1).reshape(B, L, N_HEADS * V_DIM)


def mla_mixer(u, uc, cos, sin, w_dqkv, q_norm, w_uq, kv_norm, w_ukv, w_o, ctx_out):
    w_dq, w_dkv = w_dqkv[:, :Q_LORA], w_dqkv[:, Q_LORA:]
    qn, qr = mla_queries(u, w_dq, q_norm, w_uq)
    kn, kr, v = mla_keys_values(u, w_dkv, kv_norm, w_ukv)
    qr = apply_axial_rope(qr, cos, sin)
    kr = apply_axial_rope(kr, cos, sin)
    kn_c, kr_c, v_c = mla_keys_values(uc, w_dkv, kv_norm, w_ukv)
    k_nope = jnp.concatenate([kn_c, kn], axis=1)
    k_rope = jnp.concatenate([kr_c, kr], axis=1)
    vv = jnp.concatenate([v_c, v], axis=1)
    y = blocked_attention(qn, qr, k_nope, k_rope, vv) @ w_o
    yc = None
    if ctx_out:
        B, C = uc.shape[:2]
        qn_c, qr_c = mla_queries(uc, w_dq, q_norm, w_uq)
        yc = attend(qn_c, qr_c, kn_c, kr_c, v_c).reshape(B, C, N_HEADS * V_DIM) @ w_o
    return y, yc


def setup_inputs(seed: int = 0) -> dict:
    key = jax.random.key(seed)
    ks = jax.random.split(key, 18)
    D = D_MODEL

    def nrm(k, shape, scale):
        return jax.random.normal(k, shape, jnp.float32) * scale

    return {
        "x": nrm(ks[0], (BATCH, SEQ, D), 1.0),
        "c": nrm(ks[1], (BATCH, D), 1.0),
        "ctx": nrm(ks[2], (BATCH, CTX_LEN, D), 1.0),
        "c_ctx": nrm(ks[3], (D,), 1.0),
        "ada_w": nrm(ks[4], (DEPTH, D, N_MOD * D), 0.5 * D ** -0.5),
        "ada_b": nrm(ks[5], (DEPTH, N_MOD * D), 0.01),
        "norm_g": 1.0 + nrm(ks[6], (DEPTH, 4, D), 0.05),
        "pool_w": nrm(ks[7], (N_POOL_LAYERS, POOL_GROUPS, POOL_GW, POOL_GW), POOL_GW ** -0.5),
        "pool_scale": 1.0 + nrm(ks[8], (N_POOL_LAYERS, D), 0.1),
        "mla_w_dqkv": nrm(ks[9], (N_MLA_LAYERS, D, Q_LORA + KV_LORA + ROPE_DIM), D ** -0.5),
        "mla_q_norm": 1.0 + nrm(ks[10], (N_MLA_LAYERS, Q_LORA), 0.05),
        "mla_w_uq": nrm(ks[11], (N_MLA_LAYERS, Q_LORA, N_HEADS * QK_DIM), Q_LORA ** -0.5),
        "mla_kv_norm": 1.0 + nrm(ks[12], (N_MLA_LAYERS, KV_LORA), 0.05),
        "mla_w_ukv": nrm(ks[13], (N_MLA_LAYERS, KV_LORA, N_HEADS * (QK_NOPE + V_DIM)), KV_LORA ** -0.5),
        "mla_w_o": nrm(ks[14], (N_MLA_LAYERS, N_HEADS * V_DIM, D), (N_HEADS * V_DIM) ** -0.5),
        "ffn_w1": nrm(ks[15], (DEPTH, D, D_FF), D ** -0.5),
        "ffn_w3": nrm(ks[16], (DEPTH, D, D_FF), D ** -0.5),
        "ffn_w2": nrm(ks[17], (DEPTH, D_FF, D), D_FF ** -0.5),
    }


def reference(x, c, ctx, c_ctx, ada_w, ada_b, norm_g, pool_w, pool_scale, mla_w_dqkv, mla_q_norm,
              mla_w_uq, mla_kv_norm, mla_w_ukv, mla_w_o, ffn_w1, ffn_w3, ffn_w2):
    L = x.shape[1]
    cos, sin = axial_rope_tables(L)
    s_lat = jax.nn.silu(c)[:, None, :]
    s_ctx = jax.nn.silu(c_ctx)[None, None, :]
    h, hc = x, ctx
    for i in range(DEPTH):
        ctx_out = i < DEPTH - 1
        use_pool = i % N_MIXERS == 0
        j = i // N_MIXERS
        mod = jnp.split(s_lat @ ada_w[i] + ada_b[i], N_MOD, axis=-1)
        mod_c = jnp.split(s_ctx @ ada_w[i] + ada_b[i], N_MOD, axis=-1)
        u = modulate(rmsnorm(h, norm_g[i, 0]), mod[0], mod[1])
        if use_pool:
            y = pool_mixer(u, pool_w[j], pool_scale[j])
            if ctx_out:
                uc = modulate(rmsnorm(hc, norm_g[i, 0]), mod_c[0], mod_c[1])
                yc = pool_mixer(uc, pool_w[j], pool_scale[j])
        else:
            uc = modulate(rmsnorm(hc, norm_g[i, 0]), mod_c[0], mod_c[1])
            y, yc = mla_mixer(u, uc, cos, sin, mla_w_dqkv[j], mla_q_norm[j], mla_w_uq[j],
                              mla_kv_norm[j], mla_w_ukv[j], mla_w_o[j], ctx_out)
        h = h + mod[2] * rmsnorm(y, norm_g[i, 1])
        u = modulate(rmsnorm(h, norm_g[i, 2]), mod[3], mod[4])
        h = h + mod[5] * rmsnorm(swiglu(u, ffn_w1[i], ffn_w3[i], ffn_w2[i]), norm_g[i, 3])
        if ctx_out:
            hc = hc + mod_c[2] * rmsnorm(yc, norm_g[i, 1])
            uc = modulate(rmsnorm(hc, norm_g[i, 2]), mod_c[3], mod_c[4])
            hc = hc + mod_c[5] * rmsnorm(swiglu(uc, ffn_w1[i], ffn_w3[i], ffn_w2[i]), norm_g[i, 3])
    return h
```

```cpp
#include <hip/hip_runtime.h>
#include <cstdio>
#include <cstdint>

#ifndef MK_PER_PHASE
#define MK_PER_PHASE 0
#endif

#ifndef PROBE_DBL
#define PROBE_DBL 0
#endif
#define LAS __attribute__((address_space(3)))
#define GAS __attribute__((address_space(1)))
typedef unsigned short bf16_t;
typedef short bf16x8 __attribute__((ext_vector_type(8)));
typedef short s16x4 __attribute__((ext_vector_type(4)));
typedef float f32x4 __attribute__((ext_vector_type(4)));
typedef float f32x2 __attribute__((ext_vector_type(2)));
typedef float f32x16 __attribute__((ext_vector_type(16)));
typedef unsigned u32x4 __attribute__((ext_vector_type(4)));
typedef unsigned u32x2 __attribute__((ext_vector_type(2)));

constexpr int D = 2048, SEQ = 8192, NB = 2, CTXL = 256, TL = NB * SEQ, TC = NB * CTXL, T = TL + TC;
constexpr int DFF = 5632, NH = 16, QKD = 192, NOPE = 128, ROPED = 64, VD = 128, QL = 512, KVL = 512;
constexpr int NDQKV = 1280;
constexpr int NQ = NH * QKD, NKV = NH * (NOPE + VD), NUP = NQ + NKV;
constexpr int NMOD = 6 * D;
constexpr float RMS_EPS = 1e-6f;
constexpr int NWAVES = 8, NTHREADS = 512;

__device__ __forceinline__ unsigned cvt_pk_bf16(float lo, float hi) { unsigned r; asm volatile("v_cvt_pk_bf16_f32 %0, %1, %2" : "=v"(r) : "v"(lo), "v"(hi)); return r; }
__device__ __forceinline__ float bf_lo(unsigned w) { return __uint_as_float(w << 16); }
__device__ __forceinline__ float bf_hi(unsigned w) { return __uint_as_float(w & 0xffff0000u); }
__device__ __forceinline__ float wave_sum(float v) {
#pragma unroll
    for (int o = 1; o < 64; o <<= 1) v += __shfl_xor(v, o);
    return v;
}

namespace pg8 {
constexpr int BM = 256, BK = 64, HALF = 128, HTB = HALF * BK * 2, STAGE_BYTES = 8 * HTB, NXCD = 8, WGM = 8;
__host__ __device__ __forceinline__ int lds_byte(int r, int c) { const int st = (r >> 4) * 2 + (c >> 5), rr = r & 15, cc = c & 31, ob = rr * 64 + cc * 2; return st * 1024 + (ob ^ (((ob >> 9) & 1) << 5)); }
__host__ __device__ __forceinline__ void stage_rc(int b, int& R, int& C) { const int st = b / 1024, sb = b % 1024, swz = sb ^ (((sb >> 9) & 1) << 5); R = (st >> 1) * 16 + swz / 64; C = (st & 1) * 32 + (swz % 64) / 2; }
__host__ __device__ __forceinline__ int perm32(int rho) { const int n = rho >> 4, i = rho & 15; return 8 * (i >> 2) + 4 * n + (i & 3); }

struct Unit { int pm, pn, kt0, nkt, part; };
struct Gemm { const bf16_t* A; const bf16_t* Bt; int M, N, K, lda, ldb; };

struct StaticOrder {
    int nM, nN, nwg, G, c, nkt;
    __host__ __device__ void init(int M, int N, int K, int G_, int c_) { nM = M / BM; nN = N / BM; nwg = nM * nN; G = G_; c = c_; nkt = K / BK; }
    __host__ __device__ bool next(int i, Unit& u) const {
        const long L = (long)i * G + c; if (L >= nwg) return false;
        int wgid = (int)L; { const int q = nwg / NXCD, r = nwg % NXCD, xcd = wgid % NXCD, off = wgid / NXCD; wgid = (xcd < r ? xcd * (q + 1) : r * (q + 1) + (xcd - r) * q) + off; }
        const int nig = WGM * nN, gid = wgid / nig, fm = gid * WGM, gsz = (nM - fm) < WGM ? (nM - fm) : WGM;
        u.pm = fm + ((wgid % nig) % gsz); u.pn = (wgid % nig) / gsz; u.kt0 = 0; u.nkt = nkt; u.part = -1; return true;
    }
};
struct HybridOrder {
    StaticOrder full; int nfull, nsplit, S, nktp, nN, pm0, G, c;
    __host__ __device__ void init(int Mfull, int Mtot, int N, int K, int G_, int c_, int S_) { full.init(Mfull, N, K, G_, c_); nfull = full.nwg; nN = N / BM; pm0 = Mfull / BM; S = S_; nktp = (K / BK) / S_;
        nsplit = ((Mtot - Mfull) / BM) * nN * S_; G = G_; c = c_; }
    __host__ __device__ bool next(int i, Unit& u) const {
        const long L = (long)i * G + c; if (L < nfull) return full.next(i, u);
        const int e = (int)(L - nfull); if (e >= nsplit) return false;
        const int part = e % S, tile = e / S; u.pm = pm0 + tile / nN; u.pn = tile % nN; u.kt0 = part * nktp; u.nkt = nktp; u.part = part; return true;
    }
};

template <class Epi, class Sched, bool ALIGN_EPI = true>
__device__ __forceinline__ void gemm_phase(LAS unsigned char* lds, const Gemm g, const Sched& S, const Epi& E) {
    int tid = threadIdx.x; asm volatile("" : "+v"(tid));
    const int wid = __builtin_amdgcn_readfirstlane(tid >> 6), lane = tid & 63, wr = wid >> 2, wc = wid & 3, fr = lane & 15, fq = lane >> 4;
    unsigned voffA[2], voffB[2];
#pragma unroll
    for (int i = 0; i < 2; ++i) { int R, C; stage_rc(tid * 16 + i * 8192, R, C); const int Rb = (R & ~31) + perm32(R & 31);
        voffA[i] = (unsigned)(R * g.lda + C) * 2u; voffB[i] = (unsigned)(Rb * g.ldb + C) * 2u; }
    const size_t kstep = (size_t)(BK * 2);
    const size_t hstepA = (size_t)HALF * g.lda * 2, hstepB = (size_t)HALF * g.ldb * 2;
    const size_t tstepA = 2 * hstepA, tstepB = 2 * hstepB;
    const unsigned ldsw = (unsigned)wid * 1024u;
    const int aoff = lds_byte(wr * 64 + fr, fq * 8), boff = lds_byte(wc * 32 + fr, fq * 8);
#define PG8_SA(b, h) (((b) * 2 + (h)) * HTB)
#define PG8_SB(b, h) ((4 + (b) * 2 + (h)) * HTB)
#define PG8_STAGE(bufoff, gbase, voff) do { _Pragma("unroll") for (int _i = 0; _i < 2; ++_i) \
        __builtin_amdgcn_global_load_lds((const unsigned*)((const char*)(gbase) + (voff)[_i]), (LAS unsigned*)(lds + (bufoff) + ldsw + _i * 8192), 16, 0, 0); } while (0)
#define PG8_LDA(dst, b, h) do { _Pragma("unroll") for (int m = 0; m < 4; ++m) _Pragma("unroll") for (int k = 0; k < 2; ++k) dst[m][k] = *(const LAS bf16x8*)(lds + PG8_SA(b, h) + aoff + m * 2048 + k * 1024); } while (0)
#define PG8_LDB(dst, b, h) do { _Pragma("unroll") for (int n = 0; n < 2; ++n) _Pragma("unroll") for (int k = 0; k < 2; ++k) dst[n][k] = *(const LAS bf16x8*)(lds + PG8_SB(b, h) + boff + n * 2048 + k * 1024); } while (0)
#define PG8_MMA(ai, bj, At, Bt) do { __builtin_amdgcn_s_setprio(1); _Pragma("unroll") for (int m = 0; m < 4; ++m) _Pragma("unroll") for (int n = 0; n < 2; ++n) _Pragma("unroll") for (int k = 0; k < 2; ++k) \
        acc[ai][bj][m][n] = __builtin_amdgcn_mfma_f32_16x16x32_bf16(Bt[n][k], At[m][k], acc[ai][bj][m][n], 0, 0, 0); __builtin_amdgcn_s_setprio(0); } while (0)
#define PG8_WAIT_V(n) asm volatile("s_waitcnt vmcnt(" #n ")" ::: "memory")
#define PG8_WAIT_L(n) asm volatile("s_waitcnt lgkmcnt(" #n ")" ::: "memory")
#define PG8_BAR __builtin_amdgcn_s_barrier()
#define PG8_SCHED __builtin_amdgcn_sched_barrier(0)
    Unit cur, nxt; int ui = 0;
    if (!S.next(0, cur)) return;
    f32x4 acc[2][2][4][2];
#pragma unroll
    for (int a = 0; a < 2; ++a)
#pragma unroll
        for (int b = 0; b < 2; ++b)
#pragma unroll
            for (int m = 0; m < 4; ++m)
#pragma unroll
                for (int n = 0; n < 2; ++n) acc[a][b][m][n] = (f32x4){0.f, 0.f, 0.f, 0.f};
    bf16x8 At[4][2], B0[2][2], B1[2][2];
    const char* cA = (const char*)g.A + (size_t)cur.pm * tstepA + (size_t)E.a_off(cur.pn) * 2 + (size_t)cur.kt0 * kstep; const char* cB = (const char*)g.Bt + (size_t)cur.pn * tstepB + (size_t)cur.kt0 * kstep;
    PG8_STAGE(PG8_SB(0, 0), cB, voffB); PG8_STAGE(PG8_SB(0, 1), cB + hstepB, voffB); PG8_STAGE(PG8_SA(0, 0), cA, voffA); PG8_STAGE(PG8_SA(0, 1), cA + hstepA, voffA);
    if (wr == 1) PG8_BAR;
    PG8_WAIT_V(2); PG8_BAR;
    PG8_STAGE(PG8_SB(1, 0), cB + kstep, voffB); PG8_STAGE(PG8_SA(1, 0), cA + kstep, voffA); PG8_STAGE(PG8_SB(1, 1), cB + hstepB + kstep, voffB);
    PG8_WAIT_V(6); PG8_BAR;
    for (;;) {
        const bool has_next = S.next(ui + 1, nxt);
        const char* nA = has_next ? (const char*)g.A + (size_t)nxt.pm * tstepA + (size_t)E.a_off(nxt.pn) * 2 + (size_t)nxt.kt0 * kstep : cA; const char* nB = has_next ? (const char*)g.Bt + (size_t)nxt.pn * tstepB + (size_t)nxt.kt0 * kstep : cB;
        const int nt = cur.nkt;
        for (int t = 0; t < nt; t += 2) {
            const bool last = (t == nt - 2);
            const char* a1 = cA + (size_t)(t + 1) * kstep;
            const char* a2 = last ? nA : cA + (size_t)(t + 2) * kstep; const char* b2 = last ? nB : cB + (size_t)(t + 2) * kstep;
            const char* a3 = a2 + kstep; const char* b3 = b2 + kstep;
            PG8_LDB(B0, 0, 0); PG8_LDB(B1, 0, 1); PG8_SCHED; PG8_LDA(At, 0, 0); PG8_STAGE(PG8_SA(1, 1), a1 + hstepA, voffA);
            PG8_WAIT_V(8); PG8_WAIT_L(0); PG8_BAR; PG8_MMA(0, 0, At, B0); PG8_MMA(0, 1, At, B1); PG8_BAR; PG8_SCHED;
            PG8_LDA(At, 0, 1); PG8_STAGE(PG8_SB(0, 0), b2, voffB); PG8_STAGE(PG8_SB(0, 1), b2 + hstepB, voffB); PG8_STAGE(PG8_SA(0, 0), a2, voffA);
            PG8_WAIT_V(8); PG8_WAIT_L(0); PG8_BAR; PG8_MMA(1, 0, At, B0); PG8_MMA(1, 1, At, B1); PG8_BAR; PG8_SCHED;
            PG8_LDB(B0, 1, 0); PG8_LDB(B1, 1, 1); PG8_SCHED; PG8_LDA(At, 1, 0); PG8_STAGE(PG8_SA(0, 1), a2 + hstepA, voffA);
            PG8_WAIT_V(8); PG8_WAIT_L(0); PG8_BAR; PG8_MMA(0, 0, At, B0); PG8_MMA(0, 1, At, B1); PG8_BAR; PG8_SCHED;
            PG8_LDA(At, 1, 1); PG8_STAGE(PG8_SB(1, 0), b3, voffB); PG8_STAGE(PG8_SB(1, 1), b3 + hstepB, voffB); PG8_STAGE(PG8_SA(1, 0), a3, voffA);
            PG8_WAIT_V(8); PG8_WAIT_L(0); PG8_BAR; PG8_MMA(1, 0, At, B0); PG8_MMA(1, 1, At, B1); PG8_BAR; PG8_SCHED;
        }
        if constexpr (ALIGN_EPI) { if (wr == 0) PG8_BAR; }
        E(acc, cur, wr, wc, fr, fq);
        if (!has_next) break;
#pragma unroll
        for (int a = 0; a < 2; ++a)
#pragma unroll
            for (int b = 0; b < 2; ++b)
#pragma unroll
                for (int m = 0; m < 4; ++m)
#pragma unroll
                    for (int n = 0; n < 2; ++n) acc[a][b][m][n] = (f32x4){0.f, 0.f, 0.f, 0.f};
        cur = nxt; cA = nA; cB = nB; ++ui;
        if constexpr (ALIGN_EPI) { if (wr == 1) PG8_BAR; }
    }
    PG8_WAIT_V(0);
    if constexpr (!ALIGN_EPI) { if (wr == 0) PG8_BAR; }
    PG8_BAR;
#undef PG8_SA
#undef PG8_SB
#undef PG8_STAGE
#undef PG8_LDA
#undef PG8_LDB
#undef PG8_MMA
#undef PG8_WAIT_V
#undef PG8_WAIT_L
#undef PG8_BAR
#undef PG8_SCHED
}

#ifndef EPI_SC1
#define EPI_SC1 0
#endif
__device__ __forceinline__ void st16(void* p, u32x4 w) {
#if EPI_SC1
    asm volatile("global_store_dwordx4 %0, %1, off sc1\n\ts_nop 1" :: "v"(p), "v"(w) : "memory");
#else
    *(u32x4*)p = w;
#endif
}
struct EpiStore {
    bf16_t* O; int ldc; float* ssq0; float* ssq1; int split0, split1; int a_grp_tiles, a_grp_off;
    __device__ __forceinline__ int a_off(int pn) const { return a_grp_tiles ? (pn / a_grp_tiles) * a_grp_off : 0; }
    __device__ __forceinline__ void operator()(const f32x4 (&acc)[2][2][4][2], const Unit& u, int wr, int wc, int fr, int fq) const {
        const int row0 = u.pm * BM + wr * 64 + fr, col0 = u.pn * BM + wc * 32 + 8 * fq;
        float* ssq = u.pn < split0 ? ssq0 : (u.pn < split1 ? ssq1 : nullptr);
#pragma unroll
        for (int ai = 0; ai < 2; ++ai)
#pragma unroll
            for (int m = 0; m < 4; ++m) { const int row = row0 + ai * HALF + m * 16; bf16_t* rowp = O + (size_t)row * ldc + col0; float s = 0.f;
#pragma unroll
                for (int bj = 0; bj < 2; ++bj) { const f32x4 v0 = acc[ai][bj][m][0], v1 = acc[ai][bj][m][1];
                    s += (v0[0] * v0[0] + v0[1] * v0[1]) + (v0[2] * v0[2] + v0[3] * v0[3]) + (v1[0] * v1[0] + v1[1] * v1[1]) + (v1[2] * v1[2] + v1[3] * v1[3]);
                    u32x4 w; w.x = cvt_pk_bf16(v0[0], v0[1]); w.y = cvt_pk_bf16(v0[2], v0[3]); w.z = cvt_pk_bf16(v1[0], v1[1]); w.w = cvt_pk_bf16(v1[2], v1[3]);
                    st16(rowp + bj * HALF, w); }
                if (ssq) { s += __shfl_xor(s, 16); s += __shfl_xor(s, 32); if (fq == 0) ssq[(size_t)row * 8 + (u.pn & 1) * 4 + wc] = s; } }
    }
};
struct EpiY {
    bf16_t* O; float* Yp; int ldc, row_split, nsplit_rows; int a_grp_tiles, a_grp_off;
    __device__ __forceinline__ int a_off(int pn) const { return a_grp_tiles ? (pn / a_grp_tiles) * a_grp_off : 0; }
    __device__ __forceinline__ void operator()(const f32x4 (&acc)[2][2][4][2], const Unit& u, int wr, int wc, int fr, int fq) const {
        const int row0 = u.pm * BM + wr * 64 + fr, col0 = u.pn * BM + wc * 32 + 8 * fq;
        if (u.part < 0) {
#pragma unroll
            for (int ai = 0; ai < 2; ++ai)
#pragma unroll
                for (int m = 0; m < 4; ++m) { bf16_t* rowp = O + (size_t)(row0 + ai * HALF + m * 16) * ldc + col0;
#pragma unroll
                    for (int bj = 0; bj < 2; ++bj) { const f32x4 v0 = acc[ai][bj][m][0], v1 = acc[ai][bj][m][1];
                        u32x4 w; w.x = cvt_pk_bf16(v0[0], v0[1]); w.y = cvt_pk_bf16(v0[2], v0[3]); w.z = cvt_pk_bf16(v1[0], v1[1]); w.w = cvt_pk_bf16(v1[2], v1[3]);
                        st16(rowp + bj * HALF, w); } }
        } else { float* slab = Yp + (size_t)u.part * nsplit_rows * ldc;
#pragma unroll
            for (int ai = 0; ai < 2; ++ai)
#pragma unroll
                for (int m = 0; m < 4; ++m) { float* rowp = slab + (size_t)(row0 + ai * HALF + m * 16 - row_split) * ldc + col0;
#pragma unroll
                    for (int bj = 0; bj < 2; ++bj) { *(f32x4*)(rowp + bj * HALF) = acc[ai][bj][m][0]; *(f32x4*)(rowp + bj * HALF + 4) = acc[ai][bj][m][1]; } }
        }
    }
};
struct EpiSwiGLU {
    bf16_t* O; int ldc;
    __device__ __forceinline__ int a_off(int) const { return 0; }
    __device__ __forceinline__ void operator()(const f32x4 (&acc)[2][2][4][2], const Unit& u, int wr, int wc, int fr, int fq) const {
        const int row0 = u.pm * BM + wr * 64 + fr, col0 = u.pn * HALF + wc * 32 + 8 * fq;
#pragma unroll
        for (int ai = 0; ai < 2; ++ai)
#pragma unroll
            for (int m = 0; m < 4; ++m) { const int row = row0 + ai * HALF + m * 16; float gv[8];
#pragma unroll
                for (int n = 0; n < 2; ++n)
#pragma unroll
                    for (int j = 0; j < 4; ++j) { const float a = acc[ai][0][m][n][j], b = acc[ai][1][m][n][j]; gv[n * 4 + j] = a * __builtin_amdgcn_rcpf(1.f + __expf(-a)) * b; }
                u32x4 w; w.x = cvt_pk_bf16(gv[0], gv[1]); w.y = cvt_pk_bf16(gv[2], gv[3]); w.z = cvt_pk_bf16(gv[4], gv[5]); w.w = cvt_pk_bf16(gv[6], gv[7]);
                st16(O + (size_t)row * ldc + col0, w); }
    }
};
struct EpiUp {
    bf16_t* Q; bf16_t* KV; const float* ssq_q; const float* ssq_kv;
    __device__ __forceinline__ int a_off(int pn) const { return pn < NQ / BM ? 0 : QL; }
    __device__ __forceinline__ void operator()(const f32x4 (&acc)[2][2][4][2], const Unit& u, int wr, int wc, int fr, int fq) const {
        const bool isq = u.pn < NQ / BM; const int ldc = isq ? NQ : NKV; bf16_t* O = isq ? Q : KV; const float* ssq = isq ? ssq_q : ssq_kv;
        const int row0 = u.pm * BM + wr * 64 + fr, col0 = (isq ? u.pn : u.pn - NQ / BM) * BM + wc * 32 + 8 * fq;
        float rs[2][4];
#pragma unroll
        for (int ai = 0; ai < 2; ++ai)
#pragma unroll
            for (int m = 0; m < 4; ++m) { const int row = row0 + ai * HALF + m * 16;
                const f32x4 sa = *(const f32x4*)(ssq + (size_t)row * 8), sb = *(const f32x4*)(ssq + (size_t)row * 8 + 4);
                rs[ai][m] = __builtin_amdgcn_rsqf((((sa[0] + sa[1]) + (sa[2] + sa[3])) + ((sb[0] + sb[1]) + (sb[2] + sb[3]))) * (1.f / 512.f) + RMS_EPS); }
#pragma unroll
        for (int ai = 0; ai < 2; ++ai)
#pragma unroll
            for (int m = 0; m < 4; ++m) { const int row = row0 + ai * HALF + m * 16; bf16_t* rowp = O + (size_t)row * ldc + col0;
#pragma unroll
                for (int bj = 0; bj < 2; ++bj) { const f32x4 v0 = acc[ai][bj][m][0] * rs[ai][m], v1 = acc[ai][bj][m][1] * rs[ai][m];
                    u32x4 w; w.x = cvt_pk_bf16(v0[0], v0[1]); w.y = cvt_pk_bf16(v0[2], v0[3]); w.z = cvt_pk_bf16(v1[0], v1[1]); w.w = cvt_pk_bf16(v1[2], v1[3]);
                    st16(rowp + bj * HALF, w); } }
    }
};
}
namespace att {
constexpr int QBLK = 32, KVBLK = 64;
constexpr float SCALE = 0.07216878364870322f;
constexpr float THR = 8.f;
#ifndef ATT_SDEPTH
#define ATT_SDEPTH 1
#endif
constexpr int SDEPTH = ATT_SDEPTH;
constexpr int SHM_V = KVBLK * VD * 2, SHM_K = KVBLK * QKD * 2;
constexpr int LDS_BYTES = 2 * SHM_V + 2 * SHM_K + NWAVES * 64 * 4;
#define KOFF(row, ch) ((row) * 384 + ((((ch) ^ (((row) >> 1) & 7))) << 4))
#define SBAR() __builtin_amdgcn_sched_barrier(0)
__device__ __forceinline__ int crow(int r, int hi) { return (r & 3) + 8 * (r >> 2) + 4 * hi; }

__device__ __forceinline__ void finishSM(f32x16& p0, f32x16& p1, float alpha, float& l_reg, bf16x8& pa0, bf16x8& pa1, bf16x8& pa2, bf16x8& pa3) {
#pragma unroll
    for (int r = 0; r < 16; ++r) p1[r] = __builtin_amdgcn_exp2f(p1[r]);
    float ps = 0;
#pragma unroll
    for (int r = 0; r < 16; ++r) ps += p0[r];
#pragma unroll
    for (int r = 0; r < 16; ++r) ps += p1[r];
    { auto rr = __builtin_amdgcn_permlane32_swap(__float_as_uint(ps), __float_as_uint(ps), false, false);
      ps = __uint_as_float(rr[0]) + __uint_as_float(rr[1]); }
    l_reg = l_reg * alpha + ps;
#define PK4(P, BASE, OUT) do { unsigned a0 = cvt_pk_bf16(P[BASE + 0], P[BASE + 1]), a1 = cvt_pk_bf16(P[BASE + 2], P[BASE + 3]);   \
    unsigned b0 = cvt_pk_bf16(P[BASE + 4], P[BASE + 5]), b1 = cvt_pk_bf16(P[BASE + 6], P[BASE + 7]);                              \
    auto r0 = __builtin_amdgcn_permlane32_swap(a0, b0, false, false); auto r1 = __builtin_amdgcn_permlane32_swap(a1, b1, false, false); \
    u32x4 w = {r0[0], r1[0], r0[1], r1[1]}; OUT = *reinterpret_cast<bf16x8*>(&w); } while (0)
    PK4(p0, 0, pa0); PK4(p0, 8, pa1); PK4(p1, 0, pa2); PK4(p1, 8, pa3);
#undef PK4
}
__device__ __forceinline__ int v_st(int k, int c) { const int kk = (k & ~0xC) | ((k & 4) << 1) | ((k & 8) >> 1); return ((kk >> 3) * 4 + (c >> 5)) * 512 + ((kk & 7) * 32 + (c & 31)) * 2; }
__device__ __forceinline__ int v_rd_base(int lane) { return ((lane & 3) << 3) | (((lane >> 2) & 3) << 6) | (((lane >> 4) & 1) << 5) | (((lane >> 5) & 1) << 8); }
constexpr int v_rd_off(int d0, int ks, int half) { return d0 * 512 + ks * 4096 + half * 2048; }
template <int OFF> __device__ __forceinline__ s16x4 tr_read(int vb) {
    s16x4 r; asm volatile("ds_read_b64_tr_b16 %0, %1 offset:%2" : "=&v"(r) : "v"(vb), "i"(OFF) : "memory"); return r;
}
template <int D0> __device__ __forceinline__ void pv_one(f32x16& od, int vb, bf16x8 pa0, bf16x8 pa1, bf16x8 pa2, bf16x8 pa3) {
    const s16x4 l0 = tr_read<v_rd_off(D0, 0, 0)>(vb), h0 = tr_read<v_rd_off(D0, 0, 1)>(vb), l1 = tr_read<v_rd_off(D0, 1, 0)>(vb), h1 = tr_read<v_rd_off(D0, 1, 1)>(vb);
    const s16x4 l2 = tr_read<v_rd_off(D0, 2, 0)>(vb), h2 = tr_read<v_rd_off(D0, 2, 1)>(vb), l3 = tr_read<v_rd_off(D0, 3, 0)>(vb), h3 = tr_read<v_rd_off(D0, 3, 1)>(vb);
    asm volatile("s_waitcnt lgkmcnt(0)" ::: "memory"); SBAR();
#define PK(L, H) (bf16x8){L[0], L[1], L[2], L[3], H[0], H[1], H[2], H[3]}
    od = __builtin_amdgcn_mfma_f32_32x32x16_bf16(pa0, PK(l0, h0), od, 0, 0, 0);
    od = __builtin_amdgcn_mfma_f32_32x32x16_bf16(pa1, PK(l1, h1), od, 0, 0, 0);
    od = __builtin_amdgcn_mfma_f32_32x32x16_bf16(pa2, PK(l2, h2), od, 0, 0, 0);
    od = __builtin_amdgcn_mfma_f32_32x32x16_bf16(pa3, PK(l3, h3), od, 0, 0, 0);
#undef PK
}
__device__ __forceinline__ void pv_d0(f32x16* o, int vb, bf16x8 pa0, bf16x8 pa1, bf16x8 pa2, bf16x8 pa3) {
    pv_one<0>(o[0], vb, pa0, pa1, pa2, pa3); pv_one<1>(o[1], vb, pa0, pa1, pa2, pa3); pv_one<2>(o[2], vb, pa0, pa1, pa2, pa3); pv_one<3>(o[3], vb, pa0, pa1, pa2, pa3);
}
__device__ __forceinline__ void rope8(bf16x8& x1, bf16x8& x2, const float* tab) {
    u32x4 a = *reinterpret_cast<u32x4*>(&x1), b = *reinterpret_cast<u32x4*>(&x2), oa, ob;
#pragma unroll
    for (int w = 0; w < 4; ++w) {
        const f32x4 cs = *reinterpret_cast<const f32x4*>(tab + 4 * w);
        const float a0 = bf_lo(a[w]), a1 = bf_hi(a[w]), b0 = bf_lo(b[w]), b1 = bf_hi(b[w]);
        oa[w] = cvt_pk_bf16(a0 * cs[0] - b0 * cs[1], a1 * cs[2] - b1 * cs[3]);
        ob[w] = cvt_pk_bf16(b0 * cs[0] + a0 * cs[1], b1 * cs[2] + a1 * cs[3]);
    }
    x1 = *reinterpret_cast<bf16x8*>(&oa); x2 = *reinterpret_cast<bf16x8*>(&ob);
}

struct Unit { const bf16_t* Qb; const bf16_t* KVh; bf16_t* Ob; int kb_lat, nt_lat, kb_ctx, NT, qpos0; };

constexpr int SLOT = 40960, KR_OFF = 16384, V_OFF = 24576, LDS2_BYTES = 3 * SLOT + NWAVES * 64 * 4;
constexpr float THRL = THR * 1.4426950408889634f;
__device__ __forceinline__ void qkt2n(f32x16& p0, f32x16& p1, LAS const char* lds, int kn, int kr, const bf16x8* qr, const f32x16& negm) {
#pragma unroll
    for (int d0 = 0; d0 < 8; ++d0) { const int a = kn ^ (d0 << 5);
        const bf16x8 b0 = *reinterpret_cast<LAS const bf16x8*>(lds + a), b1 = *reinterpret_cast<LAS const bf16x8*>(lds + a + 32 * 256);
        if (d0 == 0) { p0 = __builtin_amdgcn_mfma_f32_32x32x16_bf16(b0, qr[0], negm, 0, 0, 0); p1 = __builtin_amdgcn_mfma_f32_32x32x16_bf16(b1, qr[0], negm, 0, 0, 0); }
        else { p0 = __builtin_amdgcn_mfma_f32_32x32x16_bf16(b0, qr[d0], p0, 0, 0, 0); p1 = __builtin_amdgcn_mfma_f32_32x32x16_bf16(b1, qr[d0], p1, 0, 0, 0); } }
#pragma unroll
    for (int d0 = 0; d0 < 4; ++d0) { const int a = kr ^ (d0 << 5);
        const bf16x8 b0 = *reinterpret_cast<LAS const bf16x8*>(lds + a), b1 = *reinterpret_cast<LAS const bf16x8*>(lds + a + 32 * 128);
        p0 = __builtin_amdgcn_mfma_f32_32x32x16_bf16(b0, qr[8 + d0], p0, 0, 0, 0); p1 = __builtin_amdgcn_mfma_f32_32x32x16_bf16(b1, qr[8 + d0], p1, 0, 0, 0); }
}
template <bool FIRST>
__device__ __forceinline__ void partialSM2(f32x16& p0, f32x16& p1, float& m_reg, f32x16& negm, float& alpha) {
    float pmax = p0[0];
#pragma unroll
    for (int r = 1; r < 16; ++r) pmax = fmaxf(pmax, p0[r]);
#pragma unroll
    for (int r = 0; r < 16; ++r) pmax = fmaxf(pmax, p1[r]);
    { auto rr = __builtin_amdgcn_permlane32_swap(__float_as_uint(pmax), __float_as_uint(pmax), false, false);
      pmax = fmaxf(__uint_as_float(rr[0]), __uint_as_float(rr[1])); }
    alpha = 1.f;
    if (FIRST || !__builtin_expect(__all(pmax <= THRL), 1)) {
        const float delta = FIRST ? pmax : fmaxf(pmax, 0.f);
        if (!FIRST) alpha = __builtin_amdgcn_exp2f(-delta);
        m_reg += delta;
#pragma unroll
        for (int r = 0; r < 16; ++r) { p0[r] -= delta; p1[r] -= delta; negm[r] = -m_reg; }
    }
#pragma unroll
    for (int r = 0; r < 16; ++r) p0[r] = __builtin_amdgcn_exp2f(p0[r]);
}
__device__ __forceinline__ void exp_half(f32x16& p0) {
#pragma unroll
    for (int r = 0; r < 16; ++r) p0[r] = __builtin_amdgcn_exp2f(p0[r]);
}
template <bool FIXM>
__device__ __forceinline__ void attn_unit6(const Unit& U, const bf16_t* __restrict__ KR, const float* __restrict__ ropetab, LAS unsigned char* lds) {
    int tid = threadIdx.x; asm volatile("" : "+v"(tid));
    const int wid = __builtin_amdgcn_readfirstlane(tid >> 6), lane = tid & 63, r32 = lane & 31, hi = lane >> 5;
    LAS float* wsf = (LAS float*)(lds + 3 * SLOT) + wid * 64; LAS float* li_l = wsf; LAS float* al_l = wsf + 32;
    float m_reg = 0.f, l_reg = 0; f32x16 o[4] = {}; bf16x8 qr[12]; f32x16 negm = {};
    const bf16_t* Qw = U.Qb + (size_t)(wid * QBLK + r32) * NQ + hi * 8;
#pragma unroll
    for (int d0 = 0; d0 < 12; ++d0) qr[d0] = *reinterpret_cast<const bf16x8*>(Qw + d0 * 16);
    if (U.qpos0 >= 0) { const int t = U.qpos0 + wid * QBLK + r32, pr = t >> 6, pc = t & 63;
        rope8(qr[8], qr[9], ropetab + (pr * 16 + hi * 8) * 2); rope8(qr[10], qr[11], ropetab + (pc * 16 + hi * 8) * 2); }
    unsigned von[2], vov[2], vor;
#pragma unroll
    for (int i = 0; i < 2; ++i) { const int p = (wid * 2 + i) * 64 + lane;
        { const int row = p >> 4, c = (p & 15) ^ (row & 15); von[i] = (unsigned)(row * (NKV * 2) + c * 16); }
        { const int sub = p >> 5, within = p & 31, kk = (sub >> 2) * 8 + (within >> 2), k = (kk & ~0xC) | ((kk & 4) << 1) | ((kk & 8) >> 1), c = (sub & 3) * 32 + (within & 3) * 8; vov[i] = (unsigned)(k * (NKV * 2) + NOPE * 2 + c * 2); } }
    { const int p = wid * 64 + lane, row = p >> 3, c = (p & 7) ^ ((row >> 1) & 7); vor = (unsigned)(row * (ROPED * 2) + c * 16); }
    const int kn0 = r32 * 256 + ((hi ^ (r32 & 15)) << 4), kr0 = KR_OFF + r32 * 128 + ((hi ^ ((r32 >> 1) & 7)) << 4), vb0 = (int)(uintptr_t)lds + V_OFF + v_rd_base(lane);
    const int nt_lat = U.nt_lat, kb_lat = U.kb_lat, kb_ctx = U.kb_ctx - 64 * nt_lat, NT = U.NT;
    const bf16_t* KVh = U.KVh;
    const unsigned ldsw2 = (unsigned)wid * 2048u, ldsw1 = (unsigned)wid * 1024u;
#define KROW(j) (((j) < nt_lat ? kb_lat : kb_ctx) + 64 * (j))
#define DMA(j, so) do { const size_t _k = (size_t)KROW(j); const char* _kv = (const char*)KVh + _k * (NKV * 2); const char* _kr = (const char*)KR + _k * (ROPED * 2); \
    __builtin_amdgcn_global_load_lds((const unsigned*)(_kv + von[0]), (LAS unsigned*)(lds + (so) + ldsw2), 16, 0, 0); \
    __builtin_amdgcn_global_load_lds((const unsigned*)(_kv + von[1]), (LAS unsigned*)(lds + (so) + ldsw2 + 1024), 16, 0, 0); \
    __builtin_amdgcn_global_load_lds((const unsigned*)(_kr + vor), (LAS unsigned*)(lds + (so) + KR_OFF + ldsw1), 16, 0, 0); \
    __builtin_amdgcn_global_load_lds((const unsigned*)(_kv + vov[0]), (LAS unsigned*)(lds + (so) + V_OFF + ldsw2), 16, 0, 0); \
    __builtin_amdgcn_global_load_lds((const unsigned*)(_kv + vov[1]), (LAS unsigned*)(lds + (so) + V_OFF + ldsw2 + 1024), 16, 0, 0); } while (0)
#define TILE_BAR() asm volatile("s_waitcnt vmcnt(0) lgkmcnt(0)\n\ts_barrier" ::: "memory")
#define RESC2(a) do { if (__any((a) < 1.f)) { if (hi == 0) al_l[r32] = (a); asm volatile("s_waitcnt lgkmcnt(0)" ::: "memory"); \
    _Pragma("unroll") for (int d = 0; d < 4; ++d) _Pragma("unroll") for (int r = 0; r < 16; ++r) o[d][r] *= al_l[crow(r, hi)]; } } while (0)
    f32x16 pA0, pA1, pB0, pB1; float alA, alB; bf16x8 pa0, pa1, pa2, pa3;
    int s_prev = 0, s_cur = SLOT, s_next = 2 * SLOT;
    DMA(0, 0); DMA(1, SLOT); TILE_BAR();
    qkt2n(pA0, pA1, (LAS const char*)lds, kn0, kr0, qr, negm); partialSM2<true>(pA0, pA1, m_reg, negm, alA);
    for (int j = 1; j + 1 < NT; j += 2) {
        DMA(j + 1, s_next); SBAR();
        qkt2n(pB0, pB1, (LAS const char*)lds, kn0 + s_cur, kr0 + s_cur, qr, negm);
        finishSM(pA0, pA1, alA, l_reg, pa0, pa1, pa2, pa3); SBAR();
        pv_d0(o, vb0 + s_prev, pa0, pa1, pa2, pa3); if (FIXM) { alB = 1.f; exp_half(pB0); } else partialSM2<false>(pB0, pB1, m_reg, negm, alB);
        if (!FIXM) RESC2(alB); TILE_BAR();
        { const int t = s_prev; s_prev = s_cur; s_cur = s_next; s_next = t; }
        if (j + 2 < NT) DMA(j + 2, s_next); SBAR();
        qkt2n(pA0, pA1, (LAS const char*)lds, kn0 + s_cur, kr0 + s_cur, qr, negm);
        finishSM(pB0, pB1, alB, l_reg, pa0, pa1, pa2, pa3); SBAR();
        pv_d0(o, vb0 + s_prev, pa0, pa1, pa2, pa3); if (FIXM) { alA = 1.f; exp_half(pA0); } else partialSM2<false>(pA0, pA1, m_reg, negm, alA);
        if (!FIXM) RESC2(alA); TILE_BAR();
        { const int t = s_prev; s_prev = s_cur; s_cur = s_next; s_next = t; }
    }
    SBAR(); qkt2n(pB0, pB1, (LAS const char*)lds, kn0 + s_cur, kr0 + s_cur, qr, negm);
    finishSM(pA0, pA1, alA, l_reg, pa0, pa1, pa2, pa3); SBAR();
    pv_d0(o, vb0 + s_prev, pa0, pa1, pa2, pa3); if (FIXM) { alB = 1.f; exp_half(pB0); } else partialSM2<false>(pB0, pB1, m_reg, negm, alB);
    if (!FIXM) RESC2(alB);
    finishSM(pB0, pB1, alB, l_reg, pa0, pa1, pa2, pa3); SBAR();
    pv_d0(o, vb0 + s_cur, pa0, pa1, pa2, pa3);
    if (FIXM) { const bool okl = (l_reg > 0.f) && (l_reg < 1e30f); const bool okw = __all(okl); if (lane == 0) ((LAS unsigned*)(lds + LDS2_BYTES))[wid] = okw ? 1u : 0u; }
    if (hi == 0) li_l[r32] = l_reg; asm volatile("s_waitcnt lgkmcnt(0)" ::: "memory");
    float rli[16];
#pragma unroll
    for (int r = 0; r < 16; ++r) rli[r] = __builtin_amdgcn_rcpf(li_l[crow(r, hi)]);
    bf16_t* Ow = U.Ob + (size_t)(wid * QBLK) * D;
#pragma unroll
    for (int r = 0; r < 16; ++r) { const int orow = crow(r, hi);
#pragma unroll
        for (int d0 = 0; d0 < 4; ++d0) Ow[(size_t)orow * D + d0 * 32 + r32] = (bf16_t)(cvt_pk_bf16(o[d0][r] * rli[r], 0.f) & 0xffffu); }
    TILE_BAR();
#undef KROW
#undef DMA
#undef TILE_BAR
#undef RESC2
}


#ifndef ATT_FORCE_SAFE
#define ATT_FORCE_SAFE 0
#endif
__device__ __forceinline__ void attn_unit_auto(const Unit& U, const bf16_t* __restrict__ KR, const float* __restrict__ ropetab, LAS unsigned char* lds) {
    attn_unit6<true>(U, KR, ropetab, lds);
    const LAS unsigned* fl = (const LAS unsigned*)(lds + LDS2_BYTES);
    unsigned okc = 0; for (int w = 0; w < NWAVES; ++w) okc += fl[w];
    if (ATT_FORCE_SAFE || __builtin_amdgcn_readfirstlane(okc) != (unsigned)NWAVES) attn_unit6<false>(U, KR, ropetab, lds);
}
}
constexpr size_t MiB = 1u << 20;
constexpr int CW_TMO = 0, CW_BAR = 4096;
constexpr int KSPL = 16;
constexpr size_t WS_CTL = 0;
constexpr size_t WS_MOD = 64 * 1024;
constexpr size_t WS_SSQ = 1 * MiB;
constexpr size_t CTL_ZERO_BYTES = 64 * 1024;
constexpr size_t WS_ROPE = 3 * MiB;
constexpr size_t WS_W13 = 4 * MiB;
constexpr size_t WS_W2 = 180 * MiB;
constexpr size_t WS_WPOOL = 268 * MiB;
constexpr size_t WS_WDQKV = 272 * MiB;
constexpr size_t WS_WUP = 282 * MiB;
constexpr size_t WS_WO = 296 * MiB;
constexpr size_t WS_H = 312 * MiB;
constexpr size_t WS_U = 444 * MiB;
constexpr size_t WS_Y = 510 * MiB;
constexpr size_t WS_P = 576 * MiB;
constexpr size_t WS_G = 642 * MiB;
constexpr size_t WS_CQKV = 824 * MiB;
constexpr size_t WS_Q = 866 * MiB;
constexpr size_t WS_KV = 965 * MiB;
constexpr size_t WS_KR = 1097 * MiB;
constexpr size_t WS_YP = 1100 * MiB;
constexpr size_t WS_END = 1148 * MiB;
static_assert(WS_W13 + (size_t)4 * 11264 * 2048 * 2 <= WS_W2 && WS_W2 + (size_t)4 * 2048 * 5632 * 2 <= WS_WPOOL && WS_H + (size_t)T * D * 4 <= WS_U && WS_U + (size_t)T * D * 2 <= WS_Y, "ws map");
static_assert(WS_G + (size_t)T * DFF * 2 <= WS_CQKV && WS_CQKV + (size_t)T * NDQKV * 2 <= WS_Q && WS_Q + (size_t)T * NQ * 2 <= WS_KV && WS_KV + (size_t)T * NKV * 2 <= WS_KR && WS_KR + (size_t)T * ROPED * 2 <= WS_YP && WS_YP + (size_t)11 * TC * D * 4 <= WS_END, "ws map");
static_assert(WS_MOD + (size_t)4 * 3 * NMOD * 4 <= WS_SSQ && WS_SSQ + (size_t)16 * T * 4 <= WS_ROPE && (CW_BAR + 3456) * 4 <= (int)CTL_ZERO_BYTES, "ctl map");

constexpr int RING_BYTES = 131072, MISC_OFF = RING_BYTES, LDS_BYTES = 147456;
static_assert(att::LDS_BYTES <= RING_BYTES && att::LDS2_BYTES + 64 <= RING_BYTES, "attention LDS");

#define XB_TMO      128
#define XB_XCNT(j)  (256  + 64 * (j))
#define XB_XSUB(j)  (1280 + 64 * (j))
#define XB_XGEN(j)  (2304 + 64 * (j))
#define XB_TOP      3328
#define XB_TOPGEN   3392
#define XCD_BAR_WORDS 3456
#define XB_SPIN_CAP (1u << 22)
__device__ __forceinline__ unsigned xb_ld(unsigned* p)              { return __hip_atomic_load(p, __ATOMIC_RELAXED, __HIP_MEMORY_SCOPE_AGENT); }
__device__ __forceinline__ unsigned xb_add(unsigned* p, unsigned v) { return __hip_atomic_fetch_add(p, v, __ATOMIC_RELAXED, __HIP_MEMORY_SCOPE_AGENT); }
__device__ __forceinline__ unsigned xb_xcc_id() { return (unsigned)__builtin_amdgcn_s_getreg((3 << 11) | 20) & 0xFu; }
#define XB_SPIN(cond, bar) do { unsigned _sp = 0; while (cond) { __builtin_amdgcn_s_sleep(1); \
    if ((++_sp & 255u) == 0u) { if (xb_ld(&(bar)[XB_TMO])) break; if (_sp > XB_SPIN_CAP) { atomicAdd(&(bar)[XB_TMO], 1u); break; } } } } while (0)
struct XcdBarrier { unsigned* bar; unsigned x; volatile LAS unsigned* st; };
__device__ __forceinline__ XcdBarrier xcd_barrier_post(unsigned* bar, volatile LAS unsigned* st) {
    XcdBarrier b; b.bar = bar; b.x = xb_xcc_id(); b.st = st;
    if (threadIdx.x == 0) (void)xb_add(&bar[XB_XCNT(b.x)], 1u);
    return b;
}
__device__ __forceinline__ void xcd_barrier_complete(unsigned* bar, unsigned x, unsigned& nloc, unsigned& nx) {
    const unsigned G = gridDim.x * gridDim.y * gridDim.z;
    unsigned sum, cnt, mine, sp = 0u;
    for (;;) {
        sum = 0u; cnt = 0u; mine = 0u;
#pragma unroll
        for (unsigned j = 0; j < 16; ++j) { const unsigned c = xb_ld(&bar[XB_XCNT(j)]); sum += c; cnt += (c > 0u) ? 1u : 0u; mine = (j == x) ? c : mine; }
        if (sum == G) break;
        __builtin_amdgcn_s_sleep(1);
        if ((++sp & 255u) == 0u) { if (xb_ld(&bar[XB_TMO])) break; if (sp > XB_SPIN_CAP) { atomicAdd(&bar[XB_TMO], 1u); break; } }
    }
    nloc = mine > 0u ? mine : 1u; nx = cnt > 0u ? cnt : 1u;
}
__device__ __forceinline__ void xcd_barrier(const XcdBarrier& b) {
    asm volatile("s_waitcnt vmcnt(0)" ::: "memory");
    __syncthreads();
    if (threadIdx.x == 0) {
        unsigned* bar = b.bar; asm volatile("" : "+s"(bar));
        __builtin_amdgcn_s_waitcnt(0);
        const unsigned bx = xb_xcc_id();
        unsigned nloc = b.st[0], nx = b.st[1];
        if (nloc == 0u) { xcd_barrier_complete(bar, bx, nloc, nx); b.st[0] = nloc; b.st[1] = nx; }
        const unsigned old = xb_add(&bar[XB_XSUB(bx)], 1u);
        const unsigned gen = old / nloc;
        if (old + 1u == (gen + 1u) * nloc) {
            __builtin_amdgcn_fence(__ATOMIC_RELEASE, "agent");
            asm volatile("s_waitcnt vmcnt(0)" ::: "memory");
            const unsigned og = xb_add(&bar[XB_TOP], 1u);
            const unsigned tg = og / nx;
            if (og + 1u == (tg + 1u) * nx) xb_add(&bar[XB_TOPGEN], 1u);
            else XB_SPIN(xb_ld(&bar[XB_TOPGEN]) == tg, bar);
            __builtin_amdgcn_fence(__ATOMIC_ACQUIRE, "agent");
            xb_add(&bar[XB_XGEN(bx)], 1u);
            asm volatile("s_waitcnt vmcnt(0)" ::: "memory");
        } else {
            XB_SPIN(xb_ld(&bar[XB_XGEN(bx)]) == gen, bar);
            __builtin_amdgcn_fence(__ATOMIC_ACQUIRE, "agent");
            asm volatile("s_waitcnt vmcnt(0)" ::: "memory");
        }
    }
    __syncthreads();
}

#define LDS_WAIT() asm volatile("s_waitcnt lgkmcnt(0)" ::: "memory")
__device__ __forceinline__ void tr_item(const float* __restrict__ W, int ldw, int k0, int n0, bf16_t* __restrict__ WT, int ldt, int drow0, const float* __restrict__ ksc, const float* __restrict__ nsc, LAS float* scr, int lane, float mul = 1.f) {
    const float ns = (nsc ? nsc[n0 + (lane & 31)] : 1.f) * mul;
    float v[32];
    const float* wp = W + (size_t)(k0 + (lane >> 5)) * ldw + n0 + (lane & 31);
#pragma unroll
    for (int i = 0; i < 32; ++i) v[i] = __builtin_nontemporal_load(wp + (size_t)(2 * i) * ldw);
    if (ksc) {
#pragma unroll
        for (int i = 0; i < 32; ++i) v[i] *= ksc[k0 + 2 * i + (lane >> 5)]; }
#pragma unroll
    for (int i = 0; i < 32; ++i) scr[(2 * i + (lane >> 5)) * 33 + (lane & 31)] = v[i] * ns;
    LDS_WAIT(); asm volatile("" ::: "memory");
    const int c = lane & 7;
#pragma unroll
    for (int j = 0; j < 4; ++j) { const int n = (lane >> 3) + 8 * j; const LAS float* s = scr + (8 * c) * 33 + n;
        u32x4 o; o.x = cvt_pk_bf16(s[0 * 33], s[1 * 33]); o.y = cvt_pk_bf16(s[2 * 33], s[3 * 33]); o.z = cvt_pk_bf16(s[4 * 33], s[5 * 33]); o.w = cvt_pk_bf16(s[6 * 33], s[7 * 33]);
        *(u32x4*)(WT + (size_t)(drow0 + n) * ldt + k0 + 8 * c) = o; }
    LDS_WAIT(); asm volatile("" ::: "memory");
}

constexpr int I_F = (D / 64) * (DFF / 32);
__device__ __forceinline__ void ffn_item(const float* w1, const float* w3, const float* w2, bf16_t* W13, bf16_t* W2, int l, int q, LAS float* scr, int lane) {
    const int which = q / I_F, item = q % I_F;
    if (which < 2) { const int nblk = DFF / 32, kb = item / nblk, nb = item % nblk, n0 = nb * 32;
        tr_item((which ? w3 : w1) + (size_t)l * D * DFF, DFF, kb * 64, n0, W13 + (size_t)l * 2 * DFF * D, D, 256 * (n0 >> 7) + 128 * which + (n0 & 127), nullptr, nullptr, scr, lane); }
    else { const int nblk = D / 32, kb = item / nblk, nb = item % nblk;
        tr_item(w2 + (size_t)l * DFF * D, D, kb * 64, nb * 32, W2 + (size_t)l * D * DFF, DFF, nb * 32, nullptr, nullptr, scr, lane); }
}

struct In {
    const float *x, *c, *ctx, *c_ctx, *ada_w, *ada_b, *norm_g, *pool_w, *pool_scale, *w_dqkv, *q_norm, *w_uq, *kv_norm, *w_ukv, *w_o, *w1, *w3, *w2;
};

__device__ __forceinline__ void prologue(const In& I, unsigned char* ws, LAS unsigned char* lds, int gw, int ngw, int wave, int lane, int gtid, int ngt) {
    LAS float* scr = (LAS float*)(lds + wave * 16384);
    bf16_t* W13 = (bf16_t*)(ws + WS_W13); bf16_t* W2 = (bf16_t*)(ws + WS_W2); bf16_t* WPOOL = (bf16_t*)(ws + WS_WPOOL); bf16_t* WDQKV = (bf16_t*)(ws + WS_WDQKV);
    bf16_t* WUP = (bf16_t*)(ws + WS_WUP); bf16_t* WO = (bf16_t*)(ws + WS_WO);
    constexpr int I_P = (512 / 64) * (512 / 32);
    constexpr int I_DQ = (D / 64) * (1088 / 32);
    constexpr int I_UQ = (QL / 64) * (NQ / 32), I_UKV = (KVL / 64) * (NKV / 32);
    constexpr int I_O = (D / 64) * (D / 32);
    constexpr int N_FFN = 12 * I_F, N_POOL = 8 * I_P, N_DQ = 2 * I_DQ, N_UQ = 2 * I_UQ, N_UKV = 2 * I_UKV, N_O = 2 * I_O;
    constexpr int NITEMS = N_FFN + N_POOL + N_DQ + N_UQ + N_UKV + N_O;
    for (int it = gw; it < NITEMS; it += ngw) {
        int r = it;
        if (r < N_FFN) { ffn_item(I.w1, I.w3, I.w2, W13, W2, r / (3 * I_F), r % (3 * I_F), scr, lane); continue; }
        r -= N_FFN;
        if (r < N_POOL) { const int jg = r / I_P, item = r % I_P, j = jg >> 2, g = jg & 3, nblk = 512 / 32, kb = item / nblk, nb = item % nblk;
            tr_item(I.pool_w + (size_t)jg * 512 * 512, 512, kb * 64, nb * 32, WPOOL + (size_t)j * D * 512, 512, g * 512 + nb * 32, nullptr, I.pool_scale + j * D + g * 512, scr, lane); continue; }
        r -= N_POOL;
        if (r < N_DQ) { const int j = r / I_DQ, item = r % I_DQ, nblk = 1088 / 32, kb = item / nblk, nb = item % nblk;
            tr_item(I.w_dqkv + (size_t)j * D * 1088, 1088, kb * 64, nb * 32, WDQKV + (size_t)j * NDQKV * D, D, nb * 32, nullptr, nullptr, scr, lane); continue; }
        r -= N_DQ;
        if (r < N_UQ) { const int j = r / I_UQ, item = r % I_UQ, nblk = NQ / 32, kb = item / nblk, nb = item % nblk;
            tr_item(I.w_uq + (size_t)j * QL * NQ, NQ, kb * 64, nb * 32, WUP + (size_t)j * NUP * 512, 512, nb * 32, I.q_norm + j * QL, nullptr, scr, lane, att::SCALE * 1.4426950408889634f); continue; }
        r -= N_UQ;
        if (r < N_UKV) { const int j = r / I_UKV, item = r % I_UKV, nblk = NKV / 32, kb = item / nblk, nb = item % nblk;
            tr_item(I.w_ukv + (size_t)j * KVL * NKV, NKV, kb * 64, nb * 32, WUP + (size_t)j * NUP * 512, 512, NQ + nb * 32, I.kv_norm + j * KVL, nullptr, scr, lane); continue; }
        r -= N_UKV;
        { const int j = r / I_O, item = r % I_O, nblk = D / 32, kb = item / nblk, nb = item % nblk;
            tr_item(I.w_o + (size_t)j * D * D, D, kb * 64, nb * 32, WO + (size_t)j * D * D, D, nb * 32, nullptr, nullptr, scr, lane); }
    }
    { constexpr int PER = (NDQKV - 1088) * D / 8;
        for (int i = gtid; i < 2 * PER; i += ngt) { const int j = i / PER, q = i % PER; *(u32x4*)(WDQKV + (size_t)j * NDQKV * D + (size_t)1088 * D + (size_t)q * 8) = (u32x4){0u, 0u, 0u, 0u}; } }
    if (gtid < 128 * 16) { const int pos = gtid >> 4, f = gtid & 15; const float inv = powf(10000.f, -(float)(2 * f) / 32.f), ang = (float)pos * inv;
        float* tab = (float*)(ws + WS_ROPE); tab[gtid * 2] = cosf(ang); tab[gtid * 2 + 1] = sinf(ang); }
    { float* MODP = (float*)(ws + WS_G); constexpr int NSTRIP = NMOD / 256, KLEN = D / KSPL;
        for (int task = gw; task < 4 * NSTRIP * KSPL; task += ngw) { const int ks = task % KSPL, st = (task / KSPL) % NSTRIP, l = task / (KSPL * NSTRIP), k0 = ks * KLEN;
            float sv[3][2];
#pragma unroll
            for (int h = 0; h < 2; ++h) { const int k = k0 + h * 64 + lane; const float c0 = I.c[k], c1 = I.c[D + k], c2 = I.c_ctx[k];
                sv[0][h] = c0 / (1.f + __expf(-c0)); sv[1][h] = c1 / (1.f + __expf(-c1)); sv[2][h] = c2 / (1.f + __expf(-c2)); }
            const float* wp = I.ada_w + ((size_t)l * D + k0) * NMOD + st * 256 + lane * 4;
            f32x4 a0 = {0.f, 0.f, 0.f, 0.f}, a1 = a0, a2 = a0;
#pragma unroll
            for (int h = 0; h < 2; ++h)
#pragma unroll 8
                for (int kk = 0; kk < 64; ++kk) { const f32x4 w = __builtin_nontemporal_load((const f32x4*)(wp + (size_t)(h * 64 + kk) * NMOD));
                    a0 += w * __shfl(sv[0][h], kk); a1 += w * __shfl(sv[1][h], kk); a2 += w * __shfl(sv[2][h], kk); }
            float* mp = MODP + (size_t)ks * 12 * NMOD + (size_t)l * 3 * NMOD + st * 256 + lane * 4;
            *(f32x4*)mp = a0; *(f32x4*)(mp + NMOD) = a1; *(f32x4*)(mp + 2 * NMOD) = a2;
        } }
}

struct RN { const float* xin_lat; const float* xin_ctx; const bf16_t* hin; const bf16_t* Y; const float* Yp; int nparts; const float* gate; const float* gY; bf16_t* hout; float* fout;
            const float* gN; const float* shift; const float* scale; bf16_t* U; int nrows; const float* modp; const float* bias; float* mod_out; };
template <bool HAS_Y, bool WRITE_U, bool HIN_F32, bool HOUT_F32, bool MODP_IN = false, bool POOLY = false>
__device__ __forceinline__ void resid_norm(const RN& a, LAS unsigned char* lds, int gw, int ngw, int tid) {
    asm volatile("" : "+v"(tid)); const int lane = tid & 63;
    typedef const GAS char* gcp; typedef GAS char* gp;
    if (MODP_IN) {
        for (int i = (gw * 64 + lane); i < 12 * NMOD / 4; i += ngw * 64) { f32x4 acc = *(const GAS f32x4*)((gcp)a.bias + 16 * ((size_t)(i / (3 * NMOD / 4)) * (NMOD / 4) + i % (NMOD / 4)));
            for (int p = 0; p < KSPL; ++p) acc += *(const GAS f32x4*)((gcp)a.modp + ((size_t)p * 12 * NMOD + (size_t)i * 4) * 4);
            *(GAS f32x4*)((gp)a.mod_out + (size_t)i * 16) = acc; } }
    for (int i = tid; i < 3 * (D / 4); i += NTHREADS) { const int s = i / (D / 4), c4 = i % (D / 4); LAS f32x4* t = (LAS f32x4*)(lds + s * 24576) + c4;
        if (HAS_Y) t[0] = *(const GAS f32x4*)((gcp)(a.gate + (size_t)s * NMOD) + 16 * c4) * *(const GAS f32x4*)((gcp)a.gY + 16 * c4);
        if (WRITE_U) { f32x4 sc, sh;
            if (MODP_IN) { sh = *(const GAS f32x4*)((gcp)a.bias + 16 * c4); sc = *(const GAS f32x4*)((gcp)a.bias + 16 * (D / 4 + c4));
                for (int p = 0; p < KSPL; ++p) { const float* mp = a.modp + (size_t)p * 12 * NMOD + (size_t)s * NMOD; sh += *(const GAS f32x4*)((gcp)mp + 16 * c4); sc += *(const GAS f32x4*)((gcp)mp + 16 * (D / 4 + c4)); } }
            else { sc = *(const GAS f32x4*)((gcp)(a.scale + (size_t)s * NMOD) + 16 * c4); sh = *(const GAS f32x4*)((gcp)(a.shift + (size_t)s * NMOD) + 16 * c4); }
            t[D / 4] = *(const GAS f32x4*)((gcp)a.gN + 16 * c4) * (sc + 1.f); t[2 * (D / 4)] = sh; } }
    __syncthreads();
    const unsigned l16 = (unsigned)lane * 16u, l8 = (unsigned)lane * 8u;
    const int nrows = a.nrows, nparts = a.nparts;
#define LDF4(base, j) (*(const GAS f32x4*)((gcp)(base) + l16 + 1024u * (j)))
#define LDB4(base, j) (*(const GAS u32x2*)((gcp)(base) + l8 + 512u * (j)))
#define UNPK(w) ((f32x4){bf_lo((w).x), bf_hi((w).x), bf_lo((w).y), bf_hi((w).y)})
#define RN_LOAD(hf, hw, yw, r) do { \
        if (HIN_F32) { const float* hp_ = (r) < TL ? a.xin_lat + (size_t)(r) * D : a.xin_ctx + (size_t)((r) - TL) * D; _Pragma("unroll") for (int j = 0; j < 8; ++j) hf[j] = LDF4(hp_, j); } \
        else { const bf16_t* hp_ = a.hin + (size_t)(r) * D; _Pragma("unroll") for (int j = 0; j < 8; ++j) hw[j] = LDB4(hp_, j); } \
        if (HAS_Y && !POOLY && !((r) >= TL && nparts > 0)) { const bf16_t* yr_ = a.Y + (size_t)(r) * D; _Pragma("unroll") for (int j = 0; j < 8; ++j) yw[j] = LDB4(yr_, j); } } while (0)
#define RN_PROC(hf, hw, yw, r) do { const int s_ = (r) < SEQ ? 0 : ((r) < TL ? 1 : 2); const LAS f32x4* tb_ = (const LAS f32x4*)(lds + s_ * 24576) + lane; f32x4 h[8]; \
        _Pragma("unroll") for (int j = 0; j < 8; ++j) h[j] = HIN_F32 ? hf[j] : UNPK(hw[j]); \
        if (HAS_Y) { f32x4 y[8]; float sy = 0.f; \
            if (POOLY) {   \
                int sb_, L_; if ((r) < TL) { sb_ = ((r) / SEQ) * SEQ; L_ = SEQ; } else { sb_ = TL + (((r) - TL) / CTXL) * CTXL; L_ = CTXL; } const int t_ = (r) - sb_; const bf16_t* zs_ = a.Y + (size_t)sb_ * D; \
                _Pragma("unroll") for (int g = 0; g < 4; ++g) { const int w2_ = 1 << g, lo_ = max(t_ - w2_, 0), hi_ = min(t_ + w2_, L_); const float inv_ = 1.f / (float)(hi_ - lo_); \
                    f32x4 s0_ = {0.f, 0.f, 0.f, 0.f}, s1_ = s0_; \
                    _Pragma("unroll") for (int i = 0; i < 2 * w2_; ++i) { const int q_ = t_ - w2_ + i; const bool ok_ = q_ >= 0 && q_ < L_; const bf16_t* zr_ = zs_ + (size_t)(ok_ ? q_ : t_) * D; \
                        const u32x2 wa_ = LDB4(zr_, 2 * g), wb_ = LDB4(zr_, 2 * g + 1); const float m_ = ok_ ? 1.f : 0.f; s0_ += UNPK(wa_) * m_; s1_ += UNPK(wb_) * m_; } \
                    const bf16_t* zc_ = zs_ + (size_t)t_ * D; const u32x2 ca_ = LDB4(zc_, 2 * g), cb_ = LDB4(zc_, 2 * g + 1); y[2 * g] = s0_ * inv_ - UNPK(ca_); y[2 * g + 1] = s1_ * inv_ - UNPK(cb_); } } \
            else if ((r) >= TL && nparts > 0) { _Pragma("unroll") for (int j = 0; j < 8; ++j) y[j] = (f32x4){0.f, 0.f, 0.f, 0.f}; \
                for (int p = 0; p < nparts; ++p) { const float* yp_ = a.Yp + ((size_t)p * TC + ((r) - TL)) * D; _Pragma("unroll") for (int j = 0; j < 8; ++j) y[j] += LDF4(yp_, j); } } \
            else { _Pragma("unroll") for (int j = 0; j < 8; ++j) y[j] = UNPK(yw[j]); } \
            _Pragma("unroll") for (int j = 0; j < 8; ++j) sy += (y[j][0] * y[j][0] + y[j][1] * y[j][1]) + (y[j][2] * y[j][2] + y[j][3] * y[j][3]); \
            const float rs_ = __builtin_amdgcn_rsqf(wave_sum(sy) * (1.f / D) + RMS_EPS); \
            _Pragma("unroll") for (int j = 0; j < 8; ++j) h[j] += tb_[64 * j] * (y[j] * rs_); } \
        if (HOUT_F32) { float* op_ = a.fout + (size_t)(r) * D; _Pragma("unroll") for (int j = 0; j < 8; ++j) *(GAS f32x4*)((gp)op_ + l16 + 1024u * j) = h[j]; } \
        else if (a.hout) { bf16_t* op_ = a.hout + (size_t)(r) * D; _Pragma("unroll") for (int j = 0; j < 8; ++j) { u32x2 w; w.x = cvt_pk_bf16(h[j][0], h[j][1]); w.y = cvt_pk_bf16(h[j][2], h[j][3]); *(GAS u32x2*)((gp)op_ + l8 + 512u * j) = w; } } \
        if (WRITE_U) { float ss = 0.f; \
            _Pragma("unroll") for (int j = 0; j < 8; ++j) ss += (h[j][0] * h[j][0] + h[j][1] * h[j][1]) + (h[j][2] * h[j][2] + h[j][3] * h[j][3]); \
            const float rstd_ = __builtin_amdgcn_rsqf(wave_sum(ss) * (1.f / D) + RMS_EPS); bf16_t* ur_ = a.U + (size_t)(r) * D; \
            _Pragma("unroll") for (int j = 0; j < 8; ++j) { const f32x4 u = (h[j] * rstd_) * tb_[D / 4 + 64 * j] + tb_[2 * (D / 4) + 64 * j]; u32x2 w; w.x = cvt_pk_bf16(u[0], u[1]); w.y = cvt_pk_bf16(u[2], u[3]); \
                *(GAS u32x2*)((gp)ur_ + l8 + 512u * j) = w; } } } while (0)
    f32x4 hfA[8], hfB[8]; u32x2 hwA[8], hwB[8], ywA[8], ywB[8];
    int r = gw;
    if (r < nrows) RN_LOAD(hfA, hwA, ywA, r);
    while (r < nrows) {
        int rn = r + ngw;
        if (rn < nrows) RN_LOAD(hfB, hwB, ywB, rn);
        RN_PROC(hfA, hwA, ywA, r);
        r = rn; if (r >= nrows) break;
        rn = r + ngw;
        if (rn < nrows) RN_LOAD(hfA, hwA, ywA, rn);
        RN_PROC(hfB, hwB, ywB, r);
        r = rn;
    }
#undef LDF4
#undef LDB4
#undef UNPK
#undef RN_LOAD
#undef RN_PROC
    __syncthreads();
}

__device__ __forceinline__ void krope_phase(const bf16_t* __restrict__ CQKV, bf16_t* __restrict__ KR, const float* __restrict__ tab, int gtid, int ngt) {
    asm volatile("" : "+v"(gtid));
    for (int i = gtid; i < T * 32; i += ngt) { const int r = i >> 5, ax = (i >> 4) & 1, f = i & 15;
        const bf16_t* src = CQKV + (size_t)r * NDQKV + 1024 + ax * 32 + f; const float x1 = bf_lo((unsigned)src[0]), x2 = bf_lo((unsigned)src[16]); float o1 = x1, o2 = x2;
        if (r < TL) { const int t = r & (SEQ - 1), pos = ax ? (t & 63) : (t >> 6); const float c = tab[(pos * 16 + f) * 2], s = tab[(pos * 16 + f) * 2 + 1]; o1 = x1 * c - x2 * s; o2 = x2 * c + x1 * s; }
        bf16_t* dst = KR + (size_t)r * ROPED + ax * 32 + f; dst[0] = (bf16_t)(cvt_pk_bf16(o1, 0.f) & 0xffffu); dst[16] = (bf16_t)(cvt_pk_bf16(o2, 0.f) & 0xffffu); }
}

#ifndef EN_P0
#define EN_P0 1
#endif
#ifndef EN_P1
#define EN_P1 1
#endif
#ifndef EN_S0
#define EN_S0 1
#endif
#ifndef EN_S1
#define EN_S1 1
#endif
#ifndef EN_S2
#define EN_S2 1
#endif
#ifndef EN_S3
#define EN_S3 1
#endif
#ifndef EN_S4
#define EN_S4 1
#endif
#ifndef EN_S5
#define EN_S5 1
#endif
#ifndef EN_S6
#define EN_S6 1
#endif
#ifndef EN_S7
#define EN_S7 1
#endif
struct Args { const float* in[18]; float* out; unsigned char* ws; int ph_lo, ph_hi; };
constexpr int N_PHASES = 34;
constexpr int SPLIT_POOL = 2, SPLIT_WO = 8, SPLIT_FFN2 = 11;

__global__ void __launch_bounds__(NTHREADS, 2) mk_fwd(Args args) {
    extern __shared__ __attribute__((aligned(16))) unsigned char lds_raw[];
    LAS unsigned char* lds = (LAS unsigned char*)lds_raw;
    volatile LAS unsigned* MISC = (volatile LAS unsigned*)(lds + MISC_OFF);
    const int G0 = gridDim.x, bid0 = blockIdx.x;
    unsigned char* ws = args.ws;
    for (int u = threadIdx.x; u < (LDS_BYTES - MISC_OFF) / 4; u += NTHREADS) ((LAS unsigned*)(lds + MISC_OFF))[u] = 0u;
    __syncthreads();
#if MK_PER_PHASE
    const int lo = args.ph_lo, hi = args.ph_hi;
#else
    constexpr int lo = 0, hi = N_PHASES;
#endif
    const bool use_bar = (hi - lo) > 1;
    XcdBarrier bar; bar.bar = (unsigned*)(ws + WS_CTL) + CW_BAR; bar.x = 0; bar.st = MISC + 8;
    if (use_bar) bar = xcd_barrier_post((unsigned*)(ws + WS_CTL) + CW_BAR, MISC + 8);
#define IN(k) (lo <= (k) && (k) < hi)
#define PHASE_END(k) do { if (hi > (k) + 1) xcd_barrier(bar); } while (0)
#define SITE() int tid = threadIdx.x, G = G0, bid = bid0; asm volatile("" : "+v"(tid), "+s"(G), "+s"(bid)); const int lane = tid & 63, wave = __builtin_amdgcn_readfirstlane(tid >> 6), gw = bid * NWAVES + wave, gtid = bid * NTHREADS + tid, ngw = G * NWAVES, ngt = G * NTHREADS; \
               (void)lane; (void)gw; (void)gtid; (void)ngw; (void)ngt; const __attribute__((address_space(4))) char* kp_ = (const __attribute__((address_space(4))) char*)__builtin_amdgcn_kernarg_segment_ptr(); asm volatile("" : "+s"(kp_)); \
               unsigned char* wsl = *(unsigned char* const __attribute__((address_space(4)))*)(kp_ + 19 * 8); asm volatile("" : "+s"(wsl))
#define KIN(k) (*(const float* const __attribute__((address_space(4)))*)(kp_ + (k) * 8))
#define KOUT() (*(float* const __attribute__((address_space(4)))*)(kp_ + 18 * 8))
#define WP(type, off) ((type*)(wsl + (off)))

    if (EN_P0 && IN(0)) { SITE();
        In I; I.x = KIN(0); I.c = KIN(1); I.ctx = KIN(2); I.c_ctx = KIN(3); I.ada_w = KIN(4); I.ada_b = KIN(5); I.norm_g = KIN(6); I.pool_w = KIN(7);
        I.pool_scale = KIN(8); I.w_dqkv = KIN(9); I.q_norm = KIN(10); I.w_uq = KIN(11); I.kv_norm = KIN(12); I.w_ukv = KIN(13); I.w_o = KIN(14); I.w1 = KIN(15); I.w3 = KIN(16); I.w2 = KIN(17);
        prologue(I, wsl, lds, gw, ngw, wave, lane, gtid, ngt); PHASE_END(0); }
    if (EN_P1 && IN(1)) { SITE();
        RN a; a.xin_lat = KIN(0); a.xin_ctx = KIN(2); a.hin = nullptr; a.Y = nullptr; a.Yp = nullptr; a.nparts = 0; a.gate = nullptr; a.gY = nullptr; a.hout = nullptr; a.fout = nullptr;
        a.gN = KIN(6); a.shift = nullptr; a.scale = nullptr; a.U = WP(bf16_t, WS_U); a.nrows = T; a.modp = WP(const float, WS_G); a.bias = KIN(5); a.mod_out = WP(float, WS_MOD);
        resid_norm<false, true, true, false, true>(a, lds, gw, ngw, tid); PHASE_END(1); }

    for (int L = 0; L < 4; ++L) {
        const int base = 2 + 8 * L, j = L >> 1; const bool pool = (L & 1) == 0;
        const int Mrows = (L == 3) ? TL : T;
        if (EN_S0 && !pool && IN(base + 0)) { SITE(); float* SSQ = WP(float, WS_SSQ);
            pg8::Gemm g{WP(const bf16_t, WS_U), WP(const bf16_t, WS_WDQKV) + (size_t)j * NDQKV * D, T, NDQKV, D, D, D}; pg8::StaticOrder S; S.init(T, NDQKV, D, G, bid);
            pg8::EpiStore E{WP(bf16_t, WS_CQKV), NDQKV, SSQ, SSQ + (size_t)8 * T, 2, 4, 0, 0};
            pg8::gemm_phase<pg8::EpiStore, pg8::StaticOrder>(lds, g, S, E);
            PHASE_END(base + 0); }
        if (EN_S1 && !pool && IN(base + 1)) { SITE(); float* SSQ = WP(float, WS_SSQ);
            krope_phase(WP(const bf16_t, WS_CQKV), WP(bf16_t, WS_KR), WP(const float, WS_ROPE), gtid, ngt);
            pg8::Gemm g{WP(const bf16_t, WS_CQKV), WP(const bf16_t, WS_WUP) + (size_t)j * NUP * 512, T, NUP, 512, NDQKV, 512}; pg8::StaticOrder S; S.init(T, NUP, 512, G, bid);
            pg8::EpiUp E{WP(bf16_t, WS_Q), WP(bf16_t, WS_KV), SSQ, SSQ + (size_t)8 * T};
            pg8::gemm_phase<pg8::EpiUp, pg8::StaticOrder>(lds, g, S, E);
            PHASE_END(base + 1); }
        if (EN_S2 && !pool && IN(base + 2)) { SITE();
            const bf16_t* Qb = WP(const bf16_t, WS_Q); const bf16_t* KV = WP(const bf16_t, WS_KV); bf16_t* P = WP(bf16_t, WS_P);
            const int nlat = NB * NH * (SEQ / 256), nunits = nlat + (L == 1 ? NB * NH : 0);
            for (int u = bid; u < nunits; u += G) {
                att::Unit A;
                if (u < nlat) { const int pair = (u >> 8) * 8 + (u & 7), qb = (u & 255) >> 3, b = pair >> 4, h = pair & 15; const int row0 = b * SEQ + qb * 256;
                    A.Qb = Qb + (size_t)row0 * NQ + h * QKD; A.KVh = KV + h * 256; A.Ob = P + (size_t)row0 * D + h * VD; A.kb_lat = b * SEQ; A.nt_lat = SEQ / 64; A.kb_ctx = TL + b * CTXL; A.NT = SEQ / 64 + CTXL / 64; A.qpos0 = qb * 256; }
                else { const int v = u - nlat, b = v >> 4, h = v & 15; const int row0 = TL + b * CTXL;
                    A.Qb = Qb + (size_t)row0 * NQ + h * QKD; A.KVh = KV + h * 256; A.Ob = P + (size_t)row0 * D + h * VD; A.kb_lat = 0; A.nt_lat = 0; A.kb_ctx = row0; A.NT = CTXL / 64; A.qpos0 = -1; }
                att::attn_unit_auto(A, WP(const bf16_t, WS_KR), WP(const float, WS_ROPE), lds);
            }
            PHASE_END(base + 2); }
        if (EN_S3 && IN(base + 3)) { SITE();
            pg8::Gemm g; pg8::EpiY E{WP(bf16_t, WS_Y), WP(float, WS_YP), D, TL, TC, 0, 0}; pg8::HybridOrder S;
            if (pool) { g = pg8::Gemm{WP(const bf16_t, WS_U), WP(const bf16_t, WS_WPOOL) + (size_t)j * D * 512, Mrows, D, 512, D, 512}; E.a_grp_tiles = 2; E.a_grp_off = 512; S.init(Mrows, Mrows, D, 512, G, bid, 1); }
            else { g = pg8::Gemm{WP(const bf16_t, WS_P), WP(const bf16_t, WS_WO) + (size_t)j * D * D, Mrows, D, D, D, D}; S.init(TL, Mrows, D, D, G, bid, SPLIT_WO); }
            pg8::gemm_phase<pg8::EpiY, pg8::HybridOrder>(lds, g, S, E);
            PHASE_END(base + 3); }
        if (EN_S4 && IN(base + 4)) { SITE(); const float* modL = WP(const float, WS_MOD) + (size_t)L * 3 * NMOD; const float* gL = KIN(6) + (size_t)L * 4 * D;
            RN a; a.xin_lat = KIN(0); a.xin_ctx = KIN(2); a.hin = WP(const bf16_t, WS_H); a.Y = WP(const bf16_t, WS_Y); a.Yp = WP(const float, WS_YP); a.nparts = (!pool && Mrows > TL) ? SPLIT_WO : 0; a.gate = modL + 2 * D; a.gY = gL + D;
            a.hout = WP(bf16_t, WS_H); a.fout = nullptr; a.gN = gL + 2 * D; a.shift = modL + 3 * D; a.scale = modL + 4 * D; a.U = WP(bf16_t, WS_U); a.nrows = Mrows; a.modp = nullptr; a.bias = nullptr; a.mod_out = nullptr;
            if (L == 0) resid_norm<true, true, true, false, false, true>(a, lds, gw, ngw, tid); else if (pool) resid_norm<true, true, false, false, false, true>(a, lds, gw, ngw, tid); else resid_norm<true, true, false, false>(a, lds, gw, ngw, tid);
            PHASE_END(base + 4); }
        if (EN_S5 && IN(base + 5)) { SITE(); pg8::Gemm g{WP(const bf16_t, WS_U), WP(const bf16_t, WS_W13) + (size_t)L * 2 * DFF * D, Mrows, 2 * DFF, D, D, D}; pg8::StaticOrder S; S.init(Mrows, 2 * DFF, D, G, bid);
            pg8::EpiSwiGLU E{WP(bf16_t, WS_G), DFF};
            pg8::gemm_phase<pg8::EpiSwiGLU, pg8::StaticOrder>(lds, g, S, E);
            PHASE_END(base + 5); }
        if (EN_S6 && IN(base + 6)) { SITE();
            pg8::Gemm g{WP(const bf16_t, WS_G), WP(const bf16_t, WS_W2) + (size_t)L * D * DFF, Mrows, D, DFF, DFF, DFF}; pg8::HybridOrder S; S.init(TL, Mrows, D, DFF, G, bid, SPLIT_FFN2);
            pg8::EpiY E{WP(bf16_t, WS_Y), WP(float, WS_YP), D, TL, TC, 0, 0};
            pg8::gemm_phase<pg8::EpiY, pg8::HybridOrder>(lds, g, S, E);
            PHASE_END(base + 6); }
        if (EN_S7 && IN(base + 7)) { SITE(); const float* modL = WP(const float, WS_MOD) + (size_t)L * 3 * NMOD; const float* gL = KIN(6) + (size_t)L * 4 * D;
            RN a; a.xin_lat = nullptr; a.xin_ctx = nullptr; a.hin = WP(const bf16_t, WS_H); a.Y = WP(const bf16_t, WS_Y); a.Yp = WP(const float, WS_YP); a.nparts = L < 3 ? SPLIT_FFN2 : 0; a.gate = modL + 5 * D; a.gY = gL + 3 * D; a.modp = nullptr; a.bias = nullptr; a.mod_out = nullptr;
            if (L < 3) { a.hout = WP(bf16_t, WS_H); a.fout = nullptr; a.gN = gL + 4 * D; a.shift = modL + 3 * NMOD; a.scale = modL + 3 * NMOD + D; a.U = WP(bf16_t, WS_U); a.nrows = T;
                resid_norm<true, true, false, false>(a, lds, gw, ngw, tid); }
            else { a.hout = nullptr; a.fout = KOUT(); a.gN = nullptr; a.shift = nullptr; a.scale = nullptr; a.U = nullptr; a.nrows = TL;
                resid_norm<true, false, false, true>(a, lds, gw, ngw, tid); }
            PHASE_END(base + 7); }
    }
#undef IN
#undef PHASE_END
}

extern "C" void kernel_launch(void* const* d_in, const int* in_sizes, int n_in, void* d_out, int out_size, void* d_ws, size_t ws_size, hipStream_t stream) {
    static int grid = 0;
    if (grid == 0) {
        if (n_in != 18 || in_sizes[0] != TL * D || out_size != TL * D || ws_size < WS_END) { fprintf(stderr, "kernel_launch: unexpected shapes (n_in %d, in0 %d, out %d, ws %zu); nothing launched\n", n_in, n_in > 0 ? in_sizes[0] : -1, out_size, ws_size); grid = -1; return; }
        int dev = 0, cus = 0, per_cu = 0;
        if (hipGetDevice(&dev) != hipSuccess || hipDeviceGetAttribute(&cus, hipDeviceAttributeMultiprocessorCount, dev) != hipSuccess) { grid = -1; return; }
        if (hipFuncSetAttribute((const void*)mk_fwd, hipFuncAttributeMaxDynamicSharedMemorySize, LDS_BYTES) != hipSuccess) { fprintf(stderr, "kernel_launch: hipFuncSetAttribute failed\n"); grid = -1; return; }
        if (hipOccupancyMaxActiveBlocksPerMultiprocessor(&per_cu, (const void*)mk_fwd, NTHREADS, LDS_BYTES) != hipSuccess || per_cu < 1) { fprintf(stderr, "kernel_launch: occupancy query says %d blocks per CU\n", per_cu); }
        (void)hipGetLastError();
        grid = cus;
    }
    if (grid < 0) return;
    if (hipMemsetAsync((char*)d_ws + WS_CTL, 0, CTL_ZERO_BYTES, stream) != hipSuccess) return;
    Args a{};
    for (int i = 0; i < 18; ++i) a.in[i] = (const float*)d_in[i];
    a.out = (float*)d_out; a.ws = (unsigned char*)d_ws;
#if MK_PER_PHASE
    for (int p = 0; p < N_PHASES; ++p) { const int k = p - 2, L = k >> 3, s = k & 7; if (p >= 2 && (L & 1) == 0 && s <= 2) continue;
        a.ph_lo = p; a.ph_hi = p + 1; hipLaunchKernelGGL(mk_fwd, dim3(grid), dim3(NTHREADS), LDS_BYTES, stream, a); }
#else
    a.ph_lo = 0; a.ph_hi = N_PHASES; hipLaunchKernelGGL(mk_fwd, dim3(grid), dim3(NTHREADS), LDS_BYTES, stream, a);
#endif
    const hipError_t le = hipPeekAtLastError();
    if (le != hipSuccess) fprintf(stderr, "kernel_launch: launch failed: %s\n", hipGetErrorName(le));
}
```

```cpp
#include <hip/hip_runtime.h>
#include <cstdio>
#include <cstdint>

#ifndef MK_PER_PHASE
#define MK_PER_PHASE 0
#endif

#define LAS __attribute__((address_space(3)))
#define GAS __attribute__((address_space(1)))
typedef unsigned short bf16_t;
typedef short bf16x8 __attribute__((ext_vector_type(8)));
typedef short s16x4 __attribute__((ext_vector_type(4)));
typedef float f32x4 __attribute__((ext_vector_type(4)));
typedef float f32x2 __attribute__((ext_vector_type(2)));
typedef float f32x16 __attribute__((ext_vector_type(16)));
typedef unsigned u32x4 __attribute__((ext_vector_type(4)));
typedef unsigned u32x2 __attribute__((ext_vector_type(2)));

constexpr int D = 2048, SEQ = 8192, NB = 2, CTXL = 256, TL = NB * SEQ, TC = NB * CTXL, T = TL + TC;
constexpr int DFF = 5632, NH = 16, QKD = 192, NOPE = 128, ROPED = 64, VD = 128, QL = 512, KVL = 512;
constexpr int NDQKV = 1280;
constexpr int NQ = NH * QKD, NKV = NH * (NOPE + VD), NUP = NQ + NKV;
constexpr int NMOD = 6 * D;
constexpr float RMS_EPS = 1e-6f;
constexpr int NWAVES = 8, NTHREADS = 512;

__device__ __forceinline__ unsigned cvt_pk_bf16(float lo, float hi) { unsigned r; asm volatile("v_cvt_pk_bf16_f32 %0, %1, %2" : "=v"(r) : "v"(lo), "v"(hi)); return r; }
__device__ __forceinline__ float bf_lo(unsigned w) { return __uint_as_float(w << 16); }
__device__ __forceinline__ float bf_hi(unsigned w) { return __uint_as_float(w & 0xffff0000u); }
__device__ __forceinline__ float wave_sum(float v) {
#pragma unroll
    for (int o = 1; o < 64; o <<= 1) v += __shfl_xor(v, o);
    return v;
}

namespace pg8 {
constexpr int BM = 256, BK = 64, HALF = 128, HTB = HALF * BK * 2, STAGE_BYTES = 8 * HTB, NXCD = 8, WGM = 4;
__host__ __device__ __forceinline__ int lds_byte(int r, int c) { const int st = (r >> 4) * 2 + (c >> 5), rr = r & 15, cc = c & 31, ob = rr * 64 + cc * 2; return st * 1024 + (ob ^ (((ob >> 9) & 1) << 5)); }
__host__ __device__ __forceinline__ void stage_rc(int b, int& R, int& C) { const int st = b / 1024, sb = b % 1024, swz = sb ^ (((sb >> 9) & 1) << 5); R = (st >> 1) * 16 + swz / 64; C = (st & 1) * 32 + (swz % 64) / 2; }
__host__ __device__ __forceinline__ int perm32(int rho) { const int n = rho >> 4, i = rho & 15; return 8 * (i >> 2) + 4 * n + (i & 3); }

struct Unit { int pm, pn, kt0, nkt, part; };
struct Gemm { const bf16_t* A; const bf16_t* Bt; int M, N, K, lda, ldb; };

struct StaticOrder {
    int nM, nN, nwg, G, c, nkt;
    __host__ __device__ void init(int M, int N, int K, int G_, int c_) { nM = M / BM; nN = N / BM; nwg = nM * nN; G = G_; c = c_; nkt = K / BK; }
    __host__ __device__ bool next(int i, Unit& u) const {
        const long L = (long)i * G + c; if (L >= nwg) return false;
        int wgid = (int)L; { const int q = nwg / NXCD, r = nwg % NXCD, xcd = wgid % NXCD, off = wgid / NXCD; wgid = (xcd < r ? xcd * (q + 1) : r * (q + 1) + (xcd - r) * q) + off; }
        const int nig = WGM * nN, gid = wgid / nig, fm = gid * WGM, gsz = (nM - fm) < WGM ? (nM - fm) : WGM;
        u.pm = fm + ((wgid % nig) % gsz); u.pn = (wgid % nig) / gsz; u.kt0 = 0; u.nkt = nkt; u.part = -1; return true;
    }
};
struct HybridOrder {
    StaticOrder full; int nfull, nsplit, S, nktp, nN, pm0, G, c;
    __host__ __device__ void init(int Mfull, int Mtot, int N, int K, int G_, int c_, int S_) { full.init(Mfull, N, K, G_, c_); nfull = full.nwg; nN = N / BM; pm0 = Mfull / BM; S = S_; nktp = (K / BK) / S_;
        nsplit = ((Mtot - Mfull) / BM) * nN * S_; G = G_; c = c_; }
    __host__ __device__ bool next(int i, Unit& u) const {
        const long L = (long)i * G + c; if (L < nfull) return full.next(i, u);
        const int e = (int)(L - nfull); if (e >= nsplit) return false;
        const int part = e % S, tile = e / S; u.pm = pm0 + tile / nN; u.pn = tile % nN; u.kt0 = part * nktp; u.nkt = nktp; u.part = part; return true;
    }
};

template <class Epi, class Sched, bool ALIGN_EPI = true>
__device__ __forceinline__ void gemm_phase(LAS unsigned char* lds, const Gemm g, const Sched& S, const Epi& E) {
    int tid = threadIdx.x; asm volatile("" : "+v"(tid));
    const int wid = __builtin_amdgcn_readfirstlane(tid >> 6), lane = tid & 63, wr = wid >> 2, wc = wid & 3, fr = lane & 15, fq = lane >> 4;
    unsigned voffA[2], voffB[2];
#pragma unroll
    for (int i = 0; i < 2; ++i) { int R, C; stage_rc(tid * 16 + i * 8192, R, C); const int Rb = (R & ~31) + perm32(R & 31);
        voffA[i] = (unsigned)(R * g.lda + C) * 2u; voffB[i] = (unsigned)(Rb * g.ldb + C) * 2u; }
    const size_t kstep = (size_t)(BK * 2);
    const size_t hstepA = (size_t)HALF * g.lda * 2, hstepB = (size_t)HALF * g.ldb * 2;
    const size_t tstepA = 2 * hstepA, tstepB = 2 * hstepB;
    const unsigned ldsw = (unsigned)wid * 1024u;
    const int aoff = lds_byte(wr * 64 + fr, fq * 8), boff = lds_byte(wc * 32 + fr, fq * 8);
#define PG8_SA(b, h) (((b) * 2 + (h)) * HTB)
#define PG8_SB(b, h) ((4 + (b) * 2 + (h)) * HTB)
#define PG8_STAGE(bufoff, gbase, voff) do { _Pragma("unroll") for (int _i = 0; _i < 2; ++_i) \
        __builtin_amdgcn_global_load_lds((const unsigned*)((const char*)(gbase) + (voff)[_i]), (LAS unsigned*)(lds + (bufoff) + ldsw + _i * 8192), 16, 0, 0); } while (0)
#define PG8_LDA(dst, b, h) do { _Pragma("unroll") for (int m = 0; m < 4; ++m) _Pragma("unroll") for (int k = 0; k < 2; ++k) dst[m][k] = *(const LAS bf16x8*)(lds + PG8_SA(b, h) + aoff + m * 2048 + k * 1024); } while (0)
#define PG8_LDB(dst, b, h) do { _Pragma("unroll") for (int n = 0; n < 2; ++n) _Pragma("unroll") for (int k = 0; k < 2; ++k) dst[n][k] = *(const LAS bf16x8*)(lds + PG8_SB(b, h) + boff + n * 2048 + k * 1024); } while (0)
#define PG8_MMA(ai, bj, At, Bt) do { __builtin_amdgcn_s_setprio(1); _Pragma("unroll") for (int m = 0; m < 4; ++m) _Pragma("unroll") for (int n = 0; n < 2; ++n) _Pragma("unroll") for (int k = 0; k < 2; ++k) \
        acc[ai][bj][m][n] = __builtin_amdgcn_mfma_f32_16x16x32_bf16(Bt[n][k], At[m][k], acc[ai][bj][m][n], 0, 0, 0); __builtin_amdgcn_s_setprio(0); } while (0)
#define PG8_WAIT_V(n) asm volatile("s_waitcnt vmcnt(" #n ")" ::: "memory")
#define PG8_WAIT_L(n) asm volatile("s_waitcnt lgkmcnt(" #n ")" ::: "memory")
#define PG8_BAR __builtin_amdgcn_s_barrier()
#define PG8_SCHED __builtin_amdgcn_sched_barrier(0)
    Unit cur, nxt; int ui = 0;
    if (!S.next(0, cur)) return;
    f32x4 acc[2][2][4][2];
#pragma unroll
    for (int a = 0; a < 2; ++a)
#pragma unroll
        for (int b = 0; b < 2; ++b)
#pragma unroll
            for (int m = 0; m < 4; ++m)
#pragma unroll
                for (int n = 0; n < 2; ++n) acc[a][b][m][n] = (f32x4){0.f, 0.f, 0.f, 0.f};
    bf16x8 At[4][2], B0[2][2], B1[2][2];
    const char* cA = (const char*)g.A + (size_t)cur.pm * tstepA + (size_t)E.a_off(cur.pn) * 2 + (size_t)cur.kt0 * kstep; const char* cB = (const char*)g.Bt + (size_t)cur.pn * tstepB + (size_t)cur.kt0 * kstep;
    PG8_STAGE(PG8_SB(0, 0), cB, voffB); PG8_STAGE(PG8_SB(0, 1), cB + hstepB, voffB); PG8_STAGE(PG8_SA(0, 0), cA, voffA); PG8_STAGE(PG8_SA(0, 1), cA + hstepA, voffA);
    if (wr == 1) PG8_BAR;
    PG8_WAIT_V(2); PG8_BAR;
    PG8_STAGE(PG8_SB(1, 0), cB + kstep, voffB); PG8_STAGE(PG8_SA(1, 0), cA + kstep, voffA); PG8_STAGE(PG8_SB(1, 1), cB + hstepB + kstep, voffB);
    PG8_WAIT_V(6); PG8_BAR;
    for (;;) {
        const bool has_next = S.next(ui + 1, nxt);
        const char* nA = has_next ? (const char*)g.A + (size_t)nxt.pm * tstepA + (size_t)E.a_off(nxt.pn) * 2 + (size_t)nxt.kt0 * kstep : cA; const char* nB = has_next ? (const char*)g.Bt + (size_t)nxt.pn * tstepB + (size_t)nxt.kt0 * kstep : cB;
        const int nt = cur.nkt;
        asm volatile(".p2align 6");
        for (int t = 0; t < nt; t += 2) {
            const bool last = (t == nt - 2);
            const char* a1 = cA + (size_t)(t + 1) * kstep;
            const char* a2 = last ? nA : cA + (size_t)(t + 2) * kstep; const char* b2 = last ? nB : cB + (size_t)(t + 2) * kstep;
            const char* a3 = a2 + kstep; const char* b3 = b2 + kstep;
            PG8_LDB(B0, 0, 0); PG8_LDB(B1, 0, 1); PG8_SCHED; PG8_LDA(At, 0, 0); PG8_STAGE(PG8_SA(1, 1), a1 + hstepA, voffA);
            PG8_WAIT_V(8); PG8_WAIT_L(0); PG8_BAR; PG8_MMA(0, 0, At, B0); PG8_MMA(0, 1, At, B1); PG8_BAR; PG8_SCHED;
            PG8_LDA(At, 0, 1); PG8_STAGE(PG8_SB(0, 0), b2, voffB); PG8_STAGE(PG8_SB(0, 1), b2 + hstepB, voffB); PG8_STAGE(PG8_SA(0, 0), a2, voffA);
            PG8_WAIT_V(8); PG8_WAIT_L(0); PG8_BAR; PG8_MMA(1, 0, At, B0); PG8_MMA(1, 1, At, B1); PG8_BAR; PG8_SCHED;
            PG8_LDB(B0, 1, 0); PG8_LDB(B1, 1, 1); PG8_SCHED; PG8_LDA(At, 1, 0); PG8_STAGE(PG8_SA(0, 1), a2 + hstepA, voffA);
            PG8_WAIT_V(8); PG8_WAIT_L(0); PG8_BAR; PG8_MMA(0, 0, At, B0); PG8_MMA(0, 1, At, B1); PG8_BAR; PG8_SCHED;
            PG8_LDA(At, 1, 1); PG8_STAGE(PG8_SB(1, 0), b3, voffB); PG8_STAGE(PG8_SB(1, 1), b3 + hstepB, voffB); PG8_STAGE(PG8_SA(1, 0), a3, voffA);
            PG8_WAIT_V(8); PG8_WAIT_L(0); PG8_BAR; PG8_MMA(1, 0, At, B0); PG8_MMA(1, 1, At, B1); PG8_BAR; PG8_SCHED;
        }
        if constexpr (ALIGN_EPI) { if (wr == 0) PG8_BAR; }
        E(acc, cur, wr, wc, fr, fq);
        if (!has_next) break;
#pragma unroll
        for (int a = 0; a < 2; ++a)
#pragma unroll
            for (int b = 0; b < 2; ++b)
#pragma unroll
                for (int m = 0; m < 4; ++m)
#pragma unroll
                    for (int n = 0; n < 2; ++n) acc[a][b][m][n] = (f32x4){0.f, 0.f, 0.f, 0.f};
        cur = nxt; cA = nA; cB = nB; ++ui;
        if constexpr (ALIGN_EPI) { if (wr == 1) PG8_BAR; }
    }
    PG8_WAIT_V(0);
    if constexpr (!ALIGN_EPI) { if (wr == 0) PG8_BAR; }
    PG8_BAR;
#undef PG8_SA
#undef PG8_SB
#undef PG8_STAGE
#undef PG8_LDA
#undef PG8_LDB
#undef PG8_MMA
#undef PG8_WAIT_V
#undef PG8_WAIT_L
#undef PG8_BAR
#undef PG8_SCHED
}

#ifndef EPI_SC1
#define EPI_SC1 0
#endif
__device__ __forceinline__ void st16(void* p, u32x4 w) {
#if EPI_SC1
    asm volatile("global_store_dwordx4 %0, %1, off sc1\n\ts_nop 1" :: "v"(p), "v"(w) : "memory");
#else
    *(u32x4*)p = w;
#endif
}
struct EpiStore {
    bf16_t* O; int ldc; float* ssq0; float* ssq1; int split0, split1; int a_grp_tiles, a_grp_off;
    __device__ __forceinline__ int a_off(int pn) const { return a_grp_tiles ? (pn / a_grp_tiles) * a_grp_off : 0; }
    __device__ __forceinline__ void operator()(const f32x4 (&acc)[2][2][4][2], const Unit& u, int wr, int wc, int fr, int fq) const {
        const int row0 = u.pm * BM + wr * 64 + fr, col0 = u.pn * BM + wc * 32 + 8 * fq;
        float* ssq = u.pn < split0 ? ssq0 : (u.pn < split1 ? ssq1 : nullptr);
#pragma unroll
        for (int ai = 0; ai < 2; ++ai)
#pragma unroll
            for (int m = 0; m < 4; ++m) { const int row = row0 + ai * HALF + m * 16; bf16_t* rowp = O + (size_t)row * ldc + col0; float s = 0.f;
#pragma unroll
                for (int bj = 0; bj < 2; ++bj) { const f32x4 v0 = acc[ai][bj][m][0], v1 = acc[ai][bj][m][1];
                    s += (v0[0] * v0[0] + v0[1] * v0[1]) + (v0[2] * v0[2] + v0[3] * v0[3]) + (v1[0] * v1[0] + v1[1] * v1[1]) + (v1[2] * v1[2] + v1[3] * v1[3]);
                    u32x4 w; w.x = cvt_pk_bf16(v0[0], v0[1]); w.y = cvt_pk_bf16(v0[2], v0[3]); w.z = cvt_pk_bf16(v1[0], v1[1]); w.w = cvt_pk_bf16(v1[2], v1[3]);
                    st16(rowp + bj * HALF, w); }
                if (ssq) { s += __shfl_xor(s, 16); s += __shfl_xor(s, 32); if (fq == 0) ssq[(size_t)row * 8 + (u.pn & 1) * 4 + wc] = s; } }
    }
};
struct EpiY {
    bf16_t* O; float* Yp; int ldc, row_split, nsplit_rows; int a_grp_tiles, a_grp_off;
    __device__ __forceinline__ int a_off(int pn) const { return a_grp_tiles ? (pn / a_grp_tiles) * a_grp_off : 0; }
    __device__ __forceinline__ void operator()(const f32x4 (&acc)[2][2][4][2], const Unit& u, int wr, int wc, int fr, int fq) const {
        const int row0 = u.pm * BM + wr * 64 + fr, col0 = u.pn * BM + wc * 32 + 8 * fq;
        if (u.part < 0) {
#pragma unroll
            for (int ai = 0; ai < 2; ++ai)
#pragma unroll
                for (int m = 0; m < 4; ++m) { bf16_t* rowp = O + (size_t)(row0 + ai * HALF + m * 16) * ldc + col0;
#pragma unroll
                    for (int bj = 0; bj < 2; ++bj) { const f32x4 v0 = acc[ai][bj][m][0], v1 = acc[ai][bj][m][1];
                        u32x4 w; w.x = cvt_pk_bf16(v0[0], v0[1]); w.y = cvt_pk_bf16(v0[2], v0[3]); w.z = cvt_pk_bf16(v1[0], v1[1]); w.w = cvt_pk_bf16(v1[2], v1[3]);
                        st16(rowp + bj * HALF, w); } }
        } else { float* slab = Yp + (size_t)u.part * nsplit_rows * ldc;
#pragma unroll
            for (int ai = 0; ai < 2; ++ai)
#pragma unroll
                for (int m = 0; m < 4; ++m) { float* rowp = slab + (size_t)(row0 + ai * HALF + m * 16 - row_split) * ldc + col0;
#pragma unroll
                    for (int bj = 0; bj < 2; ++bj) { *(f32x4*)(rowp + bj * HALF) = acc[ai][bj][m][0]; *(f32x4*)(rowp + bj * HALF + 4) = acc[ai][bj][m][1]; } }
        }
    }
};
struct EpiSwiGLU {
    bf16_t* O; int ldc;
    __device__ __forceinline__ int a_off(int) const { return 0; }
    __device__ __forceinline__ void operator()(const f32x4 (&acc)[2][2][4][2], const Unit& u, int wr, int wc, int fr, int fq) const {
        const int row0 = u.pm * BM + wr * 64 + fr, col0 = u.pn * HALF + wc * 32 + 8 * fq;
#pragma unroll
        for (int ai = 0; ai < 2; ++ai)
#pragma unroll
            for (int m = 0; m < 4; ++m) { const int row = row0 + ai * HALF + m * 16; float gv[8];
#pragma unroll
                for (int n = 0; n < 2; ++n)
#pragma unroll
                    for (int j = 0; j < 4; ++j) { const float a = acc[ai][0][m][n][j], b = acc[ai][1][m][n][j]; gv[n * 4 + j] = a * __builtin_amdgcn_rcpf(1.f + __expf(-a)) * b; }
                u32x4 w; w.x = cvt_pk_bf16(gv[0], gv[1]); w.y = cvt_pk_bf16(gv[2], gv[3]); w.z = cvt_pk_bf16(gv[4], gv[5]); w.w = cvt_pk_bf16(gv[6], gv[7]);
                st16(O + (size_t)row * ldc + col0, w); }
    }
};
struct EpiUp {
    bf16_t* Q; bf16_t* KV; const float* ssq_q; const float* ssq_kv;
    __device__ __forceinline__ int a_off(int pn) const { return pn < NQ / BM ? 0 : QL; }
    __device__ __forceinline__ void operator()(const f32x4 (&acc)[2][2][4][2], const Unit& u, int wr, int wc, int fr, int fq) const {
        const bool isq = u.pn < NQ / BM; const int ldc = isq ? NQ : NKV; bf16_t* O = isq ? Q : KV; const float* ssq = isq ? ssq_q : ssq_kv;
        const int row0 = u.pm * BM + wr * 64 + fr, col0 = (isq ? u.pn : u.pn - NQ / BM) * BM + wc * 32 + 8 * fq;
        float rs[2][4];
#pragma unroll
        for (int ai = 0; ai < 2; ++ai)
#pragma unroll
            for (int m = 0; m < 4; ++m) { const int row = row0 + ai * HALF + m * 16;
                const f32x4 sa = *(const f32x4*)(ssq + (size_t)row * 8), sb = *(const f32x4*)(ssq + (size_t)row * 8 + 4);
                rs[ai][m] = __builtin_amdgcn_rsqf((((sa[0] + sa[1]) + (sa[2] + sa[3])) + ((sb[0] + sb[1]) + (sb[2] + sb[3]))) * (1.f / 512.f) + RMS_EPS); }
#pragma unroll
        for (int ai = 0; ai < 2; ++ai)
#pragma unroll
            for (int m = 0; m < 4; ++m) { const int row = row0 + ai * HALF + m * 16; bf16_t* rowp = O + (size_t)row * ldc + col0;
#pragma unroll
                for (int bj = 0; bj < 2; ++bj) { const f32x4 v0 = acc[ai][bj][m][0] * rs[ai][m], v1 = acc[ai][bj][m][1] * rs[ai][m];
                    u32x4 w; w.x = cvt_pk_bf16(v0[0], v0[1]); w.y = cvt_pk_bf16(v0[2], v0[3]); w.z = cvt_pk_bf16(v1[0], v1[1]); w.w = cvt_pk_bf16(v1[2], v1[3]);
                    st16(rowp + bj * HALF, w); } }
    }
};
}
namespace att {
constexpr int QBLK = 32, KVBLK = 64;
constexpr float SCALE = 0.07216878364870322f;
constexpr float THR = 8.f;
#ifndef ATT_SDEPTH
#define ATT_SDEPTH 1
#endif
constexpr int SDEPTH = ATT_SDEPTH;
constexpr int SHM_V = KVBLK * VD * 2, SHM_K = KVBLK * QKD * 2;
constexpr int LDS_BYTES = 2 * SHM_V + 2 * SHM_K + NWAVES * 64 * 4;
#define KOFF(row, ch) ((row) * 384 + ((((ch) ^ (((row) >> 1) & 7))) << 4))
#define SBAR() __builtin_amdgcn_sched_barrier(0)
__device__ __forceinline__ int crow(int r, int hi) { return (r & 3) + 8 * (r >> 2) + 4 * hi; }

__device__ __forceinline__ void finishSM(f32x16& p0, f32x16& p1, float alpha, float& l_reg, bf16x8& pa0, bf16x8& pa1, bf16x8& pa2, bf16x8& pa3) {
#pragma unroll
    for (int r = 0; r < 16; ++r) p1[r] = __builtin_amdgcn_exp2f(p1[r]);
    float ps = 0;
#pragma unroll
    for (int r = 0; r < 16; ++r) ps += p0[r];
#pragma unroll
    for (int r = 0; r < 16; ++r) ps += p1[r];
    { auto rr = __builtin_amdgcn_permlane32_swap(__float_as_uint(ps), __float_as_uint(ps), false, false);
      ps = __uint_as_float(rr[0]) + __uint_as_float(rr[1]); }
    l_reg = l_reg * alpha + ps;
#define PK8(P, BASE, OUT) do { u32x4 w = {cvt_pk_bf16(P[BASE + 0], P[BASE + 1]), cvt_pk_bf16(P[BASE + 2], P[BASE + 3]), cvt_pk_bf16(P[BASE + 4], P[BASE + 5]), cvt_pk_bf16(P[BASE + 6], P[BASE + 7])}; \
    OUT = *reinterpret_cast<bf16x8*>(&w); } while (0)
    PK8(p0, 0, pa0); PK8(p0, 8, pa1); PK8(p1, 0, pa2); PK8(p1, 8, pa3);
#undef PK8
}
__device__ __forceinline__ int v_st(int k, int c) { const int kk = (k & ~0xC) | ((k & 4) << 1) | ((k & 8) >> 1); return ((kk >> 3) * 4 + (c >> 5)) * 512 + ((kk & 7) * 32 + (c & 31)) * 2; }
__device__ __forceinline__ int v_rd_base(int lane) { return ((lane & 3) << 3) | (((lane >> 2) & 3) << 6) | (((lane >> 4) & 1) << 5) | (((lane >> 5) & 1) << 8); }
constexpr int v_rd_off(int d0, int ks, int half) { return d0 * 512 + ks * 4096 + half * 2048; }
template <int OFF> __device__ __forceinline__ s16x4 tr_read(int vb) {
    s16x4 r; asm volatile("ds_read_b64_tr_b16 %0, %1 offset:%2" : "=&v"(r) : "v"(vb), "i"(OFF) : "memory"); return r;
}
template <int D0> __device__ __forceinline__ void pv_one(f32x16& od, int vb, bf16x8 pa0, bf16x8 pa1, bf16x8 pa2, bf16x8 pa3) {
    const s16x4 l0 = tr_read<v_rd_off(D0, 0, 0)>(vb), h0 = tr_read<v_rd_off(D0, 0, 1)>(vb), l1 = tr_read<v_rd_off(D0, 1, 0)>(vb), h1 = tr_read<v_rd_off(D0, 1, 1)>(vb);
    const s16x4 l2 = tr_read<v_rd_off(D0, 2, 0)>(vb), h2 = tr_read<v_rd_off(D0, 2, 1)>(vb), l3 = tr_read<v_rd_off(D0, 3, 0)>(vb), h3 = tr_read<v_rd_off(D0, 3, 1)>(vb);
    asm volatile("s_waitcnt lgkmcnt(0)" ::: "memory"); SBAR();
#define PK(L, H) (bf16x8){L[0], L[1], L[2], L[3], H[0], H[1], H[2], H[3]}
    od = __builtin_amdgcn_mfma_f32_32x32x16_bf16(pa0, PK(l0, h0), od, 0, 0, 0);
    od = __builtin_amdgcn_mfma_f32_32x32x16_bf16(pa1, PK(l1, h1), od, 0, 0, 0);
    od = __builtin_amdgcn_mfma_f32_32x32x16_bf16(pa2, PK(l2, h2), od, 0, 0, 0);
    od = __builtin_amdgcn_mfma_f32_32x32x16_bf16(pa3, PK(l3, h3), od, 0, 0, 0);
#undef PK
}
__device__ __forceinline__ void pv_d0(f32x16* o, int vb, bf16x8 pa0, bf16x8 pa1, bf16x8 pa2, bf16x8 pa3) {
    pv_one<0>(o[0], vb, pa0, pa1, pa2, pa3); pv_one<1>(o[1], vb, pa0, pa1, pa2, pa3); pv_one<2>(o[2], vb, pa0, pa1, pa2, pa3); pv_one<3>(o[3], vb, pa0, pa1, pa2, pa3);
}
__device__ __forceinline__ void rope8(bf16x8& x1, bf16x8& x2, const float* tab) {
    u32x4 a = *reinterpret_cast<u32x4*>(&x1), b = *reinterpret_cast<u32x4*>(&x2), oa, ob;
#pragma unroll
    for (int w = 0; w < 4; ++w) {
        const f32x4 cs = *reinterpret_cast<const f32x4*>(tab + 4 * w);
        const float a0 = bf_lo(a[w]), a1 = bf_hi(a[w]), b0 = bf_lo(b[w]), b1 = bf_hi(b[w]);
        oa[w] = cvt_pk_bf16(a0 * cs[0] - b0 * cs[1], a1 * cs[2] - b1 * cs[3]);
        ob[w] = cvt_pk_bf16(b0 * cs[0] + a0 * cs[1], b1 * cs[2] + a1 * cs[3]);
    }
    x1 = *reinterpret_cast<bf16x8*>(&oa); x2 = *reinterpret_cast<bf16x8*>(&ob);
}

struct Unit { const bf16_t* Qb; const bf16_t* KVh; bf16_t* Ob; int kb_lat, nt_lat, kb_ctx, NT, qpos0; };

constexpr int SLOT = 40960, KR_OFF = 16384, V_OFF = 24576, LDS2_BYTES = 3 * SLOT + NWAVES * 64 * 4;
constexpr float THRL = THR * 1.4426950408889634f;
#ifndef ATT_MARGIN
#define ATT_MARGIN 100.f
#endif
__device__ __forceinline__ void qkt2n(f32x16& p0, f32x16& p1, LAS const char* lds, int kn, int kr, const bf16x8* qr, const f32x16& negm) {
#pragma unroll
    for (int d0 = 0; d0 < 8; ++d0) { const int a = kn ^ (d0 << 5);
        const bf16x8 b0 = *reinterpret_cast<LAS const bf16x8*>(lds + a), b1 = *reinterpret_cast<LAS const bf16x8*>(lds + a + 32 * 256);
        if (d0 == 0) { p0 = __builtin_amdgcn_mfma_f32_32x32x16_bf16(b0, qr[0], negm, 0, 0, 0); p1 = __builtin_amdgcn_mfma_f32_32x32x16_bf16(b1, qr[0], negm, 0, 0, 0); }
        else { p0 = __builtin_amdgcn_mfma_f32_32x32x16_bf16(b0, qr[d0], p0, 0, 0, 0); p1 = __builtin_amdgcn_mfma_f32_32x32x16_bf16(b1, qr[d0], p1, 0, 0, 0); } }
#pragma unroll
    for (int d0 = 0; d0 < 4; ++d0) { const int a = kr ^ (d0 << 5);
        const bf16x8 b0 = *reinterpret_cast<LAS const bf16x8*>(lds + a), b1 = *reinterpret_cast<LAS const bf16x8*>(lds + a + 32 * 128);
        p0 = __builtin_amdgcn_mfma_f32_32x32x16_bf16(b0, qr[8 + d0], p0, 0, 0, 0); p1 = __builtin_amdgcn_mfma_f32_32x32x16_bf16(b1, qr[8 + d0], p1, 0, 0, 0); }
}
template <bool FIRST>
__device__ __forceinline__ void partialSM2(f32x16& p0, f32x16& p1, float& m_reg, f32x16& negm, float& alpha, float margin = 0.f) {
    float pmax = p0[0];
#pragma unroll
    for (int r = 1; r < 16; ++r) pmax = fmaxf(pmax, p0[r]);
#pragma unroll
    for (int r = 0; r < 16; ++r) pmax = fmaxf(pmax, p1[r]);
    { auto rr = __builtin_amdgcn_permlane32_swap(__float_as_uint(pmax), __float_as_uint(pmax), false, false);
      pmax = fmaxf(__uint_as_float(rr[0]), __uint_as_float(rr[1])); }
    alpha = 1.f;
    if (FIRST || !__builtin_expect(__all(pmax <= THRL), 1)) {
        const float delta = FIRST ? pmax + margin : fmaxf(pmax, 0.f);
        if (!FIRST) alpha = __builtin_amdgcn_exp2f(-delta);
        m_reg += delta;
#pragma unroll
        for (int r = 0; r < 16; ++r) { p0[r] -= delta; p1[r] -= delta; negm[r] = -m_reg; }
    }
#pragma unroll
    for (int r = 0; r < 16; ++r) p0[r] = __builtin_amdgcn_exp2f(p0[r]);
}
__device__ __forceinline__ void exp_half(f32x16& p0) {
#pragma unroll
    for (int r = 0; r < 16; ++r) p0[r] = __builtin_amdgcn_exp2f(p0[r]);
}
template <bool FIXM>
__device__ __forceinline__ void attn_unit6(const Unit& U, const bf16_t* __restrict__ KR, const float* __restrict__ ropetab, LAS unsigned char* lds) {
    int tid = threadIdx.x; asm volatile("" : "+v"(tid));
    const int wid = __builtin_amdgcn_readfirstlane(tid >> 6), lane = tid & 63, r32 = lane & 31, hi = lane >> 5;
    LAS float* wsf = (LAS float*)(lds + 3 * SLOT) + wid * 64; LAS float* li_l = wsf; LAS float* al_l = wsf + 32;
    float m_reg = 0.f, l_reg = 0; f32x16 o[4] = {}; bf16x8 qr[12]; f32x16 negm = {};
    const bf16_t* Qw = U.Qb + (size_t)(wid * QBLK + r32) * NQ + hi * 8;
#pragma unroll
    for (int d0 = 0; d0 < 12; ++d0) qr[d0] = *reinterpret_cast<const bf16x8*>(Qw + d0 * 16);
    if (U.qpos0 >= 0) { const int t = U.qpos0 + wid * QBLK + r32, pr = t >> 6, pc = t & 63;
        rope8(qr[8], qr[9], ropetab + (pr * 16 + hi * 8) * 2); rope8(qr[10], qr[11], ropetab + (pc * 16 + hi * 8) * 2); }
    unsigned von[2], vov[2], vor;
#pragma unroll
    for (int i = 0; i < 2; ++i) { const int p = (wid * 2 + i) * 64 + lane;
        { const int row = p >> 4, c = (p & 15) ^ (row & 15); von[i] = (unsigned)(row * (NKV * 2) + c * 16); }
        { const int sub = p >> 5, within = p & 31, k = (sub >> 2) * 8 + (within >> 2), c = (sub & 3) * 32 + (within & 3) * 8;     vov[i] = (unsigned)(k * (NKV * 2) + NOPE * 2 + c * 2); } }
    { const int p = wid * 64 + lane, row = p >> 3, c = (p & 7) ^ ((row >> 1) & 7); vor = (unsigned)(row * (ROPED * 2) + c * 16); }
    const int kn0 = r32 * 256 + ((hi ^ (r32 & 15)) << 4), kr0 = KR_OFF + r32 * 128 + ((hi ^ ((r32 >> 1) & 7)) << 4), vb0 = (int)(uintptr_t)lds + V_OFF + v_rd_base(lane);
    const int nt_lat = U.nt_lat, kb_lat = U.kb_lat, kb_ctx = U.kb_ctx - 64 * nt_lat, NT = U.NT;
    const bf16_t* KVh = U.KVh;
    const unsigned ldsw2 = (unsigned)wid * 2048u, ldsw1 = (unsigned)wid * 1024u;
#define KROW(j) (((j) < nt_lat ? kb_lat : kb_ctx) + 64 * (j))
#define DMA(j, so) do { const size_t _k = (size_t)KROW(j); const char* _kv = (const char*)KVh + _k * (NKV * 2); const char* _kr = (const char*)KR + _k * (ROPED * 2); \
    __builtin_amdgcn_global_load_lds((const unsigned*)(_kv + von[0]), (LAS unsigned*)(lds + (so) + ldsw2), 16, 0, 0); \
    __builtin_amdgcn_global_load_lds((const unsigned*)(_kv + von[1]), (LAS unsigned*)(lds + (so) + ldsw2 + 1024), 16, 0, 0); \
    __builtin_amdgcn_global_load_lds((const unsigned*)(_kr + vor), (LAS unsigned*)(lds + (so) + KR_OFF + ldsw1), 16, 0, 0); \
    __builtin_amdgcn_global_load_lds((const unsigned*)(_kv + vov[0]), (LAS unsigned*)(lds + (so) + V_OFF + ldsw2), 16, 0, 0); \
    __builtin_amdgcn_global_load_lds((const unsigned*)(_kv + vov[1]), (LAS unsigned*)(lds + (so) + V_OFF + ldsw2 + 1024), 16, 0, 0); } while (0)
#define TILE_BAR() asm volatile("s_waitcnt vmcnt(0) lgkmcnt(0)\n\ts_barrier" ::: "memory")
#define RESC2(a) do { if (__any((a) < 1.f)) { if (hi == 0) al_l[r32] = (a); asm volatile("s_waitcnt lgkmcnt(0)" ::: "memory"); \
    _Pragma("unroll") for (int d = 0; d < 4; ++d) _Pragma("unroll") for (int r = 0; r < 16; ++r) o[d][r] *= al_l[crow(r, hi)]; } } while (0)
    f32x16 pA0, pA1, pB0, pB1; float alA, alB; bf16x8 pa0, pa1, pa2, pa3;
    int s_prev = 0, s_cur = SLOT, s_next = 2 * SLOT;
    DMA(0, 0); DMA(1, SLOT); TILE_BAR();
    qkt2n(pA0, pA1, (LAS const char*)lds, kn0, kr0, qr, negm); partialSM2<true>(pA0, pA1, m_reg, negm, alA, FIXM ? ATT_MARGIN : 0.f);
    asm volatile(".p2align 6");
    for (int j = 1; j + 1 < NT; j += 2) {
        DMA(j + 1, s_next); SBAR();
        qkt2n(pB0, pB1, (LAS const char*)lds, kn0 + s_cur, kr0 + s_cur, qr, negm);
        finishSM(pA0, pA1, alA, l_reg, pa0, pa1, pa2, pa3); SBAR();
        pv_d0(o, vb0 + s_prev, pa0, pa1, pa2, pa3); if (FIXM) { alB = 1.f; exp_half(pB0); } else partialSM2<false>(pB0, pB1, m_reg, negm, alB);
        if (!FIXM) RESC2(alB); TILE_BAR();
        { const int t = s_prev; s_prev = s_cur; s_cur = s_next; s_next = t; }
        if (j + 2 < NT) DMA(j + 2, s_next); SBAR();
        qkt2n(pA0, pA1, (LAS const char*)lds, kn0 + s_cur, kr0 + s_cur, qr, negm);
        finishSM(pB0, pB1, alB, l_reg, pa0, pa1, pa2, pa3); SBAR();
        pv_d0(o, vb0 + s_prev, pa0, pa1, pa2, pa3); if (FIXM) { alA = 1.f; exp_half(pA0); } else partialSM2<false>(pA0, pA1, m_reg, negm, alA);
        if (!FIXM) RESC2(alA); TILE_BAR();
        { const int t = s_prev; s_prev = s_cur; s_cur = s_next; s_next = t; }
    }
    SBAR(); qkt2n(pB0, pB1, (LAS const char*)lds, kn0 + s_cur, kr0 + s_cur, qr, negm);
    finishSM(pA0, pA1, alA, l_reg, pa0, pa1, pa2, pa3); SBAR();
    pv_d0(o, vb0 + s_prev, pa0, pa1, pa2, pa3); if (FIXM) { alB = 1.f; exp_half(pB0); } else partialSM2<false>(pB0, pB1, m_reg, negm, alB);
    if (!FIXM) RESC2(alB);
    finishSM(pB0, pB1, alB, l_reg, pa0, pa1, pa2, pa3); SBAR();
    pv_d0(o, vb0 + s_cur, pa0, pa1, pa2, pa3);
    if (FIXM) { const bool okl = (l_reg > 0.f) && (l_reg < 1e30f); const bool okw = __all(okl); if (lane == 0) ((LAS unsigned*)(lds + LDS2_BYTES))[wid] = okw ? 1u : 0u; }
    if (hi == 0) li_l[r32] = l_reg; asm volatile("s_waitcnt lgkmcnt(0)" ::: "memory");
    float rli[16];
#pragma unroll
    for (int r = 0; r < 16; ++r) rli[r] = __builtin_amdgcn_rcpf(li_l[crow(r, hi)]);
    asm volatile("s_waitcnt lgkmcnt(0)\n\ts_barrier" ::: "memory");
    { constexpr int OP = 272; LAS unsigned char* st = lds + wid * (32 * OP);
#pragma unroll
      for (int r = 0; r < 16; ++r) { const int orow = crow(r, hi);
#pragma unroll
        for (int d0 = 0; d0 < 4; ++d0) *(LAS bf16_t*)(st + orow * OP + (d0 * 32 + r32) * 2) = (bf16_t)(cvt_pk_bf16(o[d0][r] * rli[r], 0.f) & 0xffffu); }
      asm volatile("s_waitcnt lgkmcnt(0)" ::: "memory");
      bf16_t* Ow = U.Ob + (size_t)(wid * QBLK) * D;
#pragma unroll
      for (int i = 0; i < 8; ++i) { const int row = (lane >> 4) + 4 * i, ch = lane & 15;
        const u32x4 w = *(const LAS u32x4*)(st + row * OP + ch * 16); *(u32x4*)(Ow + (size_t)row * D + ch * 8) = w; } }
    TILE_BAR();
#undef KROW
#undef DMA
#undef TILE_BAR
#undef RESC2
}


#ifndef ATT_FAST_FIRST
#define ATT_FAST_FIRST 1
#endif
#ifndef ATT_FORCE_SAFE
#define ATT_FORCE_SAFE 0
#endif
__device__ __forceinline__ void attn_unit_auto(const Unit& U, const bf16_t* __restrict__ KR, const float* __restrict__ ropetab, LAS unsigned char* lds) {
#if ATT_FAST_FIRST
    attn_unit6<true>(U, KR, ropetab, lds);
    const LAS unsigned* fl = (const LAS unsigned*)(lds + LDS2_BYTES);
    unsigned okc = 0; for (int w = 0; w < NWAVES; ++w) okc += fl[w];
    if (ATT_FORCE_SAFE || __builtin_amdgcn_readfirstlane(okc) != (unsigned)NWAVES) attn_unit6<false>(U, KR, ropetab, lds);
#else
    attn_unit6<false>(U, KR, ropetab, lds);
#endif
}
}
constexpr size_t MiB = 1u << 20;
constexpr int CW_TMO = 0, CW_BAR = 4096;
constexpr int KSPL = 16;
constexpr size_t WS_CTL = 0;
constexpr size_t WS_MOD = 64 * 1024;
constexpr size_t WS_SSQ = 1 * MiB;
constexpr size_t CTL_ZERO_BYTES = 64 * 1024;
constexpr size_t WS_ROPE = 3 * MiB;
constexpr size_t WS_W13 = 4 * MiB;
constexpr size_t WS_W2 = 180 * MiB;
constexpr size_t WS_WPOOL = 268 * MiB;
constexpr size_t WS_WDQKV = 272 * MiB;
constexpr size_t WS_WUP = 282 * MiB;
constexpr size_t WS_WO = 296 * MiB;
constexpr size_t WS_H = 312 * MiB;
constexpr size_t WS_U = 444 * MiB;
constexpr size_t WS_Y = 510 * MiB;
constexpr size_t WS_P = 576 * MiB;
constexpr size_t WS_G = 642 * MiB;
constexpr size_t WS_CQKV = 824 * MiB;
constexpr size_t WS_Q = 866 * MiB;
constexpr size_t WS_KV = 965 * MiB;
constexpr size_t WS_KR = 1097 * MiB;
constexpr size_t WS_YP = 1100 * MiB;
constexpr size_t WS_MODP2 = 1148 * MiB;
constexpr size_t WS_END = 1176 * MiB;
static_assert(WS_W13 + (size_t)4 * 11264 * 2048 * 2 <= WS_W2 && WS_W2 + (size_t)4 * 2048 * 5632 * 2 <= WS_WPOOL && WS_H + (size_t)T * D * 4 <= WS_U && WS_U + (size_t)T * D * 2 <= WS_Y, "ws map");
static_assert(WS_G + (size_t)T * DFF * 2 <= WS_CQKV && WS_CQKV + (size_t)T * NDQKV * 2 <= WS_Q && WS_Q + (size_t)T * NQ * 2 <= WS_KV && WS_KV + (size_t)T * NKV * 2 <= WS_KR && WS_KR + (size_t)T * ROPED * 2 <= WS_YP && WS_YP + (size_t)11 * TC * D * 4 <= WS_MODP2 && WS_MODP2 + (size_t)3 * 64 * 3 * NMOD * 4 <= WS_END, "ws map");
static_assert(WS_MOD + (size_t)4 * 3 * NMOD * 4 <= WS_SSQ && WS_SSQ + (size_t)16 * T * 4 <= WS_ROPE && (CW_BAR + 3456) * 4 <= (int)CTL_ZERO_BYTES, "ctl map");

constexpr int RING_BYTES = 131072, MISC_OFF = RING_BYTES, LDS_BYTES = 147456;
static_assert(att::LDS_BYTES <= RING_BYTES && att::LDS2_BYTES + 64 <= RING_BYTES, "attention LDS");

#define XB_TMO      128
#define XB_XCNT(j)  (256  + 64 * (j))
#define XB_XSUB(j)  (1280 + 64 * (j))
#define XB_XGEN(j)  (2304 + 64 * (j))
#define XB_TOP      3328
#define XB_TOPGEN   3392
#define XCD_BAR_WORDS 3456
#define XB_SPIN_CAP (1u << 22)
__device__ __forceinline__ unsigned xb_ld(unsigned* p)              { return __hip_atomic_load(p, __ATOMIC_RELAXED, __HIP_MEMORY_SCOPE_AGENT); }
__device__ __forceinline__ unsigned xb_add(unsigned* p, unsigned v) { return __hip_atomic_fetch_add(p, v, __ATOMIC_RELAXED, __HIP_MEMORY_SCOPE_AGENT); }
__device__ __forceinline__ unsigned xb_xcc_id() { return (unsigned)__builtin_amdgcn_s_getreg((3 << 11) | 20) & 0xFu; }
#define XB_SPIN(cond, bar) do { unsigned _sp = 0; while (cond) { __builtin_amdgcn_s_sleep(1); \
    if ((++_sp & 255u) == 0u) { if (xb_ld(&(bar)[XB_TMO])) break; if (_sp > XB_SPIN_CAP) { atomicAdd(&(bar)[XB_TMO], 1u); break; } } } } while (0)
struct XcdBarrier { unsigned* bar; unsigned x; volatile LAS unsigned* st; };
__device__ __forceinline__ XcdBarrier xcd_barrier_post(unsigned* bar, volatile LAS unsigned* st) {
    XcdBarrier b; b.bar = bar; b.x = xb_xcc_id(); b.st = st;
    if (threadIdx.x == 0) (void)xb_add(&bar[XB_XCNT(b.x)], 1u);
    return b;
}
__device__ __forceinline__ void xcd_barrier_complete(unsigned* bar, unsigned x, unsigned& nloc, unsigned& nx) {
    const unsigned G = gridDim.x * gridDim.y * gridDim.z;
    unsigned sum, cnt, mine, sp = 0u;
    for (;;) {
        sum = 0u; cnt = 0u; mine = 0u;
#pragma unroll
        for (unsigned j = 0; j < 16; ++j) { const unsigned c = xb_ld(&bar[XB_XCNT(j)]); sum += c; cnt += (c > 0u) ? 1u : 0u; mine = (j == x) ? c : mine; }
        if (sum == G) break;
        __builtin_amdgcn_s_sleep(1);
        if ((++sp & 255u) == 0u) { if (xb_ld(&bar[XB_TMO])) break; if (sp > XB_SPIN_CAP) { atomicAdd(&bar[XB_TMO], 1u); break; } }
    }
    nloc = mine > 0u ? mine : 1u; nx = cnt > 0u ? cnt : 1u;
}
__device__ __forceinline__ void xcd_barrier(const XcdBarrier& b) {
    asm volatile("s_waitcnt vmcnt(0)" ::: "memory");
    __syncthreads();
    if (threadIdx.x == 0) {
        unsigned* bar = b.bar; asm volatile("" : "+s"(bar));
        __builtin_amdgcn_s_waitcnt(0);
        const unsigned bx = xb_xcc_id();
        unsigned nloc = b.st[0], nx = b.st[1];
        if (nloc == 0u) { xcd_barrier_complete(bar, bx, nloc, nx); b.st[0] = nloc; b.st[1] = nx; }
        const unsigned old = xb_add(&bar[XB_XSUB(bx)], 1u);
        const unsigned gen = old / nloc;
        if (old + 1u == (gen + 1u) * nloc) {
            __builtin_amdgcn_fence(__ATOMIC_RELEASE, "agent");
            asm volatile("s_waitcnt vmcnt(0)" ::: "memory");
            const unsigned og = xb_add(&bar[XB_TOP], 1u);
            const unsigned tg = og / nx;
            if (og + 1u == (tg + 1u) * nx) xb_add(&bar[XB_TOPGEN], 1u);
            else XB_SPIN(xb_ld(&bar[XB_TOPGEN]) == tg, bar);
            __builtin_amdgcn_fence(__ATOMIC_ACQUIRE, "agent");
            xb_add(&bar[XB_XGEN(bx)], 1u);
            asm volatile("s_waitcnt vmcnt(0)" ::: "memory");
        } else {
            XB_SPIN(xb_ld(&bar[XB_XGEN(bx)]) == gen, bar);
            __builtin_amdgcn_fence(__ATOMIC_ACQUIRE, "agent");
            asm volatile("s_waitcnt vmcnt(0)" ::: "memory");
        }
    }
    __syncthreads();
}

#define LDS_WAIT() asm volatile("s_waitcnt lgkmcnt(0)" ::: "memory")
struct TrD { const float* W; int ldw, k0, n0; bf16_t* WT; int ldt, drow0; const float* ksc; const float* nsc; float mul; };
__device__ __forceinline__ void tr_load(const TrD& d, float (&v)[32], int lane) {
    const float* wp = d.W + (size_t)(d.k0 + (lane >> 5)) * d.ldw + d.n0 + (lane & 31);
#pragma unroll
    for (int i = 0; i < 32; ++i) v[i] = __builtin_nontemporal_load(wp + (size_t)(2 * i) * d.ldw);
}
__device__ __forceinline__ void tr_finish(const TrD& d, float (&v)[32], LAS float* scr, int lane) {
    const float ns = (d.nsc ? d.nsc[d.n0 + (lane & 31)] : 1.f) * d.mul;
    if (d.ksc) {
#pragma unroll
        for (int i = 0; i < 32; ++i) v[i] *= d.ksc[d.k0 + 2 * i + (lane >> 5)]; }
#pragma unroll
    for (int i = 0; i < 32; ++i) scr[(2 * i + (lane >> 5)) * 33 + (lane & 31)] = v[i] * ns;
    LDS_WAIT(); asm volatile("" ::: "memory");
    const int c = lane & 7;
#pragma unroll
    for (int j = 0; j < 4; ++j) { const int n = (lane >> 3) + 8 * j; const LAS float* s = scr + (8 * c) * 33 + n;
        u32x4 o; o.x = cvt_pk_bf16(s[0 * 33], s[1 * 33]); o.y = cvt_pk_bf16(s[2 * 33], s[3 * 33]); o.z = cvt_pk_bf16(s[4 * 33], s[5 * 33]); o.w = cvt_pk_bf16(s[6 * 33], s[7 * 33]);
        *(u32x4*)(d.WT + (size_t)(d.drow0 + n) * d.ldt + d.k0 + 8 * c) = o; }
    LDS_WAIT(); asm volatile("" ::: "memory");
}
struct In {
    const float *x, *c, *ctx, *c_ctx, *ada_w, *ada_b, *norm_g, *pool_w, *pool_scale, *w_dqkv, *q_norm, *w_uq, *kv_norm, *w_ukv, *w_o, *w1, *w3, *w2;
};
constexpr int I_F = (D / 64) * (DFF / 32);
constexpr int I_P = (512 / 64) * (512 / 32);
constexpr int I_DQ = (D / 64) * (1088 / 32);
constexpr int I_UQ = (QL / 64) * (NQ / 32), I_UKV = (KVL / 64) * (NKV / 32);
constexpr int I_O = (D / 64) * (D / 32);
constexpr int SEG0 = 0;
constexpr int SEG1 = SEG0 + 3 * I_F + 8 * I_P + 2 * I_DQ;
constexpr int SEG2 = SEG1 + 3 * I_F;
constexpr int SEG3 = SEG2 + I_UQ + I_UKV + I_O;
constexpr int SEG4 = SEG3 + 3 * I_F;
constexpr int SEG5 = SEG4 + 2 * I_F;
constexpr int SEG6 = SEG5 + I_UQ + I_UKV + I_O + I_F;
__device__ __forceinline__ TrD d_ffn(const In& I, unsigned char* ws, int l, int which, int item) {
    if (which < 2) { const int nblk = DFF / 32, kb = item / nblk, nb = item % nblk, n0 = nb * 32;
        return TrD{(which ? I.w3 : I.w1) + (size_t)l * D * DFF, DFF, kb * 64, n0, (bf16_t*)(ws + WS_W13) + (size_t)l * 2 * DFF * D, D, 256 * (n0 >> 7) + 128 * which + (n0 & 127), nullptr, nullptr, 1.f}; }
    const int nblk = D / 32, kb = item / nblk, nb = item % nblk;
    return TrD{I.w2 + (size_t)l * DFF * D, D, kb * 64, nb * 32, (bf16_t*)(ws + WS_W2) + (size_t)l * D * DFF, DFF, nb * 32, nullptr, nullptr, 1.f};
}
__device__ __forceinline__ TrD d_pool(const In& I, unsigned char* ws, int r) { const int jg = r / I_P, item = r % I_P, j = jg >> 2, g = jg & 3, nblk = 512 / 32, kb = item / nblk, nb = item % nblk;
    return TrD{I.pool_w + (size_t)jg * 512 * 512, 512, kb * 64, nb * 32, (bf16_t*)(ws + WS_WPOOL) + (size_t)j * D * 512, 512, g * 512 + nb * 32, nullptr, I.pool_scale + j * D + g * 512, 1.f}; }
__device__ __forceinline__ TrD d_dq(const In& I, unsigned char* ws, int j, int item) { const int nblk = 1088 / 32, kb = item / nblk, nb = item % nblk;
    return TrD{I.w_dqkv + (size_t)j * D * 1088, 1088, kb * 64, nb * 32, (bf16_t*)(ws + WS_WDQKV) + (size_t)j * NDQKV * D, D, nb * 32, nullptr, nullptr, 1.f}; }
__device__ __forceinline__ TrD d_uq(const In& I, unsigned char* ws, int j, int item) { const int nblk = NQ / 32, kb = item / nblk, nb = item % nblk;
    return TrD{I.w_uq + (size_t)j * QL * NQ, NQ, kb * 64, nb * 32, (bf16_t*)(ws + WS_WUP) + (size_t)j * NUP * 512, 512, nb * 32, I.q_norm + j * QL, nullptr, att::SCALE * 1.4426950408889634f}; }
__device__ __forceinline__ TrD d_ukv(const In& I, unsigned char* ws, int j, int item) { const int nblk = NKV / 32, kb = item / nblk, nb = item % nblk;
    return TrD{I.w_ukv + (size_t)j * KVL * NKV, NKV, kb * 64, nb * 32, (bf16_t*)(ws + WS_WUP) + (size_t)j * NUP * 512, 512, NQ + nb * 32, I.kv_norm + j * KVL, nullptr, 1.f}; }
__device__ __forceinline__ TrD d_o(const In& I, unsigned char* ws, int j, int item) { const int nblk = D / 32, kb = item / nblk, nb = item % nblk;
    return TrD{I.w_o + (size_t)j * D * D, D, kb * 64, nb * 32, (bf16_t*)(ws + WS_WO) + (size_t)j * D * D, D, nb * 32, nullptr, nullptr, 1.f}; }
__device__ __forceinline__ TrD tr_desc(const In& I, unsigned char* ws, int r) {
#define PIECE(cnt, expr) if (r < (cnt)) return expr; r -= (cnt);
    PIECE(I_F, d_ffn(I, ws, 0, 0, r)) PIECE(I_F, d_ffn(I, ws, 0, 1, r)) PIECE(I_F, d_ffn(I, ws, 0, 2, r)) PIECE(8 * I_P, d_pool(I, ws, r)) PIECE(I_DQ, d_dq(I, ws, 0, r)) PIECE(I_DQ, d_dq(I, ws, 1, r))
    PIECE(I_F, d_ffn(I, ws, 1, 0, r)) PIECE(I_F, d_ffn(I, ws, 1, 1, r)) PIECE(I_F, d_ffn(I, ws, 1, 2, r))
    PIECE(I_UQ, d_uq(I, ws, 0, r)) PIECE(I_UKV, d_ukv(I, ws, 0, r)) PIECE(I_O, d_o(I, ws, 0, r))
    PIECE(I_F, d_ffn(I, ws, 2, 0, r)) PIECE(I_F, d_ffn(I, ws, 2, 1, r)) PIECE(I_F, d_ffn(I, ws, 2, 2, r))
    PIECE(I_F, d_ffn(I, ws, 3, 0, r)) PIECE(I_F, d_ffn(I, ws, 3, 1, r))
    PIECE(I_UQ, d_uq(I, ws, 1, r)) PIECE(I_UKV, d_ukv(I, ws, 1, r)) PIECE(I_O, d_o(I, ws, 1, r))
    return d_ffn(I, ws, 3, 2, r);
#undef PIECE
}
__device__ __forceinline__ void tr_run(const In& I, unsigned char* ws, int seg_lo, int seg_n, int v, int vs, LAS float* scr, int lane) {
    float vA[32], vB[32]; TrD dA, dB; int it = v;
    if (it < seg_n) { dA = tr_desc(I, ws, seg_lo + it); tr_load(dA, vA, lane); }
    while (it < seg_n) {
        int itn = it + vs;
        if (itn < seg_n) { dB = tr_desc(I, ws, seg_lo + itn); tr_load(dB, vB, lane); }
        tr_finish(dA, vA, scr, lane);
        it = itn; if (it >= seg_n) break;
        itn = it + vs;
        if (itn < seg_n) { dA = tr_desc(I, ws, seg_lo + itn); tr_load(dA, vA, lane); }
        tr_finish(dB, vB, scr, lane);
        it = itn;
    }
}
#ifndef GEMV_DEFER
#define GEMV_DEFER 0
#endif
constexpr int KSPL2 = 64;
template <int KLEN>
__device__ __forceinline__ void gemv_task(const In& I, float* outp, int l, int st, int k0, int lane) {
    constexpr int NHALF = (KLEN + 63) / 64, HL = KLEN < 64 ? KLEN : 64;
    float sv[3][NHALF];
#pragma unroll
    for (int h = 0; h < NHALF; ++h) { const int k = k0 + h * 64 + (lane % HL); const float c0 = I.c[k], c1 = I.c[D + k], c2 = I.c_ctx[k];
        sv[0][h] = c0 / (1.f + __expf(-c0)); sv[1][h] = c1 / (1.f + __expf(-c1)); sv[2][h] = c2 / (1.f + __expf(-c2)); }
    const float* wp = I.ada_w + ((size_t)l * D + k0) * NMOD + st * 256 + lane * 4;
    f32x4 a0 = {0.f, 0.f, 0.f, 0.f}, a1 = a0, a2 = a0;
#pragma unroll
    for (int h = 0; h < NHALF; ++h)
#pragma unroll (KLEN < 64 ? 16 : 8)
        for (int kk = 0; kk < HL; ++kk) { const f32x4 w = __builtin_nontemporal_load((const f32x4*)(wp + (size_t)(h * 64 + kk) * NMOD));
            a0 += w * __shfl(sv[0][h], kk); a1 += w * __shfl(sv[1][h], kk); a2 += w * __shfl(sv[2][h], kk); }
    float* mp = outp + st * 256 + lane * 4;
    *(f32x4*)mp = a0; *(f32x4*)(mp + NMOD) = a1; *(f32x4*)(mp + 2 * NMOD) = a2;
}
__device__ __forceinline__ void filler(const In& I, unsigned char* ws, int gl, int seg_lo, int seg_n, int fi, int fn, LAS float* scr, int lane) {
    int v = fi;
    if (gl > 0) { constexpr int NG2 = (NMOD / 256) * KSPL2; float* mp2 = (float*)(ws + WS_MODP2) + (size_t)(gl - 1) * KSPL2 * 3 * NMOD;
#if GEMV_TWICE
        if (gl == 2) for (int v2 = fi; v2 < NG2; v2 += fn) { const int ks = v2 % KSPL2, st = v2 / KSPL2; gemv_task<D / KSPL2>(I, mp2 + (size_t)ks * 3 * NMOD, gl, st, ks * (D / KSPL2), lane); }
#endif
        for (; v < NG2; v += fn) { const int ks = v % KSPL2, st = v / KSPL2; gemv_task<D / KSPL2>(I, mp2 + (size_t)ks * 3 * NMOD, gl, st, ks * (D / KSPL2), lane); }
        v -= NG2; }
    tr_run(I, ws, seg_lo, seg_n, v, fn, scr, lane);
}

__device__ __forceinline__ void prologue(const In& I, unsigned char* ws, LAS unsigned char* lds, int gw, int ngw, int wave, int lane, int gtid, int ngt) {
    LAS float* scr = (LAS float*)(lds + wave * 16384);
    bf16_t* WDQKV = (bf16_t*)(ws + WS_WDQKV);
    tr_run(I, ws, SEG0, SEG1 - SEG0, gw, ngw, scr, lane);
    { constexpr int PER = (NDQKV - 1088) * D / 8;
        for (int i = gtid; i < 2 * PER; i += ngt) { const int j = i / PER, q = i % PER; *(u32x4*)(WDQKV + (size_t)j * NDQKV * D + (size_t)1088 * D + (size_t)q * 8) = (u32x4){0u, 0u, 0u, 0u}; } }
    if (gtid < 128 * 16) { const int pos = gtid >> 4, f = gtid & 15; const float inv = powf(10000.f, -(float)(2 * f) / 32.f), ang = (float)pos * inv;
        float* tab = (float*)(ws + WS_ROPE); tab[gtid * 2] = cosf(ang); tab[gtid * 2 + 1] = sinf(ang); }
    { float* MODP = (float*)(ws + WS_G); constexpr int NSTRIP = NMOD / 256, KLEN = D / KSPL;
        for (int task = gw; task < (GEMV_DEFER ? 2 : 4) * NSTRIP * KSPL; task += ngw) { const int ks = task % KSPL, st = (task / KSPL) % NSTRIP, l = task / (KSPL * NSTRIP);
            gemv_task<KLEN>(I, MODP + (size_t)ks * 12 * NMOD + (size_t)l * 3 * NMOD, l, st, ks * KLEN, lane); } }
}

struct RN { const float* xin_lat; const float* xin_ctx; const bf16_t* hin; const bf16_t* Y; const float* Yp; int nparts; const float* gate; const float* gY; bf16_t* hout; float* fout;
            const float* gN; const float* shift; const float* scale; bf16_t* U; int nrows; const float* modp; const float* bias; float* mod_out; };
template <bool HAS_Y, bool WRITE_U, bool HIN_F32, bool HOUT_F32, bool MODP_IN = false, bool POOLY = false>
__device__ __forceinline__ void resid_norm(const RN& a, LAS unsigned char* lds, int gw, int ngw, int tid) {
    asm volatile("" : "+v"(tid)); const int lane = tid & 63;
    typedef const GAS char* gcp; typedef GAS char* gp;
    if (MODP_IN) {
        for (int i = (gw * 64 + lane); i < (GEMV_DEFER ? 6 : 12) * NMOD / 4; i += ngw * 64) { f32x4 acc = *(const GAS f32x4*)((gcp)a.bias + 16 * ((size_t)(i / (3 * NMOD / 4)) * (NMOD / 4) + i % (NMOD / 4)));
            for (int p = 0; p < KSPL; ++p) acc += *(const GAS f32x4*)((gcp)a.modp + ((size_t)p * 12 * NMOD + (size_t)i * 4) * 4);
            *(GAS f32x4*)((gp)a.mod_out + (size_t)i * 16) = acc; } }
    for (int i = tid; i < 3 * (D / 4); i += NTHREADS) { const int s = i / (D / 4), c4 = i % (D / 4); LAS f32x4* t = (LAS f32x4*)(lds + s * 24576) + c4;
        if (HAS_Y) t[0] = *(const GAS f32x4*)((gcp)(a.gate + (size_t)s * NMOD) + 16 * c4) * *(const GAS f32x4*)((gcp)a.gY + 16 * c4);
        if (WRITE_U) { f32x4 sc, sh;
            if (MODP_IN) { sh = *(const GAS f32x4*)((gcp)a.bias + 16 * c4); sc = *(const GAS f32x4*)((gcp)a.bias + 16 * (D / 4 + c4));
                for (int p = 0; p < KSPL; ++p) { const float* mp = a.modp + (size_t)p * 12 * NMOD + (size_t)s * NMOD; sh += *(const GAS f32x4*)((gcp)mp + 16 * c4); sc += *(const GAS f32x4*)((gcp)mp + 16 * (D / 4 + c4)); } }
            else { sc = *(const GAS f32x4*)((gcp)(a.scale + (size_t)s * NMOD) + 16 * c4); sh = *(const GAS f32x4*)((gcp)(a.shift + (size_t)s * NMOD) + 16 * c4); }
            t[D / 4] = *(const GAS f32x4*)((gcp)a.gN + 16 * c4) * (sc + 1.f); t[2 * (D / 4)] = sh; } }
    __syncthreads();
    const unsigned l16 = (unsigned)lane * 16u, l8 = (unsigned)lane * 8u;
    const int nrows = a.nrows, nparts = a.nparts;
#define LDF4(base, j) (*(const GAS f32x4*)((gcp)(base) + l16 + 1024u * (j)))
#define LDB4(base, j) (*(const GAS u32x2*)((gcp)(base) + l8 + 512u * (j)))
#define UNPK(w) ((f32x4){bf_lo((w).x), bf_hi((w).x), bf_lo((w).y), bf_hi((w).y)})
#define RN_LOAD(hf, hw, yw, r) do { \
        if (HIN_F32) { const float* hp_ = (r) < TL ? a.xin_lat + (size_t)(r) * D : a.xin_ctx + (size_t)((r) - TL) * D; _Pragma("unroll") for (int j = 0; j < 8; ++j) hf[j] = LDF4(hp_, j); } \
        else { const bf16_t* hp_ = a.hin + (size_t)(r) * D; _Pragma("unroll") for (int j = 0; j < 8; ++j) hw[j] = LDB4(hp_, j); } \
        if (HAS_Y && !POOLY && !((r) >= TL && nparts > 0)) { const bf16_t* yr_ = a.Y + (size_t)(r) * D; _Pragma("unroll") for (int j = 0; j < 8; ++j) yw[j] = LDB4(yr_, j); } } while (0)
#define RN_PROC(hf, hw, yw, r) do { const int s_ = (r) < SEQ ? 0 : ((r) < TL ? 1 : 2); const LAS f32x4* tb_ = (const LAS f32x4*)(lds + s_ * 24576) + lane; f32x4 h[8]; \
        _Pragma("unroll") for (int j = 0; j < 8; ++j) h[j] = HIN_F32 ? hf[j] : UNPK(hw[j]); \
        if (HAS_Y) { f32x4 y[8]; float sy = 0.f; \
            if (POOLY) {   \
                int sb_, L_; if ((r) < TL) { sb_ = ((r) / SEQ) * SEQ; L_ = SEQ; } else { sb_ = TL + (((r) - TL) / CTXL) * CTXL; L_ = CTXL; } const int t_ = (r) - sb_; const bf16_t* zs_ = a.Y + (size_t)sb_ * D; \
                _Pragma("unroll") for (int g = 0; g < 4; ++g) { const int w2_ = 1 << g, lo_ = max(t_ - w2_, 0), hi_ = min(t_ + w2_, L_); const float inv_ = 1.f / (float)(hi_ - lo_); \
                    f32x4 s0_ = {0.f, 0.f, 0.f, 0.f}, s1_ = s0_; \
                    _Pragma("unroll") for (int i = 0; i < 2 * w2_; ++i) { const int q_ = t_ - w2_ + i; const bool ok_ = q_ >= 0 && q_ < L_; const bf16_t* zr_ = zs_ + (size_t)(ok_ ? q_ : t_) * D; \
                        const u32x2 wa_ = LDB4(zr_, 2 * g), wb_ = LDB4(zr_, 2 * g + 1); const float m_ = ok_ ? 1.f : 0.f; s0_ += UNPK(wa_) * m_; s1_ += UNPK(wb_) * m_; } \
                    const bf16_t* zc_ = zs_ + (size_t)t_ * D; const u32x2 ca_ = LDB4(zc_, 2 * g), cb_ = LDB4(zc_, 2 * g + 1); y[2 * g] = s0_ * inv_ - UNPK(ca_); y[2 * g + 1] = s1_ * inv_ - UNPK(cb_); } } \
            else if ((r) >= TL && nparts > 0) { _Pragma("unroll") for (int j = 0; j < 8; ++j) y[j] = (f32x4){0.f, 0.f, 0.f, 0.f}; \
                for (int p = 0; p < nparts; ++p) { const float* yp_ = a.Yp + ((size_t)p * TC + ((r) - TL)) * D; _Pragma("unroll") for (int j = 0; j < 8; ++j) y[j] += LDF4(yp_, j); } } \
            else { _Pragma("unroll") for (int j = 0; j < 8; ++j) y[j] = UNPK(yw[j]); } \
            _Pragma("unroll") for (int j = 0; j < 8; ++j) sy += (y[j][0] * y[j][0] + y[j][1] * y[j][1]) + (y[j][2] * y[j][2] + y[j][3] * y[j][3]); \
            const float rs_ = __builtin_amdgcn_rsqf(wave_sum(sy) * (1.f / D) + RMS_EPS); \
            _Pragma("unroll") for (int j = 0; j < 8; ++j) h[j] += tb_[64 * j] * (y[j] * rs_); } \
        if (HOUT_F32) { float* op_ = a.fout + (size_t)(r) * D; _Pragma("unroll") for (int j = 0; j < 8; ++j) __builtin_nontemporal_store(h[j], (GAS f32x4*)((gp)op_ + l16 + 1024u * j)); } \
        else if (a.hout) { bf16_t* op_ = a.hout + (size_t)(r) * D; _Pragma("unroll") for (int j = 0; j < 8; ++j) { u32x2 w; w.x = cvt_pk_bf16(h[j][0], h[j][1]); w.y = cvt_pk_bf16(h[j][2], h[j][3]); *(GAS u32x2*)((gp)op_ + l8 + 512u * j) = w; } } \
        if (WRITE_U) { float ss = 0.f; \
            _Pragma("unroll") for (int j = 0; j < 8; ++j) ss += (h[j][0] * h[j][0] + h[j][1] * h[j][1]) + (h[j][2] * h[j][2] + h[j][3] * h[j][3]); \
            const float rstd_ = __builtin_amdgcn_rsqf(wave_sum(ss) * (1.f / D) + RMS_EPS); bf16_t* ur_ = a.U + (size_t)(r) * D; \
            _Pragma("unroll") for (int j = 0; j < 8; ++j) { const f32x4 u = (h[j] * rstd_) * tb_[D / 4 + 64 * j] + tb_[2 * (D / 4) + 64 * j]; u32x2 w; w.x = cvt_pk_bf16(u[0], u[1]); w.y = cvt_pk_bf16(u[2], u[3]); \
                *(GAS u32x2*)((gp)ur_ + l8 + 512u * j) = w; } } } while (0)
    f32x4 hfA[8], hfB[8], hfC[8]; u32x2 hwA[8], hwB[8], hwC[8], ywA[8], ywB[8], ywC[8];
    int r = POOLY ? gw : (gw % NWAVES) * (ngw / NWAVES) + gw / NWAVES;
    if (r < nrows) RN_LOAD(hfA, hwA, ywA, r);
    if (r + ngw < nrows) RN_LOAD(hfB, hwB, ywB, r + ngw);
    while (r < nrows) {
        if (r + 2 * ngw < nrows) RN_LOAD(hfC, hwC, ywC, r + 2 * ngw);
        RN_PROC(hfA, hwA, ywA, r);
        r += ngw; if (r >= nrows) break;
        if (r + 2 * ngw < nrows) RN_LOAD(hfA, hwA, ywA, r + 2 * ngw);
        RN_PROC(hfB, hwB, ywB, r);
        r += ngw; if (r >= nrows) break;
        if (r + 2 * ngw < nrows) RN_LOAD(hfB, hwB, ywB, r + 2 * ngw);
        RN_PROC(hfC, hwC, ywC, r);
        r += ngw;
    }
#undef LDF4
#undef LDB4
#undef UNPK
#undef RN_LOAD
#undef RN_PROC
    __syncthreads();
}

__device__ __forceinline__ void krope_phase(const bf16_t* __restrict__ CQKV, bf16_t* __restrict__ KR, const float* __restrict__ tab, int gtid, int ngt) {
    asm volatile("" : "+v"(gtid));
    for (int i = gtid; i < T * 32; i += ngt) { const int r = i >> 5, ax = (i >> 4) & 1, f = i & 15;
        const bf16_t* src = CQKV + (size_t)r * NDQKV + 1024 + ax * 32 + f; const float x1 = bf_lo((unsigned)src[0]), x2 = bf_lo((unsigned)src[16]); float o1 = x1, o2 = x2;
        if (r < TL) { const int t = r & (SEQ - 1), pos = ax ? (t & 63) : (t >> 6); const float c = tab[(pos * 16 + f) * 2], s = tab[(pos * 16 + f) * 2 + 1]; o1 = x1 * c - x2 * s; o2 = x2 * c + x1 * s; }
        bf16_t* dst = KR + (size_t)r * ROPED + ax * 32 + f; dst[0] = (bf16_t)(cvt_pk_bf16(o1, 0.f) & 0xffffu); dst[16] = (bf16_t)(cvt_pk_bf16(o2, 0.f) & 0xffffu); }
}

#ifndef EN_P0
#define EN_P0 1
#endif
#ifndef EN_P1
#define EN_P1 1
#endif
#ifndef EN_S0
#define EN_S0 1
#endif
#ifndef EN_S1
#define EN_S1 1
#endif
#ifndef EN_S2
#define EN_S2 1
#endif
#ifndef EN_S3
#define EN_S3 1
#endif
#ifndef EN_S4
#define EN_S4 1
#endif
#ifndef EN_S5
#define EN_S5 1
#endif
#ifndef EN_S6
#define EN_S6 1
#endif
#ifndef EN_S7
#define EN_S7 1
#endif
struct Args { const float* in[18]; float* out; unsigned char* ws; int ph_lo, ph_hi; };
constexpr int N_PHASES = 34;
constexpr int SPLIT_POOL = 2, SPLIT_WO = 8, SPLIT_FFN2 = 11;

__global__ void __launch_bounds__(NTHREADS, 2) mk_fwd(Args args) {
    extern __shared__ __attribute__((aligned(16))) unsigned char lds_raw[];
    LAS unsigned char* lds = (LAS unsigned char*)lds_raw;
    volatile LAS unsigned* MISC = (volatile LAS unsigned*)(lds + MISC_OFF);
    const int G0 = gridDim.x, bid0 = blockIdx.x;
    unsigned char* ws = args.ws;
    for (int u = threadIdx.x; u < (LDS_BYTES - MISC_OFF) / 4; u += NTHREADS) ((LAS unsigned*)(lds + MISC_OFF))[u] = 0u;
    __syncthreads();
#if MK_PER_PHASE
    const int lo = args.ph_lo, hi = args.ph_hi;
#else
    constexpr int lo = 0, hi = N_PHASES;
#endif
    const bool use_bar = (hi - lo) > 1;
    XcdBarrier bar; bar.bar = (unsigned*)(ws + WS_CTL) + CW_BAR; bar.x = 0; bar.st = MISC + 8;
    if (use_bar) bar = xcd_barrier_post((unsigned*)(ws + WS_CTL) + CW_BAR, MISC + 8);
#define IN(k) (lo <= (k) && (k) < hi)
#define PHASE_END(k) do { if (hi > (k) + 1) xcd_barrier(bar); } while (0)
#define SITE() int tid = threadIdx.x, G = G0, bid = bid0; asm volatile("" : "+v"(tid), "+s"(G), "+s"(bid)); const int lane = tid & 63, wave = __builtin_amdgcn_readfirstlane(tid >> 6), gw = bid * NWAVES + wave, gtid = bid * NTHREADS + tid, ngw = G * NWAVES, ngt = G * NTHREADS; \
               (void)lane; (void)gw; (void)gtid; (void)ngw; (void)ngt; const __attribute__((address_space(4))) char* kp_ = (const __attribute__((address_space(4))) char*)__builtin_amdgcn_kernarg_segment_ptr(); asm volatile("" : "+s"(kp_)); \
               unsigned char* wsl = *(unsigned char* const __attribute__((address_space(4)))*)(kp_ + 19 * 8); asm volatile("" : "+s"(wsl))
#define KIN(k) (*(const float* const __attribute__((address_space(4)))*)(kp_ + (k) * 8))
#define KOUT() (*(float* const __attribute__((address_space(4)))*)(kp_ + 18 * 8))
#define WP(type, off) ((type*)(wsl + (off)))
#define MKIN() In I; I.x = KIN(0); I.c = KIN(1); I.ctx = KIN(2); I.c_ctx = KIN(3); I.ada_w = KIN(4); I.ada_b = KIN(5); I.norm_g = KIN(6); I.pool_w = KIN(7); \
               I.pool_scale = KIN(8); I.w_dqkv = KIN(9); I.q_norm = KIN(10); I.w_uq = KIN(11); I.kv_norm = KIN(12); I.w_ukv = KIN(13); I.w_o = KIN(14); I.w1 = KIN(15); I.w3 = KIN(16); I.w2 = KIN(17)
#define FILL_TAIL(gl, seg_lo, seg_hi) do { const int nshort_ = S.nwg % G; if (bid >= nshort_) { __syncthreads(); MKIN();   \
               filler(I, wsl, (gl), (seg_lo), (seg_hi) - (seg_lo), (bid - nshort_) * NWAVES + wave, (G - nshort_) * NWAVES, (LAS float*)(lds + wave * 16384), lane); } } while (0)

    if (EN_P0 && IN(0)) { SITE();
        MKIN();
        prologue(I, wsl, lds, gw, ngw, wave, lane, gtid, ngt); PHASE_END(0); }
    if (EN_P1 && IN(1)) { SITE();
        RN a; a.xin_lat = KIN(0); a.xin_ctx = KIN(2); a.hin = nullptr; a.Y = nullptr; a.Yp = nullptr; a.nparts = 0; a.gate = nullptr; a.gY = nullptr; a.hout = nullptr; a.fout = nullptr;
        a.gN = KIN(6); a.shift = nullptr; a.scale = nullptr; a.U = WP(bf16_t, WS_U); a.nrows = T; a.modp = WP(const float, WS_G); a.bias = KIN(5); a.mod_out = WP(float, WS_MOD);
        resid_norm<false, true, true, false, true>(a, lds, gw, ngw, tid); PHASE_END(1); }

    for (int L = 0; L < 4; ++L) {
        const int base = 2 + 8 * L, j = L >> 1; const bool pool = (L & 1) == 0;
        const int Mrows = (L == 3) ? TL : T;
        if (EN_S0 && !pool && IN(base + 0)) { SITE(); float* SSQ = WP(float, WS_SSQ);
            pg8::Gemm g{WP(const bf16_t, WS_U), WP(const bf16_t, WS_WDQKV) + (size_t)j * NDQKV * D, T, NDQKV, D, D, D}; pg8::StaticOrder S; S.init(T, NDQKV, D, G, bid);
            pg8::EpiStore E{WP(bf16_t, WS_CQKV), NDQKV, SSQ, SSQ + (size_t)8 * T, 2, 4, 0, 0};
            pg8::gemm_phase<pg8::EpiStore, pg8::StaticOrder>(lds, g, S, E);
            { const int lo_ = L == 1 ? SEG2 : SEG5, hi_ = L == 1 ? SEG3 : SEG6; FILL_TAIL(GEMV_DEFER && L == 1 ? 2 : 0, lo_, hi_); }
            PHASE_END(base + 0); }
        if (EN_S1 && !pool && IN(base + 1)) { SITE(); float* SSQ = WP(float, WS_SSQ);
            krope_phase(WP(const bf16_t, WS_CQKV), WP(bf16_t, WS_KR), WP(const float, WS_ROPE), gtid, ngt);
            pg8::Gemm g{WP(const bf16_t, WS_CQKV), WP(const bf16_t, WS_WUP) + (size_t)j * NUP * 512, T, NUP, 512, NDQKV, 512}; pg8::StaticOrder S; S.init(T, NUP, 512, G, bid);
            pg8::EpiUp E{WP(bf16_t, WS_Q), WP(bf16_t, WS_KV), SSQ, SSQ + (size_t)8 * T};
            pg8::gemm_phase<pg8::EpiUp, pg8::StaticOrder>(lds, g, S, E);
            PHASE_END(base + 1); }
        if (EN_S2 && !pool && IN(base + 2)) { SITE();
            const bf16_t* Qb = WP(const bf16_t, WS_Q); const bf16_t* KV = WP(const bf16_t, WS_KV); bf16_t* P = WP(bf16_t, WS_P);
            const int nlat = NB * NH * (SEQ / 256), nunits = nlat + (L == 1 ? NB * NH : 0);
            for (int u = bid; u < nunits; u += G) {
                att::Unit A;
                if (u < nlat) { const int pair = (u >> 8) * 8 + (u & 7), qb = (u & 255) >> 3, b = pair >> 4, h = pair & 15; const int row0 = b * SEQ + qb * 256;
                    A.Qb = Qb + (size_t)row0 * NQ + h * QKD; A.KVh = KV + h * 256; A.Ob = P + (size_t)row0 * D + h * VD; A.kb_lat = b * SEQ; A.nt_lat = SEQ / 64; A.kb_ctx = TL + b * CTXL; A.NT = SEQ / 64 + CTXL / 64; A.qpos0 = qb * 256; }
                else { const int v = u - nlat, b = v >> 4, h = v & 15; const int row0 = TL + b * CTXL;
                    A.Qb = Qb + (size_t)row0 * NQ + h * QKD; A.KVh = KV + h * 256; A.Ob = P + (size_t)row0 * D + h * VD; A.kb_lat = 0; A.nt_lat = 0; A.kb_ctx = row0; A.NT = CTXL / 64; A.qpos0 = -1; }
                att::attn_unit_auto(A, WP(const bf16_t, WS_KR), WP(const float, WS_ROPE), lds);
            }
            PHASE_END(base + 2); }
        if (EN_S3 && IN(base + 3)) { SITE();
            pg8::Gemm g; pg8::EpiY E{WP(bf16_t, WS_Y), WP(float, WS_YP), D, TL, TC, 0, 0}; pg8::HybridOrder S;
            if (pool) { g = pg8::Gemm{WP(const bf16_t, WS_U), WP(const bf16_t, WS_WPOOL) + (size_t)j * D * 512, Mrows, D, 512, D, 512}; E.a_grp_tiles = 2; E.a_grp_off = 512; S.init(Mrows, Mrows, D, 512, G, bid, 1); }
            else { g = pg8::Gemm{WP(const bf16_t, WS_P), WP(const bf16_t, WS_WO) + (size_t)j * D * D, Mrows, D, D, D, D}; S.init(TL, Mrows, D, D, G, bid, SPLIT_WO); }
            pg8::gemm_phase<pg8::EpiY, pg8::HybridOrder>(lds, g, S, E);
            PHASE_END(base + 3); }
        if (EN_S4 && IN(base + 4)) { SITE(); const float* modL = WP(const float, WS_MOD) + (size_t)L * 3 * NMOD; const float* gL = KIN(6) + (size_t)L * 4 * D;
            RN a; a.xin_lat = KIN(0); a.xin_ctx = KIN(2); a.hin = WP(const bf16_t, WS_H); a.Y = WP(const bf16_t, WS_Y); a.Yp = WP(const float, WS_YP); a.nparts = (!pool && Mrows > TL) ? SPLIT_WO : 0; a.gate = modL + 2 * D; a.gY = gL + D;
            a.hout = WP(bf16_t, WS_H); a.fout = nullptr; a.gN = gL + 2 * D; a.shift = modL + 3 * D; a.scale = modL + 4 * D; a.U = WP(bf16_t, WS_U); a.nrows = Mrows; a.modp = nullptr; a.bias = nullptr; a.mod_out = nullptr;
            if (L == 0) resid_norm<true, true, true, false, false, true>(a, lds, gw, ngw, tid); else if (pool) resid_norm<true, true, false, false, false, true>(a, lds, gw, ngw, tid); else resid_norm<true, true, false, false>(a, lds, gw, ngw, tid);
            PHASE_END(base + 4); }
        if (EN_S5 && IN(base + 5)) { SITE(); pg8::Gemm g{WP(const bf16_t, WS_U), WP(const bf16_t, WS_W13) + (size_t)L * 2 * DFF * D, Mrows, 2 * DFF, D, D, D}; pg8::StaticOrder S; S.init(Mrows, 2 * DFF, D, G, bid);
            pg8::EpiSwiGLU E{WP(bf16_t, WS_G), DFF};
            pg8::gemm_phase<pg8::EpiSwiGLU, pg8::StaticOrder>(lds, g, S, E);
            if (L < 3) { const int lo_ = L == 0 ? SEG1 : L == 1 ? SEG3 : SEG4, hi_ = L == 0 ? SEG2 : L == 1 ? SEG4 : SEG5; FILL_TAIL(GEMV_DEFER && L == 2 ? 3 : 0, lo_, hi_); }
            PHASE_END(base + 5); }
        if (EN_S6 && IN(base + 6)) { SITE();
            pg8::Gemm g{WP(const bf16_t, WS_G), WP(const bf16_t, WS_W2) + (size_t)L * D * DFF, Mrows, D, DFF, DFF, DFF}; pg8::HybridOrder S; S.init(TL, Mrows, D, DFF, G, bid, SPLIT_FFN2);
            pg8::EpiY E{WP(bf16_t, WS_Y), WP(float, WS_YP), D, TL, TC, 0, 0};
            pg8::gemm_phase<pg8::EpiY, pg8::HybridOrder>(lds, g, S, E);
            if (GEMV_DEFER && (L == 1 || L == 2)) { const float* mp2 = WP(const float, WS_MODP2) + (size_t)L * KSPL2 * 3 * NMOD; const float* bias = KIN(5) + (size_t)(L + 1) * NMOD; float* mo = WP(float, WS_MOD) + (size_t)(L + 1) * 3 * NMOD;
                for (int o = gtid; o < 3 * NMOD; o += ngt) { float acc = bias[o % NMOD];
#pragma unroll 16
                    for (int p = 0; p < KSPL2; ++p) acc += mp2[(size_t)p * 3 * NMOD + o];
                    mo[o] = acc; } }
            PHASE_END(base + 6); }
        if (EN_S7 && IN(base + 7)) { SITE(); const float* modL = WP(const float, WS_MOD) + (size_t)L * 3 * NMOD; const float* gL = KIN(6) + (size_t)L * 4 * D;
            RN a; a.xin_lat = nullptr; a.xin_ctx = nullptr; a.hin = WP(const bf16_t, WS_H); a.Y = WP(const bf16_t, WS_Y); a.Yp = WP(const float, WS_YP); a.nparts = L < 3 ? SPLIT_FFN2 : 0; a.gate = modL + 5 * D; a.gY = gL + 3 * D; a.modp = nullptr; a.bias = nullptr; a.mod_out = nullptr;
            if (L < 3) { a.hout = WP(bf16_t, WS_H); a.fout = nullptr; a.gN = gL + 4 * D; a.shift = modL + 3 * NMOD; a.scale = modL + 3 * NMOD + D; a.U = WP(bf16_t, WS_U); a.nrows = T;
                resid_norm<true, true, false, false>(a, lds, gw, ngw, tid); }
            else { a.hout = nullptr; a.fout = KOUT(); a.gN = nullptr; a.shift = nullptr; a.scale = nullptr; a.U = nullptr; a.nrows = TL;
                resid_norm<true, false, false, true>(a, lds, gw, ngw, tid); }
            PHASE_END(base + 7); }
    }
#undef IN
#undef PHASE_END
}

extern "C" void kernel_launch(void* const* d_in, const int* in_sizes, int n_in, void* d_out, int out_size, void* d_ws, size_t ws_size, hipStream_t stream) {
    static int grid = 0;
    if (grid == 0) {
        if (n_in != 18 || in_sizes[0] != TL * D || out_size != TL * D || ws_size < WS_END) { fprintf(stderr, "kernel_launch: unexpected shapes (n_in %d, in0 %d, out %d, ws %zu); nothing launched\n", n_in, n_in > 0 ? in_sizes[0] : -1, out_size, ws_size); grid = -1; return; }
        int dev = 0, cus = 0, per_cu = 0;
        if (hipGetDevice(&dev) != hipSuccess || hipDeviceGetAttribute(&cus, hipDeviceAttributeMultiprocessorCount, dev) != hipSuccess) { grid = -1; return; }
        if (hipFuncSetAttribute((const void*)mk_fwd, hipFuncAttributeMaxDynamicSharedMemorySize, LDS_BYTES) != hipSuccess) { fprintf(stderr, "kernel_launch: hipFuncSetAttribute failed\n"); grid = -1; return; }
        if (hipOccupancyMaxActiveBlocksPerMultiprocessor(&per_cu, (const void*)mk_fwd, NTHREADS, LDS_BYTES) != hipSuccess || per_cu < 1) { fprintf(stderr, "kernel_launch: occupancy query says %d blocks per CU\n", per_cu); }
        (void)hipGetLastError();
        grid = cus;
    }
    if (grid < 0) return;
    if (hipMemsetAsync((char*)d_ws + WS_CTL, 0, CTL_ZERO_BYTES, stream) != hipSuccess) return;
    Args a{};
    for (int i = 0; i < 18; ++i) a.in[i] = (const float*)d_in[i];
    a.out = (float*)d_out; a.ws = (unsigned char*)d_ws;
#if MK_PER_PHASE
    for (int p = 0; p < N_PHASES; ++p) { const int k = p - 2, L = k >> 3, s = k & 7; if (p >= 2 && (L & 1) == 0 && s <= 2) continue;
        a.ph_lo = p; a.ph_hi = p + 1; hipLaunchKernelGGL(mk_fwd, dim3(grid), dim3(NTHREADS), LDS_BYTES, stream, a); }
#else
    a.ph_lo = 0; a.ph_hi = N_PHASES; hipLaunchKernelGGL(mk_fwd, dim3(grid), dim3(NTHREADS), LDS_BYTES, stream, a);
#endif
    const hipError_t le = hipPeekAtLastError();
    if (le != hipSuccess) fprintf(stderr, "kernel_launch: launch failed: %s\n", hipGetErrorName(le));
}
```

```cpp
#include <hip/hip_runtime.h>
#include <cstdio>
#include <cstdint>

#ifndef MK_PER_PHASE
#define MK_PER_PHASE 0
#endif

#define LAS __attribute__((address_space(3)))
#define GAS __attribute__((address_space(1)))
typedef unsigned short bf16_t;
typedef short bf16x8 __attribute__((ext_vector_type(8)));
typedef short s16x4 __attribute__((ext_vector_type(4)));
typedef float f32x4 __attribute__((ext_vector_type(4)));
typedef float f32x2 __attribute__((ext_vector_type(2)));
typedef float f32x16 __attribute__((ext_vector_type(16)));
typedef unsigned u32x4 __attribute__((ext_vector_type(4)));
typedef unsigned u32x2 __attribute__((ext_vector_type(2)));

constexpr int D = 2048, SEQ = 8192, NB = 2, CTXL = 256, TL = NB * SEQ, TC = NB * CTXL, T = TL + TC;
constexpr int DFF = 5632, NH = 16, QKD = 192, NOPE = 128, ROPED = 64, VD = 128, QL = 512, KVL = 512;
constexpr int NDQKV = 1280;
constexpr int NQ = NH * QKD, NKV = NH * (NOPE + VD), NUP = NQ + NKV;
constexpr int NMOD = 6 * D;
constexpr float RMS_EPS = 1e-6f;
constexpr int NWAVES = 8, NTHREADS = 512;

__device__ __forceinline__ unsigned cvt_pk_bf16(float lo, float hi) { unsigned r; asm volatile("v_cvt_pk_bf16_f32 %0, %1, %2" : "=v"(r) : "v"(lo), "v"(hi)); return r; }
__device__ __forceinline__ float bf_lo(unsigned w) { return __uint_as_float(w << 16); }
__device__ __forceinline__ float bf_hi(unsigned w) { return __uint_as_float(w & 0xffff0000u); }
__device__ __forceinline__ float wave_sum(float v) {
#pragma unroll
    for (int o = 1; o < 64; o <<= 1) v += __shfl_xor(v, o);
    return v;
}

namespace pg8 {
constexpr int BM = 256, BK = 64, HALF = 128, HTB = HALF * BK * 2, STAGE_BYTES = 8 * HTB, NXCD = 8, WGM = 4;
__host__ __device__ __forceinline__ int lds_byte(int r, int c) { const int st = (r >> 4) * 2 + (c >> 5), rr = r & 15, cc = c & 31, ob = rr * 64 + cc * 2; return st * 1024 + (ob ^ (((ob >> 9) & 1) << 5)); }
__host__ __device__ __forceinline__ void stage_rc(int b, int& R, int& C) { const int st = b / 1024, sb = b % 1024, swz = sb ^ (((sb >> 9) & 1) << 5); R = (st >> 1) * 16 + swz / 64; C = (st & 1) * 32 + (swz % 64) / 2; }
__host__ __device__ __forceinline__ int perm32(int rho) { const int n = rho >> 4, i = rho & 15; return 8 * (i >> 2) + 4 * n + (i & 3); }

struct Unit { int pm, pn, kt0, nkt, part; };
struct Gemm { const bf16_t* A; const bf16_t* Bt; int M, N, K, lda, ldb; };

struct StaticOrder {
    int nM, nN, nwg, G, c, nkt;
    __host__ __device__ void init(int M, int N, int K, int G_, int c_) { nM = M / BM; nN = N / BM; nwg = nM * nN; G = G_; c = c_; nkt = K / BK; }
    __host__ __device__ bool next(int i, Unit& u) const {
        const long L = (long)i * G + c; if (L >= nwg) return false;
        int wgid = (int)L; { const int q = nwg / NXCD, r = nwg % NXCD, xcd = wgid % NXCD, off = wgid / NXCD; wgid = (xcd < r ? xcd * (q + 1) : r * (q + 1) + (xcd - r) * q) + off; }
        const int nig = WGM * nN, gid = wgid / nig, fm = gid * WGM, gsz = (nM - fm) < WGM ? (nM - fm) : WGM;
        u.pm = fm + ((wgid % nig) % gsz); u.pn = (wgid % nig) / gsz; u.kt0 = 0; u.nkt = nkt; u.part = -1; return true;
    }
};
struct HybridOrder {
    StaticOrder full; int nfull, nsplit, S, nktp, nN, pm0, G, c;
    __host__ __device__ void init(int Mfull, int Mtot, int N, int K, int G_, int c_, int S_) { full.init(Mfull, N, K, G_, c_); nfull = full.nwg; nN = N / BM; pm0 = Mfull / BM; S = S_; nktp = (K / BK) / S_;
        nsplit = ((Mtot - Mfull) / BM) * nN * S_; G = G_; c = c_; }
    __host__ __device__ bool next(int i, Unit& u) const {
        const long L = (long)i * G + c; if (L < nfull) return full.next(i, u);
        const int e = (int)(L - nfull); if (e >= nsplit) return false;
        const int part = e % S, tile = e / S; u.pm = pm0 + tile / nN; u.pn = tile % nN; u.kt0 = part * nktp; u.nkt = nktp; u.part = part; return true;
    }
};

template <class Epi, class Sched, bool ALIGN_EPI = true>
__device__ __forceinline__ void gemm_phase(LAS unsigned char* lds, const Gemm g, const Sched& S, const Epi& E) {
    int tid = threadIdx.x; asm volatile("" : "+v"(tid));
    const int wid = __builtin_amdgcn_readfirstlane(tid >> 6), lane = tid & 63, wr = wid >> 2, wc = wid & 3, fr = lane & 15, fq = lane >> 4;
    unsigned voffA[2], voffB[2];
#pragma unroll
    for (int i = 0; i < 2; ++i) { int R, C; stage_rc(tid * 16 + i * 8192, R, C); const int Rb = (R & ~31) + perm32(R & 31);
        voffA[i] = (unsigned)(R * g.lda + C) * 2u; voffB[i] = (unsigned)(Rb * g.ldb + C) * 2u; }
    const size_t kstep = (size_t)(BK * 2);
    const size_t hstepA = (size_t)HALF * g.lda * 2, hstepB = (size_t)HALF * g.ldb * 2;
    const size_t tstepA = 2 * hstepA, tstepB = 2 * hstepB;
    const unsigned ldsw = (unsigned)wid * 1024u;
    const int aoff = lds_byte(wr * 64 + fr, fq * 8), boff = lds_byte(wc * 32 + fr, fq * 8);
#define PG8_SA(b, h) (((b) * 2 + (h)) * HTB)
#define PG8_SB(b, h) ((4 + (b) * 2 + (h)) * HTB)
#define PG8_STAGE(bufoff, gbase, voff) do { _Pragma("unroll") for (int _i = 0; _i < 2; ++_i) \
        __builtin_amdgcn_global_load_lds((const unsigned*)((const char*)(gbase) + (voff)[_i]), (LAS unsigned*)(lds + (bufoff) + ldsw + _i * 8192), 16, 0, 0); } while (0)
#define PG8_LDA(dst, b, h) do { _Pragma("unroll") for (int m = 0; m < 4; ++m) _Pragma("unroll") for (int k = 0; k < 2; ++k) dst[m][k] = *(const LAS bf16x8*)(lds + PG8_SA(b, h) + aoff + m * 2048 + k * 1024); } while (0)
#define PG8_LDB(dst, b, h) do { _Pragma("unroll") for (int n = 0; n < 2; ++n) _Pragma("unroll") for (int k = 0; k < 2; ++k) dst[n][k] = *(const LAS bf16x8*)(lds + PG8_SB(b, h) + boff + n * 2048 + k * 1024); } while (0)
#define PG8_MMA(ai, bj, At, Bt) do { __builtin_amdgcn_s_setprio(1); _Pragma("unroll") for (int m = 0; m < 4; ++m) _Pragma("unroll") for (int n = 0; n < 2; ++n) _Pragma("unroll") for (int k = 0; k < 2; ++k) \
        acc[ai][bj][m][n] = __builtin_amdgcn_mfma_f32_16x16x32_bf16(Bt[n][k], At[m][k], acc[ai][bj][m][n], 0, 0, 0); __builtin_amdgcn_s_setprio(0); } while (0)
#define PG8_WAIT_V(n) asm volatile("s_waitcnt vmcnt(" #n ")" ::: "memory")
#define PG8_WAIT_L(n) asm volatile("s_waitcnt lgkmcnt(" #n ")" ::: "memory")
#define PG8_BAR __builtin_amdgcn_s_barrier()
#define PG8_SCHED __builtin_amdgcn_sched_barrier(0)
    Unit cur, nxt; int ui = 0;
    if (!S.next(0, cur)) return;
    f32x4 acc[2][2][4][2];
#pragma unroll
    for (int a = 0; a < 2; ++a)
#pragma unroll
        for (int b = 0; b < 2; ++b)
#pragma unroll
            for (int m = 0; m < 4; ++m)
#pragma unroll
                for (int n = 0; n < 2; ++n) acc[a][b][m][n] = (f32x4){0.f, 0.f, 0.f, 0.f};
    bf16x8 At[4][2], B0[2][2], B1[2][2];
    const char* cA = (const char*)g.A + (size_t)cur.pm * tstepA + (size_t)E.a_off(cur.pn) * 2 + (size_t)cur.kt0 * kstep; const char* cB = (const char*)g.Bt + (size_t)cur.pn * tstepB + (size_t)cur.kt0 * kstep;
    PG8_STAGE(PG8_SB(0, 0), cB, voffB); PG8_STAGE(PG8_SB(0, 1), cB + hstepB, voffB); PG8_STAGE(PG8_SA(0, 0), cA, voffA); PG8_STAGE(PG8_SA(0, 1), cA + hstepA, voffA);
    if (wr == 1) PG8_BAR;
    PG8_WAIT_V(2); PG8_BAR;
    PG8_STAGE(PG8_SB(1, 0), cB + kstep, voffB); PG8_STAGE(PG8_SA(1, 0), cA + kstep, voffA); PG8_STAGE(PG8_SB(1, 1), cB + hstepB + kstep, voffB);
    PG8_WAIT_V(6); PG8_BAR;
    for (;;) {
        const bool has_next = S.next(ui + 1, nxt);
        const char* nA = has_next ? (const char*)g.A + (size_t)nxt.pm * tstepA + (size_t)E.a_off(nxt.pn) * 2 + (size_t)nxt.kt0 * kstep : cA; const char* nB = has_next ? (const char*)g.Bt + (size_t)nxt.pn * tstepB + (size_t)nxt.kt0 * kstep : cB;
        const int nt = cur.nkt;
        asm volatile(".p2align 6");
        for (int t = 0; t < nt; t += 2) {
            const bool last = (t == nt - 2);
            const char* a1 = cA + (size_t)(t + 1) * kstep;
            const char* a2 = last ? nA : cA + (size_t)(t + 2) * kstep; const char* b2 = last ? nB : cB + (size_t)(t + 2) * kstep;
            const char* a3 = a2 + kstep; const char* b3 = b2 + kstep;
            PG8_LDB(B0, 0, 0); PG8_LDB(B1, 0, 1); PG8_SCHED; PG8_LDA(At, 0, 0); PG8_STAGE(PG8_SA(1, 1), a1 + hstepA, voffA);
            PG8_WAIT_V(8); PG8_WAIT_L(0); PG8_BAR; PG8_MMA(0, 0, At, B0); PG8_MMA(0, 1, At, B1); PG8_BAR; PG8_SCHED;
            PG8_LDA(At, 0, 1); PG8_STAGE(PG8_SB(0, 0), b2, voffB); PG8_STAGE(PG8_SB(0, 1), b2 + hstepB, voffB); PG8_STAGE(PG8_SA(0, 0), a2, voffA);
            PG8_WAIT_V(8); PG8_WAIT_L(0); PG8_BAR; PG8_MMA(1, 0, At, B0); PG8_MMA(1, 1, At, B1); PG8_BAR; PG8_SCHED;
            PG8_LDB(B0, 1, 0); PG8_LDB(B1, 1, 1); PG8_SCHED; PG8_LDA(At, 1, 0); PG8_STAGE(PG8_SA(0, 1), a2 + hstepA, voffA);
            PG8_WAIT_V(8); PG8_WAIT_L(0); PG8_BAR; PG8_MMA(0, 0, At, B0); PG8_MMA(0, 1, At, B1); PG8_BAR; PG8_SCHED;
            PG8_LDA(At, 1, 1); PG8_STAGE(PG8_SB(1, 0), b3, voffB); PG8_STAGE(PG8_SB(1, 1), b3 + hstepB, voffB); PG8_STAGE(PG8_SA(1, 0), a3, voffA);
            PG8_WAIT_V(8); PG8_WAIT_L(0); PG8_BAR; PG8_MMA(1, 0, At, B0); PG8_MMA(1, 1, At, B1); PG8_BAR; PG8_SCHED;
        }
        if constexpr (ALIGN_EPI) { if (wr == 0) PG8_BAR; }
        E(acc, cur, wr, wc, fr, fq);
        if (!has_next) break;
#pragma unroll
        for (int a = 0; a < 2; ++a)
#pragma unroll
            for (int b = 0; b < 2; ++b)
#pragma unroll
                for (int m = 0; m < 4; ++m)
#pragma unroll
                    for (int n = 0; n < 2; ++n) acc[a][b][m][n] = (f32x4){0.f, 0.f, 0.f, 0.f};
        cur = nxt; cA = nA; cB = nB; ++ui;
        if constexpr (ALIGN_EPI) { if (wr == 1) PG8_BAR; }
    }
    PG8_WAIT_V(0);
    if constexpr (!ALIGN_EPI) { if (wr == 0) PG8_BAR; }
    PG8_BAR;
#undef PG8_SA
#undef PG8_SB
#undef PG8_STAGE
#undef PG8_LDA
#undef PG8_LDB
#undef PG8_MMA
#undef PG8_WAIT_V
#undef PG8_WAIT_L
#undef PG8_BAR
#undef PG8_SCHED
}

#ifndef EPI_SC1
#define EPI_SC1 0
#endif
__device__ __forceinline__ void st16(void* p, u32x4 w) {
#if EPI_SC1
    asm volatile("global_store_dwordx4 %0, %1, off sc1\n\ts_nop 1" :: "v"(p), "v"(w) : "memory");
#else
    *(u32x4*)p = w;
#endif
}
struct EpiStore {
    bf16_t* O; int ldc; float* ssq0; float* ssq1; int split0, split1; int a_grp_tiles, a_grp_off;
    __device__ __forceinline__ int a_off(int pn) const { return a_grp_tiles ? (pn / a_grp_tiles) * a_grp_off : 0; }
    __device__ __forceinline__ void operator()(const f32x4 (&acc)[2][2][4][2], const Unit& u, int wr, int wc, int fr, int fq) const {
        const int row0 = u.pm * BM + wr * 64 + fr, col0 = u.pn * BM + wc * 32 + 8 * fq;
        float* ssq = u.pn < split0 ? ssq0 : (u.pn < split1 ? ssq1 : nullptr);
#pragma unroll
        for (int ai = 0; ai < 2; ++ai)
#pragma unroll
            for (int m = 0; m < 4; ++m) { const int row = row0 + ai * HALF + m * 16; bf16_t* rowp = O + (size_t)row * ldc + col0; float s = 0.f;
#pragma unroll
                for (int bj = 0; bj < 2; ++bj) { const f32x4 v0 = acc[ai][bj][m][0], v1 = acc[ai][bj][m][1];
                    s += (v0[0] * v0[0] + v0[1] * v0[1]) + (v0[2] * v0[2] + v0[3] * v0[3]) + (v1[0] * v1[0] + v1[1] * v1[1]) + (v1[2] * v1[2] + v1[3] * v1[3]);
                    u32x4 w; w.x = cvt_pk_bf16(v0[0], v0[1]); w.y = cvt_pk_bf16(v0[2], v0[3]); w.z = cvt_pk_bf16(v1[0], v1[1]); w.w = cvt_pk_bf16(v1[2], v1[3]);
                    st16(rowp + bj * HALF, w); }
                if (ssq) { s += __shfl_xor(s, 16); s += __shfl_xor(s, 32); if (fq == 0) ssq[(size_t)row * 8 + (u.pn & 1) * 4 + wc] = s; } }
    }
};
struct EpiY {
    bf16_t* O; float* Yp; int ldc, row_split, nsplit_rows; int a_grp_tiles, a_grp_off;
    __device__ __forceinline__ int a_off(int pn) const { return a_grp_tiles ? (pn / a_grp_tiles) * a_grp_off : 0; }
    __device__ __forceinline__ void operator()(const f32x4 (&acc)[2][2][4][2], const Unit& u, int wr, int wc, int fr, int fq) const {
        const int row0 = u.pm * BM + wr * 64 + fr, col0 = u.pn * BM + wc * 32 + 8 * fq;
        if (u.part < 0) {
#pragma unroll
            for (int ai = 0; ai < 2; ++ai)
#pragma unroll
                for (int m = 0; m < 4; ++m) { bf16_t* rowp = O + (size_t)(row0 + ai * HALF + m * 16) * ldc + col0;
#pragma unroll
                    for (int bj = 0; bj < 2; ++bj) { const f32x4 v0 = acc[ai][bj][m][0], v1 = acc[ai][bj][m][1];
                        u32x4 w; w.x = cvt_pk_bf16(v0[0], v0[1]); w.y = cvt_pk_bf16(v0[2], v0[3]); w.z = cvt_pk_bf16(v1[0], v1[1]); w.w = cvt_pk_bf16(v1[2], v1[3]);
                        st16(rowp + bj * HALF, w); } }
        } else { float* slab = Yp + (size_t)u.part * nsplit_rows * ldc;
#pragma unroll
            for (int ai = 0; ai < 2; ++ai)
#pragma unroll
                for (int m = 0; m < 4; ++m) { float* rowp = slab + (size_t)(row0 + ai * HALF + m * 16 - row_split) * ldc + col0;
#pragma unroll
                    for (int bj = 0; bj < 2; ++bj) { *(f32x4*)(rowp + bj * HALF) = acc[ai][bj][m][0]; *(f32x4*)(rowp + bj * HALF + 4) = acc[ai][bj][m][1]; } }
        }
    }
};
struct EpiSwiGLU {
    bf16_t* O; int ldc;
    __device__ __forceinline__ int a_off(int) const { return 0; }
    __device__ __forceinline__ void operator()(const f32x4 (&acc)[2][2][4][2], const Unit& u, int wr, int wc, int fr, int fq) const {
        const int row0 = u.pm * BM + wr * 64 + fr, col0 = u.pn * HALF + wc * 32 + 8 * fq;
#pragma unroll
        for (int ai = 0; ai < 2; ++ai)
#pragma unroll
            for (int m = 0; m < 4; ++m) { const int row = row0 + ai * HALF + m * 16; float gv[8];
#pragma unroll
                for (int n = 0; n < 2; ++n)
#pragma unroll
                    for (int j = 0; j < 4; ++j) { const float a = acc[ai][0][m][n][j], b = acc[ai][1][m][n][j]; gv[n * 4 + j] = a * __builtin_amdgcn_rcpf(1.f + __expf(-a)) * b; }
                u32x4 w; w.x = cvt_pk_bf16(gv[0], gv[1]); w.y = cvt_pk_bf16(gv[2], gv[3]); w.z = cvt_pk_bf16(gv[4], gv[5]); w.w = cvt_pk_bf16(gv[6], gv[7]);
                st16(O + (size_t)row * ldc + col0, w); }
    }
};
struct EpiUp {
    bf16_t* Q; bf16_t* KV; const float* ssq_q; const float* ssq_kv;
    __device__ __forceinline__ int a_off(int pn) const { return pn < NQ / BM ? 0 : QL; }
    __device__ __forceinline__ void operator()(const f32x4 (&acc)[2][2][4][2], const Unit& u, int wr, int wc, int fr, int fq) const {
        const bool isq = u.pn < NQ / BM; const int ldc = isq ? NQ : NKV; bf16_t* O = isq ? Q : KV; const float* ssq = isq ? ssq_q : ssq_kv;
        const int row0 = u.pm * BM + wr * 64 + fr, col0 = (isq ? u.pn : u.pn - NQ / BM) * BM + wc * 32 + 8 * fq;
        float rs[2][4];
#pragma unroll
        for (int ai = 0; ai < 2; ++ai)
#pragma unroll
            for (int m = 0; m < 4; ++m) { const int row = row0 + ai * HALF + m * 16;
                const f32x4 sa = *(const f32x4*)(ssq + (size_t)row * 8), sb = *(const f32x4*)(ssq + (size_t)row * 8 + 4);
                rs[ai][m] = __builtin_amdgcn_rsqf((((sa[0] + sa[1]) + (sa[2] + sa[3])) + ((sb[0] + sb[1]) + (sb[2] + sb[3]))) * (1.f / 512.f) + RMS_EPS); }
#pragma unroll
        for (int ai = 0; ai < 2; ++ai)
#pragma unroll
            for (int m = 0; m < 4; ++m) { const int row = row0 + ai * HALF + m * 16; bf16_t* rowp = O + (size_t)row * ldc + col0;
#pragma unroll
                for (int bj = 0; bj < 2; ++bj) { const f32x4 v0 = acc[ai][bj][m][0] * rs[ai][m], v1 = acc[ai][bj][m][1] * rs[ai][m];
                    u32x4 w; w.x = cvt_pk_bf16(v0[0], v0[1]); w.y = cvt_pk_bf16(v0[2], v0[3]); w.z = cvt_pk_bf16(v1[0], v1[1]); w.w = cvt_pk_bf16(v1[2], v1[3]);
                    st16(rowp + bj * HALF, w); } }
    }
};
}
namespace att {
constexpr int QBLK = 32, KVBLK = 64;
constexpr float SCALE = 0.07216878364870322f;
constexpr float THR = 8.f;
#ifndef ATT_SDEPTH
#define ATT_SDEPTH 1
#endif
constexpr int SDEPTH = ATT_SDEPTH;
constexpr int SHM_V = KVBLK * VD * 2, SHM_K = KVBLK * QKD * 2;
constexpr int LDS_BYTES = 2 * SHM_V + 2 * SHM_K + NWAVES * 64 * 4;
#define KOFF(row, ch) ((row) * 384 + ((((ch) ^ (((row) >> 1) & 7))) << 4))
#define SBAR() __builtin_amdgcn_sched_barrier(0)
__device__ __forceinline__ int crow(int r, int hi) { return (r & 3) + 8 * (r >> 2) + 4 * hi; }

__device__ __forceinline__ void finishSM(f32x16& p0, f32x16& p1, float alpha, float& l_reg, bf16x8& pa0, bf16x8& pa1, bf16x8& pa2, bf16x8& pa3) {
#pragma unroll
    for (int r = 0; r < 16; ++r) p1[r] = __builtin_amdgcn_exp2f(p1[r]);
    float ps = 0;
#pragma unroll
    for (int r = 0; r < 16; ++r) ps += p0[r];
#pragma unroll
    for (int r = 0; r < 16; ++r) ps += p1[r];
    { auto rr = __builtin_amdgcn_permlane32_swap(__float_as_uint(ps), __float_as_uint(ps), false, false);
      ps = __uint_as_float(rr[0]) + __uint_as_float(rr[1]); }
    l_reg = l_reg * alpha + ps;
#define PK8(P, BASE, OUT) do { u32x4 w = {cvt_pk_bf16(P[BASE + 0], P[BASE + 1]), cvt_pk_bf16(P[BASE + 2], P[BASE + 3]), cvt_pk_bf16(P[BASE + 4], P[BASE + 5]), cvt_pk_bf16(P[BASE + 6], P[BASE + 7])}; \
    OUT = *reinterpret_cast<bf16x8*>(&w); } while (0)
    PK8(p0, 0, pa0); PK8(p0, 8, pa1); PK8(p1, 0, pa2); PK8(p1, 8, pa3);
#undef PK8
}
__device__ __forceinline__ int v_st(int k, int c) { const int kk = (k & ~0xC) | ((k & 4) << 1) | ((k & 8) >> 1); return ((kk >> 3) * 4 + (c >> 5)) * 512 + ((kk & 7) * 32 + (c & 31)) * 2; }
__device__ __forceinline__ int v_rd_base(int lane) { return ((lane & 3) << 3) | (((lane >> 2) & 3) << 6) | (((lane >> 4) & 1) << 5) | (((lane >> 5) & 1) << 8); }
constexpr int v_rd_off(int d0, int ks, int half) { return d0 * 512 + ks * 4096 + half * 2048; }
template <int OFF> __device__ __forceinline__ s16x4 tr_read(int vb) {
    s16x4 r; asm volatile("ds_read_b64_tr_b16 %0, %1 offset:%2" : "=&v"(r) : "v"(vb), "i"(OFF) : "memory"); return r;
}
template <int D0> __device__ __forceinline__ void pv_one(f32x16& od, int vb, bf16x8 pa0, bf16x8 pa1, bf16x8 pa2, bf16x8 pa3) {
    const s16x4 l0 = tr_read<v_rd_off(D0, 0, 0)>(vb), h0 = tr_read<v_rd_off(D0, 0, 1)>(vb), l1 = tr_read<v_rd_off(D0, 1, 0)>(vb), h1 = tr_read<v_rd_off(D0, 1, 1)>(vb);
    const s16x4 l2 = tr_read<v_rd_off(D0, 2, 0)>(vb), h2 = tr_read<v_rd_off(D0, 2, 1)>(vb), l3 = tr_read<v_rd_off(D0, 3, 0)>(vb), h3 = tr_read<v_rd_off(D0, 3, 1)>(vb);
    asm volatile("s_waitcnt lgkmcnt(0)" ::: "memory"); SBAR();
#define PK(L, H) (bf16x8){L[0], L[1], L[2], L[3], H[0], H[1], H[2], H[3]}
    od = __builtin_amdgcn_mfma_f32_32x32x16_bf16(pa0, PK(l0, h0), od, 0, 0, 0);
    od = __builtin_amdgcn_mfma_f32_32x32x16_bf16(pa1, PK(l1, h1), od, 0, 0, 0);
    od = __builtin_amdgcn_mfma_f32_32x32x16_bf16(pa2, PK(l2, h2), od, 0, 0, 0);
    od = __builtin_amdgcn_mfma_f32_32x32x16_bf16(pa3, PK(l3, h3), od, 0, 0, 0);
#undef PK
}
__device__ __forceinline__ void pv_d0(f32x16* o, int vb, bf16x8 pa0, bf16x8 pa1, bf16x8 pa2, bf16x8 pa3) {
    pv_one<0>(o[0], vb, pa0, pa1, pa2, pa3); pv_one<1>(o[1], vb, pa0, pa1, pa2, pa3); pv_one<2>(o[2], vb, pa0, pa1, pa2, pa3); pv_one<3>(o[3], vb, pa0, pa1, pa2, pa3);
}
__device__ __forceinline__ void rope8(bf16x8& x1, bf16x8& x2, const float* tab) {
    u32x4 a = *reinterpret_cast<u32x4*>(&x1), b = *reinterpret_cast<u32x4*>(&x2), oa, ob;
#pragma unroll
    for (int w = 0; w < 4; ++w) {
        const f32x4 cs = *reinterpret_cast<const f32x4*>(tab + 4 * w);
        const float a0 = bf_lo(a[w]), a1 = bf_hi(a[w]), b0 = bf_lo(b[w]), b1 = bf_hi(b[w]);
        oa[w] = cvt_pk_bf16(a0 * cs[0] - b0 * cs[1], a1 * cs[2] - b1 * cs[3]);
        ob[w] = cvt_pk_bf16(b0 * cs[0] + a0 * cs[1], b1 * cs[2] + a1 * cs[3]);
    }
    x1 = *reinterpret_cast<bf16x8*>(&oa); x2 = *reinterpret_cast<bf16x8*>(&ob);
}

struct Unit { const bf16_t* Qb; const bf16_t* KVh; bf16_t* Ob; int kb_lat, nt_lat, kb_ctx, NT, qpos0; };

constexpr int SLOT = 40960, KR_OFF = 16384, V_OFF = 24576, LDS2_BYTES = 3 * SLOT + NWAVES * 64 * 4;
constexpr float THRL = THR * 1.4426950408889634f;
#ifndef ATT_MARGIN
#define ATT_MARGIN 100.f
#endif
__device__ __forceinline__ void qkt2n(f32x16& p0, f32x16& p1, LAS const char* lds, int kn, int kr, const bf16x8* qr, const f32x16& negm) {
#pragma unroll
    for (int d0 = 0; d0 < 8; ++d0) { const int a = kn ^ (d0 << 5);
        const bf16x8 b0 = *reinterpret_cast<LAS const bf16x8*>(lds + a), b1 = *reinterpret_cast<LAS const bf16x8*>(lds + a + 32 * 256);
        if (d0 == 0) { p0 = __builtin_amdgcn_mfma_f32_32x32x16_bf16(b0, qr[0], negm, 0, 0, 0); p1 = __builtin_amdgcn_mfma_f32_32x32x16_bf16(b1, qr[0], negm, 0, 0, 0); }
        else { p0 = __builtin_amdgcn_mfma_f32_32x32x16_bf16(b0, qr[d0], p0, 0, 0, 0); p1 = __builtin_amdgcn_mfma_f32_32x32x16_bf16(b1, qr[d0], p1, 0, 0, 0); } }
#pragma unroll
    for (int d0 = 0; d0 < 4; ++d0) { const int a = kr ^ (d0 << 5);
        const bf16x8 b0 = *reinterpret_cast<LAS const bf16x8*>(lds + a), b1 = *reinterpret_cast<LAS const bf16x8*>(lds + a + 32 * 128);
        p0 = __builtin_amdgcn_mfma_f32_32x32x16_bf16(b0, qr[8 + d0], p0, 0, 0, 0); p1 = __builtin_amdgcn_mfma_f32_32x32x16_bf16(b1, qr[8 + d0], p1, 0, 0, 0); }
}
template <bool FIRST>
__device__ __forceinline__ void partialSM2(f32x16& p0, f32x16& p1, float& m_reg, f32x16& negm, float& alpha, float margin = 0.f) {
    float pmax = p0[0];
#pragma unroll
    for (int r = 1; r < 16; ++r) pmax = fmaxf(pmax, p0[r]);
#pragma unroll
    for (int r = 0; r < 16; ++r) pmax = fmaxf(pmax, p1[r]);
    { auto rr = __builtin_amdgcn_permlane32_swap(__float_as_uint(pmax), __float_as_uint(pmax), false, false);
      pmax = fmaxf(__uint_as_float(rr[0]), __uint_as_float(rr[1])); }
    alpha = 1.f;
    if (FIRST || !__builtin_expect(__all(pmax <= THRL), 1)) {
        const float delta = FIRST ? pmax + margin : fmaxf(pmax, 0.f);
        if (!FIRST) alpha = __builtin_amdgcn_exp2f(-delta);
        m_reg += delta;
#pragma unroll
        for (int r = 0; r < 16; ++r) { p0[r] -= delta; p1[r] -= delta; negm[r] = -m_reg; }
    }
#pragma unroll
    for (int r = 0; r < 16; ++r) p0[r] = __builtin_amdgcn_exp2f(p0[r]);
}
__device__ __forceinline__ void exp_half(f32x16& p0) {
#pragma unroll
    for (int r = 0; r < 16; ++r) p0[r] = __builtin_amdgcn_exp2f(p0[r]);
}
template <bool FIXM>
__device__ __forceinline__ void attn_unit6(const Unit& U, const bf16_t* __restrict__ KR, const float* __restrict__ ropetab, LAS unsigned char* lds) {
    int tid = threadIdx.x; asm volatile("" : "+v"(tid));
    const int wid = __builtin_amdgcn_readfirstlane(tid >> 6), lane = tid & 63, r32 = lane & 31, hi = lane >> 5;
    LAS float* wsf = (LAS float*)(lds + 3 * SLOT) + wid * 64; LAS float* li_l = wsf; LAS float* al_l = wsf + 32;
    float m_reg = 0.f, l_reg = 0; f32x16 o[4] = {}; bf16x8 qr[12]; f32x16 negm = {};
    const bf16_t* Qw = U.Qb + (size_t)(wid * QBLK + r32) * NQ + hi * 8;
#pragma unroll
    for (int d0 = 0; d0 < 12; ++d0) qr[d0] = *reinterpret_cast<const bf16x8*>(Qw + d0 * 16);
    if (U.qpos0 >= 0) { const int t = U.qpos0 + wid * QBLK + r32, pr = t >> 6, pc = t & 63;
        rope8(qr[8], qr[9], ropetab + (pr * 16 + hi * 8) * 2); rope8(qr[10], qr[11], ropetab + (pc * 16 + hi * 8) * 2); }
    unsigned von[2], vov[2], vor;
#pragma unroll
    for (int i = 0; i < 2; ++i) { const int p = (wid * 2 + i) * 64 + lane;
        { const int row = p >> 4, c = (p & 15) ^ (row & 15); von[i] = (unsigned)(row * (NKV * 2) + c * 16); }
        { const int sub = p >> 5, within = p & 31, k = (sub >> 2) * 8 + (within >> 2), c = (sub & 3) * 32 + (within & 3) * 8;     vov[i] = (unsigned)(k * (NKV * 2) + NOPE * 2 + c * 2); } }
    { const int p = wid * 64 + lane, row = p >> 3, c = (p & 7) ^ ((row >> 1) & 7); vor = (unsigned)(row * (ROPED * 2) + c * 16); }
    const int kn0 = r32 * 256 + ((hi ^ (r32 & 15)) << 4), kr0 = KR_OFF + r32 * 128 + ((hi ^ ((r32 >> 1) & 7)) << 4), vb0 = (int)(uintptr_t)lds + V_OFF + v_rd_base(lane);
    const int nt_lat = U.nt_lat, kb_lat = U.kb_lat, kb_ctx = U.kb_ctx - 64 * nt_lat, NT = U.NT;
    const bf16_t* KVh = U.KVh;
    const unsigned ldsw2 = (unsigned)wid * 2048u, ldsw1 = (unsigned)wid * 1024u;
#define KROW(j) (((j) < nt_lat ? kb_lat : kb_ctx) + 64 * (j))
#define DMA(j, so) do { const size_t _k = (size_t)KROW(j); const char* _kv = (const char*)KVh + _k * (NKV * 2); const char* _kr = (const char*)KR + _k * (ROPED * 2); \
    __builtin_amdgcn_global_load_lds((const unsigned*)(_kv + von[0]), (LAS unsigned*)(lds + (so) + ldsw2), 16, 0, 0); \
    __builtin_amdgcn_global_load_lds((const unsigned*)(_kv + von[1]), (LAS unsigned*)(lds + (so) + ldsw2 + 1024), 16, 0, 0); \
    __builtin_amdgcn_global_load_lds((const unsigned*)(_kr + vor), (LAS unsigned*)(lds + (so) + KR_OFF + ldsw1), 16, 0, 0); \
    __builtin_amdgcn_global_load_lds((const unsigned*)(_kv + vov[0]), (LAS unsigned*)(lds + (so) + V_OFF + ldsw2), 16, 0, 0); \
    __builtin_amdgcn_global_load_lds((const unsigned*)(_kv + vov[1]), (LAS unsigned*)(lds + (so) + V_OFF + ldsw2 + 1024), 16, 0, 0); } while (0)
#define TILE_BAR() asm volatile("s_waitcnt vmcnt(0) lgkmcnt(0)\n\ts_barrier" ::: "memory")
#define RESC2(a) do { if (__any((a) < 1.f)) { if (hi == 0) al_l[r32] = (a); asm volatile("s_waitcnt lgkmcnt(0)" ::: "memory"); \
    _Pragma("unroll") for (int d = 0; d < 4; ++d) _Pragma("unroll") for (int r = 0; r < 16; ++r) o[d][r] *= al_l[crow(r, hi)]; } } while (0)
    f32x16 pA0, pA1, pB0, pB1; float alA, alB; bf16x8 pa0, pa1, pa2, pa3;
    int s_prev = 0, s_cur = SLOT, s_next = 2 * SLOT;
    DMA(0, 0); DMA(1, SLOT); TILE_BAR();
    qkt2n(pA0, pA1, (LAS const char*)lds, kn0, kr0, qr, negm); partialSM2<true>(pA0, pA1, m_reg, negm, alA, FIXM ? ATT_MARGIN : 0.f);
    asm volatile(".p2align 6");
    for (int j = 1; j + 1 < NT; j += 2) {
        DMA(j + 1, s_next); SBAR();
        qkt2n(pB0, pB1, (LAS const char*)lds, kn0 + s_cur, kr0 + s_cur, qr, negm);
        finishSM(pA0, pA1, alA, l_reg, pa0, pa1, pa2, pa3); SBAR();
        pv_d0(o, vb0 + s_prev, pa0, pa1, pa2, pa3); if (FIXM) { alB = 1.f; exp_half(pB0); } else partialSM2<false>(pB0, pB1, m_reg, negm, alB);
        if (!FIXM) RESC2(alB); TILE_BAR();
        { const int t = s_prev; s_prev = s_cur; s_cur = s_next; s_next = t; }
        if (j + 2 < NT) DMA(j + 2, s_next); SBAR();
        qkt2n(pA0, pA1, (LAS const char*)lds, kn0 + s_cur, kr0 + s_cur, qr, negm);
        finishSM(pB0, pB1, alB, l_reg, pa0, pa1, pa2, pa3); SBAR();
        pv_d0(o, vb0 + s_prev, pa0, pa1, pa2, pa3); if (FIXM) { alA = 1.f; exp_half(pA0); } else partialSM2<false>(pA0, pA1, m_reg, negm, alA);
        if (!FIXM) RESC2(alA); TILE_BAR();
        { const int t = s_prev; s_prev = s_cur; s_cur = s_next; s_next = t; }
    }
    SBAR(); qkt2n(pB0, pB1, (LAS const char*)lds, kn0 + s_cur, kr0 + s_cur, qr, negm);
    finishSM(pA0, pA1, alA, l_reg, pa0, pa1, pa2, pa3); SBAR();
    pv_d0(o, vb0 + s_prev, pa0, pa1, pa2, pa3); if (FIXM) { alB = 1.f; exp_half(pB0); } else partialSM2<false>(pB0, pB1, m_reg, negm, alB);
    if (!FIXM) RESC2(alB);
    finishSM(pB0, pB1, alB, l_reg, pa0, pa1, pa2, pa3); SBAR();
    pv_d0(o, vb0 + s_cur, pa0, pa1, pa2, pa3);
    if (FIXM) { const bool okl = (l_reg > 0.f) && (l_reg < 1e30f); const bool okw = __all(okl); if (lane == 0) ((LAS unsigned*)(lds + LDS2_BYTES))[wid] = okw ? 1u : 0u; }
    if (hi == 0) li_l[r32] = l_reg; asm volatile("s_waitcnt lgkmcnt(0)" ::: "memory");
    float rli[16];
#pragma unroll
    for (int r = 0; r < 16; ++r) rli[r] = __builtin_amdgcn_rcpf(li_l[crow(r, hi)]);
    asm volatile("s_waitcnt lgkmcnt(0)\n\ts_barrier" ::: "memory");
    { constexpr int OP = 272; LAS unsigned char* st = lds + wid * (32 * OP);
#pragma unroll
      for (int r = 0; r < 16; ++r) { const int orow = crow(r, hi);
#pragma unroll
        for (int d0 = 0; d0 < 4; ++d0) *(LAS bf16_t*)(st + orow * OP + (d0 * 32 + r32) * 2) = (bf16_t)(cvt_pk_bf16(o[d0][r] * rli[r], 0.f) & 0xffffu); }
      asm volatile("s_waitcnt lgkmcnt(0)" ::: "memory");
      bf16_t* Ow = U.Ob + (size_t)(wid * QBLK) * D;
#pragma unroll
      for (int i = 0; i < 8; ++i) { const int row = (lane >> 4) + 4 * i, ch = lane & 15;
        const u32x4 w = *(const LAS u32x4*)(st + row * OP + ch * 16); *(u32x4*)(Ow + (size_t)row * D + ch * 8) = w; } }
    TILE_BAR();
#undef KROW
#undef DMA
#undef TILE_BAR
#undef RESC2
}


typedef float f32x4_t __attribute__((ext_vector_type(4)));
__device__ __forceinline__ void attn_unit7(const Unit& U, const bf16_t* __restrict__ KR, const float* __restrict__ ropetab, LAS unsigned char* lds) {
    int tid = threadIdx.x; asm volatile("" : "+v"(tid));
    const int wid = __builtin_amdgcn_readfirstlane(tid >> 6), lane = tid & 63, c16 = lane & 15, g = lane >> 4;
    f32x4_t o[8][2]; bf16x8 qr[2][6]; f32x4_t negm[2]; float l_reg[2] = {0.f, 0.f};
#pragma unroll
    for (int t = 0; t < 8; ++t)
#pragma unroll
        for (int u = 0; u < 2; ++u) o[t][u] = (f32x4_t){0.f, 0.f, 0.f, 0.f};
    const int xg = g < 2 ? g : g + 2;
#pragma unroll
    for (int u = 0; u < 2; ++u) { const bf16_t* Qw = U.Qb + (size_t)(wid * QBLK + 16 * u + c16) * NQ;
#pragma unroll
        for (int s = 0; s < 4; ++s) qr[u][s] = *reinterpret_cast<const bf16x8*>(Qw + 32 * s + 8 * g);
        qr[u][4] = *reinterpret_cast<const bf16x8*>(Qw + NOPE + 8 * xg); qr[u][5] = *reinterpret_cast<const bf16x8*>(Qw + NOPE + 8 * (xg + 2));
        if (U.qpos0 >= 0) { const int t = U.qpos0 + wid * QBLK + 16 * u + c16, pos = g < 2 ? (t >> 6) : (t & 63); rope8(qr[u][4], qr[u][5], ropetab + (pos * 16 + (g & 1) * 8) * 2); } }
    unsigned von[2], vov[2], vor;
#pragma unroll
    for (int i = 0; i < 2; ++i) { const int p = (wid * 2 + i) * 64 + lane;
        { const int row = p >> 4, c = (p & 15) ^ (row & 15); von[i] = (unsigned)(row * (NKV * 2) + c * 16); }
        { const int sub = p >> 5, within = p & 31, k = (sub >> 2) * 8 + (within >> 2), c = (sub & 3) * 32 + (((within & 3) * 8) ^ (((within >> 4) & 1) << 4)); vov[i] = (unsigned)(k * (NKV * 2) + NOPE * 2 + c * 2); } }
    { const int p = wid * 64 + lane, row = p >> 3, c = (p & 7) ^ ((row >> 1) & 7); vor = (unsigned)(row * (ROPED * 2) + c * 16); }
    const int kn0 = c16 * 256 + ((g ^ c16) << 4), kr0 = KR_OFF + c16 * 128 + ((xg ^ ((c16 >> 1) & 7)) << 4);
    const int vbe = (int)(uintptr_t)lds + V_OFF + (g >> 1) * 2048 + (4 * (g & 1) + (c16 >> 2)) * 64 + 32 * (g & 1) + 8 * (c16 & 3), vbo = vbe ^ 32;
    const int nt_lat = U.nt_lat, kb_lat = U.kb_lat, kb_ctx = U.kb_ctx - 64 * nt_lat, NT = U.NT;
    const bf16_t* KVh = U.KVh;
    const unsigned ldsw2 = (unsigned)wid * 2048u, ldsw1 = (unsigned)wid * 1024u;
#define KROW(j) (((j) < nt_lat ? kb_lat : kb_ctx) + 64 * (j))
#define DMA(j, so) do { const size_t _k = (size_t)KROW(j); const char* _kv = (const char*)KVh + _k * (NKV * 2); const char* _kr = (const char*)KR + _k * (ROPED * 2); \
    __builtin_amdgcn_global_load_lds((const unsigned*)(_kv + von[0]), (LAS unsigned*)(lds + (so) + ldsw2), 16, 0, 0); \
    __builtin_amdgcn_global_load_lds((const unsigned*)(_kv + von[1]), (LAS unsigned*)(lds + (so) + ldsw2 + 1024), 16, 0, 0); \
    __builtin_amdgcn_global_load_lds((const unsigned*)(_kr + vor), (LAS unsigned*)(lds + (so) + KR_OFF + ldsw1), 16, 0, 0); \
    __builtin_amdgcn_global_load_lds((const unsigned*)(_kv + vov[0]), (LAS unsigned*)(lds + (so) + V_OFF + ldsw2), 16, 0, 0); \
    __builtin_amdgcn_global_load_lds((const unsigned*)(_kv + vov[1]), (LAS unsigned*)(lds + (so) + V_OFF + ldsw2 + 1024), 16, 0, 0); } while (0)
#define TILE_BAR() asm volatile("s_waitcnt vmcnt(0) lgkmcnt(0)\n\ts_barrier" ::: "memory")
#define MFMA16(A, B, C) __builtin_amdgcn_mfma_f32_16x16x32_bf16(A, B, C, 0, 0, 0)
#define QK7(P, so) do { const LAS char* _l = (const LAS char*)lds; const int _kn = kn0 + (so), _kr = kr0 + (so); \
    _Pragma("unroll") for (int s = 0; s < 4; ++s) { bf16x8 kf[4]; \
        _Pragma("unroll") for (int a = 0; a < 4; ++a) kf[a] = *reinterpret_cast<const LAS bf16x8*>(_l + ((_kn ^ (s << 6)) + a * 4096)); \
        _Pragma("unroll") for (int a = 0; a < 4; ++a) _Pragma("unroll") for (int u = 0; u < 2; ++u) P[u][a] = MFMA16(kf[a], qr[u][s], s == 0 ? negm[u] : P[u][a]); } \
    _Pragma("unroll") for (int s = 0; s < 2; ++s) { bf16x8 kf[4]; \
        _Pragma("unroll") for (int a = 0; a < 4; ++a) kf[a] = *reinterpret_cast<const LAS bf16x8*>(_l + ((_kr ^ (s << 5)) + a * 2048)); \
        _Pragma("unroll") for (int a = 0; a < 4; ++a) _Pragma("unroll") for (int u = 0; u < 2; ++u) P[u][a] = MFMA16(kf[a], qr[u][4 + s], P[u][a]); } } while (0)
#define EXPH7(P, A0) do { _Pragma("unroll") for (int u = 0; u < 2; ++u) _Pragma("unroll") for (int a = (A0); a < (A0) + 2; ++a) _Pragma("unroll") for (int r = 0; r < 4; ++r) P[u][a][r] = __builtin_amdgcn_exp2f(P[u][a][r]); } while (0)
#define FIN7(P) do { EXPH7(P, 2); \
    _Pragma("unroll") for (int u = 0; u < 2; ++u) { float ps = 0.f; _Pragma("unroll") for (int a = 0; a < 4; ++a) ps += (P[u][a][0] + P[u][a][1]) + (P[u][a][2] + P[u][a][3]); l_reg[u] += ps; \
        _Pragma("unroll") for (int ks = 0; ks < 2; ++ks) { u32x4 w = {cvt_pk_bf16(P[u][2 * ks][0], P[u][2 * ks][1]), cvt_pk_bf16(P[u][2 * ks][2], P[u][2 * ks][3]), \
            cvt_pk_bf16(P[u][2 * ks + 1][0], P[u][2 * ks + 1][1]), cvt_pk_bf16(P[u][2 * ks + 1][2], P[u][2 * ks + 1][3])}; pk[ks][u] = *reinterpret_cast<bf16x8*>(&w); } } } while (0)
#define TR7(dst, vb, a, t) asm volatile("ds_read_b64_tr_b16 %0, %1 offset:%2" : "=&v"(dst) : "v"(vb), "i"((a) * 4096 + ((t) >> 1) * 512) : "memory")
#define PV7(so) do { const int vb0_ = vbe + (so), vb1_ = vbo + (so); \
    _Pragma("unroll") for (int t = 0; t < 8; t += 2) { s16x4 e0, e1, e2, e3, f0, f1, f2, f3;          \
        TR7(e0, vb0_, 0, t); TR7(e1, vb0_, 1, t); TR7(e2, vb0_, 2, t); TR7(e3, vb0_, 3, t); TR7(f0, vb1_, 0, t + 1); TR7(f1, vb1_, 1, t + 1); TR7(f2, vb1_, 2, t + 1); TR7(f3, vb1_, 3, t + 1); \
        asm volatile("s_waitcnt lgkmcnt(0)" ::: "memory"); SBAR(); \
        const bf16x8 v0 = (bf16x8){e0[0], e0[1], e0[2], e0[3], e1[0], e1[1], e1[2], e1[3]}, v1 = (bf16x8){e2[0], e2[1], e2[2], e2[3], e3[0], e3[1], e3[2], e3[3]}; \
        const bf16x8 w0 = (bf16x8){f0[0], f0[1], f0[2], f0[3], f1[0], f1[1], f1[2], f1[3]}, w1 = (bf16x8){f2[0], f2[1], f2[2], f2[3], f3[0], f3[1], f3[2], f3[3]}; \
        o[t][0] = MFMA16(v0, pk[0][0], o[t][0]); o[t][1] = MFMA16(v0, pk[0][1], o[t][1]); o[t + 1][0] = MFMA16(w0, pk[0][0], o[t + 1][0]); o[t + 1][1] = MFMA16(w0, pk[0][1], o[t + 1][1]); \
        o[t][0] = MFMA16(v1, pk[1][0], o[t][0]); o[t][1] = MFMA16(v1, pk[1][1], o[t][1]); o[t + 1][0] = MFMA16(w1, pk[1][0], o[t + 1][0]); o[t + 1][1] = MFMA16(w1, pk[1][1], o[t + 1][1]); } } while (0)
    f32x4_t pA[2][4], pB[2][4]; bf16x8 pk[2][2];
    negm[0] = negm[1] = (f32x4_t){0.f, 0.f, 0.f, 0.f};
    int s_prev = 0, s_cur = SLOT, s_next = 2 * SLOT;
    DMA(0, 0); DMA(1, SLOT); TILE_BAR();
    QK7(pA, 0);
#pragma unroll
    for (int u = 0; u < 2; ++u) { float pmax = pA[u][0][0];
#pragma unroll
        for (int a = 0; a < 4; ++a)
#pragma unroll
            for (int r = 0; r < 4; ++r) pmax = fmaxf(pmax, pA[u][a][r]);
        pmax = fmaxf(pmax, __shfl_xor(pmax, 16)); pmax = fmaxf(pmax, __shfl_xor(pmax, 32));
        const float delta = pmax + ATT_MARGIN; negm[u] = (f32x4_t){-delta, -delta, -delta, -delta};
#pragma unroll
        for (int a = 0; a < 4; ++a)
#pragma unroll
            for (int r = 0; r < 4; ++r) pA[u][a][r] -= delta; }
    EXPH7(pA, 0);
    asm volatile(".p2align 6");
    for (int j = 1; j + 1 < NT; j += 2) {
        DMA(j + 1, s_next); SBAR();
        QK7(pB, s_cur); FIN7(pA); SBAR();
        PV7(s_prev); EXPH7(pB, 0); TILE_BAR();
        { const int t = s_prev; s_prev = s_cur; s_cur = s_next; s_next = t; }
        if (j + 2 < NT) DMA(j + 2, s_next); SBAR();
        QK7(pA, s_cur); FIN7(pB); SBAR();
        PV7(s_prev); EXPH7(pA, 0); TILE_BAR();
        { const int t = s_prev; s_prev = s_cur; s_cur = s_next; s_next = t; }
    }
    SBAR(); QK7(pB, s_cur); FIN7(pA); SBAR();
    PV7(s_prev); EXPH7(pB, 0);
    FIN7(pB); SBAR();
    PV7(s_cur);
    float rl[2]; bool okl = true;
#pragma unroll
    for (int u = 0; u < 2; ++u) { float l = l_reg[u]; l += __shfl_xor(l, 16); l += __shfl_xor(l, 32); okl = okl && (l > 0.f) && (l < 1e30f); rl[u] = __builtin_amdgcn_rcpf(l); }
    { const bool okw = __all(okl); if (lane == 0) ((LAS unsigned*)(lds + LDS2_BYTES))[wid] = okw ? 1u : 0u; }
    asm volatile("s_waitcnt vmcnt(0) lgkmcnt(0)\n\ts_barrier" ::: "memory");
    { constexpr int OP = 272; LAS unsigned char* st = lds + wid * (32 * OP);
#pragma unroll
      for (int u = 0; u < 2; ++u)
#pragma unroll
        for (int t = 0; t < 8; ++t) { u32x2 w; w.x = cvt_pk_bf16(o[t][u][0] * rl[u], o[t][u][1] * rl[u]); w.y = cvt_pk_bf16(o[t][u][2] * rl[u], o[t][u][3] * rl[u]);
            *(LAS u32x2*)(st + (16 * u + c16) * OP + (16 * t + 4 * g) * 2) = w; }
      asm volatile("s_waitcnt lgkmcnt(0)" ::: "memory");
      bf16_t* Ow = U.Ob + (size_t)(wid * QBLK) * D;
#pragma unroll
      for (int i = 0; i < 8; ++i) { const int row = (lane >> 4) + 4 * i, ch = lane & 15;
        const u32x4 w = *(const LAS u32x4*)(st + row * OP + ch * 16); *(u32x4*)(Ow + (size_t)row * D + ch * 8) = w; } }
    TILE_BAR();
#undef KROW
#undef DMA
#undef TILE_BAR
#undef MFMA16
#undef QK7
#undef EXPH7
#undef FIN7
#undef PV7
#undef TR7
}

#ifndef ATT_FAST_FIRST
#define ATT_FAST_FIRST 1
#endif
#ifndef ATT_FORCE_SAFE
#define ATT_FORCE_SAFE 0
#endif
__device__ __forceinline__ void attn_unit_auto(const Unit& U, const bf16_t* __restrict__ KR, const float* __restrict__ ropetab, LAS unsigned char* lds) {
#if ATT_FAST_FIRST
    attn_unit7(U, KR, ropetab, lds);
    const LAS unsigned* fl = (const LAS unsigned*)(lds + LDS2_BYTES);
    unsigned okc = 0; for (int w = 0; w < NWAVES; ++w) okc += fl[w];
    if (ATT_FORCE_SAFE || __builtin_amdgcn_readfirstlane(okc) != (unsigned)NWAVES) attn_unit6<false>(U, KR, ropetab, lds);
#else
    attn_unit6<false>(U, KR, ropetab, lds);
#endif
}
}
constexpr size_t MiB = 1u << 20;
constexpr int CW_TMO = 0, CW_BAR = 4096;
constexpr int KSPL = 16;
constexpr size_t WS_CTL = 0;
constexpr size_t WS_MOD = 64 * 1024;
constexpr size_t WS_SSQ = 1 * MiB;
constexpr size_t CTL_ZERO_BYTES = 64 * 1024;
constexpr size_t WS_ROPE = 3 * MiB;
constexpr size_t WS_W13 = 4 * MiB;
constexpr size_t WS_W2 = 180 * MiB;
constexpr size_t WS_WPOOL = 268 * MiB;
constexpr size_t WS_WDQKV = 272 * MiB;
constexpr size_t WS_WUP = 282 * MiB;
constexpr size_t WS_WO = 296 * MiB;
constexpr size_t WS_H = 312 * MiB;
constexpr size_t WS_U = 444 * MiB;
constexpr size_t WS_Y = 510 * MiB;
constexpr size_t WS_P = 576 * MiB;
constexpr size_t WS_G = 642 * MiB;
constexpr size_t WS_CQKV = 824 * MiB;
constexpr size_t WS_Q = 866 * MiB;
constexpr size_t WS_KV = 965 * MiB;
constexpr size_t WS_KR = 1097 * MiB;
constexpr size_t WS_YP = 1100 * MiB;
constexpr size_t WS_MODP2 = 1148 * MiB;
constexpr size_t WS_END = 1176 * MiB;
static_assert(WS_W13 + (size_t)4 * 11264 * 2048 * 2 <= WS_W2 && WS_W2 + (size_t)4 * 2048 * 5632 * 2 <= WS_WPOOL && WS_H + (size_t)T * D * 4 <= WS_U && WS_U + (size_t)T * D * 2 <= WS_Y, "ws map");
static_assert(WS_G + (size_t)T * DFF * 2 <= WS_CQKV && WS_CQKV + (size_t)T * NDQKV * 2 <= WS_Q && WS_Q + (size_t)T * NQ * 2 <= WS_KV && WS_KV + (size_t)T * NKV * 2 <= WS_KR && WS_KR + (size_t)T * ROPED * 2 <= WS_YP && WS_YP + (size_t)11 * TC * D * 4 <= WS_MODP2 && WS_MODP2 + (size_t)3 * 64 * 3 * NMOD * 4 <= WS_END, "ws map");
static_assert(WS_MOD + (size_t)4 * 3 * NMOD * 4 <= WS_SSQ && WS_SSQ + (size_t)16 * T * 4 <= WS_ROPE && (CW_BAR + 3456) * 4 <= (int)CTL_ZERO_BYTES, "ctl map");

constexpr int RING_BYTES = 131072, MISC_OFF = RING_BYTES, LDS_BYTES = 147456;
static_assert(att::LDS_BYTES <= RING_BYTES && att::LDS2_BYTES + 64 <= RING_BYTES, "attention LDS");

#define XB_TMO      128
#define XB_XCNT(j)  (256  + 64 * (j))
#define XB_XSUB(j)  (1280 + 64 * (j))
#define XB_XGEN(j)  (2304 + 64 * (j))
#define XB_TOP      3328
#define XB_TOPGEN   3392
#define XCD_BAR_WORDS 3456
#define XB_SPIN_CAP (1u << 22)
__device__ __forceinline__ unsigned xb_ld(unsigned* p)              { return __hip_atomic_load(p, __ATOMIC_RELAXED, __HIP_MEMORY_SCOPE_AGENT); }
__device__ __forceinline__ unsigned xb_add(unsigned* p, unsigned v) { return __hip_atomic_fetch_add(p, v, __ATOMIC_RELAXED, __HIP_MEMORY_SCOPE_AGENT); }
__device__ __forceinline__ unsigned xb_xcc_id() { return (unsigned)__builtin_amdgcn_s_getreg((3 << 11) | 20) & 0xFu; }
#define XB_SPIN(cond, bar) do { unsigned _sp = 0; while (cond) { __builtin_amdgcn_s_sleep(1); \
    if ((++_sp & 255u) == 0u) { if (xb_ld(&(bar)[XB_TMO])) break; if (_sp > XB_SPIN_CAP) { atomicAdd(&(bar)[XB_TMO], 1u); break; } } } } while (0)
struct XcdBarrier { unsigned* bar; unsigned x; volatile LAS unsigned* st; };
__device__ __forceinline__ XcdBarrier xcd_barrier_post(unsigned* bar, volatile LAS unsigned* st) {
    XcdBarrier b; b.bar = bar; b.x = xb_xcc_id(); b.st = st;
    if (threadIdx.x == 0) (void)xb_add(&bar[XB_XCNT(b.x)], 1u);
    return b;
}
__device__ __forceinline__ void xcd_barrier_complete(unsigned* bar, unsigned x, unsigned& nloc, unsigned& nx) {
    const unsigned G = gridDim.x * gridDim.y * gridDim.z;
    unsigned sum, cnt, mine, sp = 0u;
    for (;;) {
        sum = 0u; cnt = 0u; mine = 0u;
#pragma unroll
        for (unsigned j = 0; j < 16; ++j) { const unsigned c = xb_ld(&bar[XB_XCNT(j)]); sum += c; cnt += (c > 0u) ? 1u : 0u; mine = (j == x) ? c : mine; }
        if (sum == G) break;
        __builtin_amdgcn_s_sleep(1);
        if ((++sp & 255u) == 0u) { if (xb_ld(&bar[XB_TMO])) break; if (sp > XB_SPIN_CAP) { atomicAdd(&bar[XB_TMO], 1u); break; } }
    }
    nloc = mine > 0u ? mine : 1u; nx = cnt > 0u ? cnt : 1u;
}
__device__ __forceinline__ void xcd_barrier(const XcdBarrier& b) {
    asm volatile("s_waitcnt vmcnt(0)" ::: "memory");
    __syncthreads();
    if (threadIdx.x == 0) {
        unsigned* bar = b.bar; asm volatile("" : "+s"(bar));
        __builtin_amdgcn_s_waitcnt(0);
        const unsigned bx = xb_xcc_id();
        unsigned nloc = b.st[0], nx = b.st[1];
        if (nloc == 0u) { xcd_barrier_complete(bar, bx, nloc, nx); b.st[0] = nloc; b.st[1] = nx; }
        const unsigned old = xb_add(&bar[XB_XSUB(bx)], 1u);
        const unsigned gen = old / nloc;
        if (old + 1u == (gen + 1u) * nloc) {
            __builtin_amdgcn_fence(__ATOMIC_RELEASE, "agent");
            asm volatile("s_waitcnt vmcnt(0)" ::: "memory");
            const unsigned og = xb_add(&bar[XB_TOP], 1u);
            const unsigned tg = og / nx;
            if (og + 1u == (tg + 1u) * nx) xb_add(&bar[XB_TOPGEN], 1u);
            else XB_SPIN(xb_ld(&bar[XB_TOPGEN]) == tg, bar);
            __builtin_amdgcn_fence(__ATOMIC_ACQUIRE, "agent");
            xb_add(&bar[XB_XGEN(bx)], 1u);
            asm volatile("s_waitcnt vmcnt(0)" ::: "memory");
        } else {
            XB_SPIN(xb_ld(&bar[XB_XGEN(bx)]) == gen, bar);
            __builtin_amdgcn_fence(__ATOMIC_ACQUIRE, "agent");
            asm volatile("s_waitcnt vmcnt(0)" ::: "memory");
        }
    }
    __syncthreads();
}

#define LDS_WAIT() asm volatile("s_waitcnt lgkmcnt(0)" ::: "memory")
struct TrD { const float* W; int ldw, k0, n0; bf16_t* WT; int ldt, drow0; const float* ksc; const float* nsc; float mul; };
__device__ __forceinline__ void tr_load(const TrD& d, float (&v)[32], int lane) {
    const float* wp = d.W + (size_t)(d.k0 + (lane >> 5)) * d.ldw + d.n0 + (lane & 31);
#pragma unroll
    for (int i = 0; i < 32; ++i) v[i] = __builtin_nontemporal_load(wp + (size_t)(2 * i) * d.ldw);
}
__device__ __forceinline__ void tr_finish(const TrD& d, float (&v)[32], LAS float* scr, int lane) {
    const float ns = (d.nsc ? d.nsc[d.n0 + (lane & 31)] : 1.f) * d.mul;
    if (d.ksc) {
#pragma unroll
        for (int i = 0; i < 32; ++i) v[i] *= d.ksc[d.k0 + 2 * i + (lane >> 5)]; }
#pragma unroll
    for (int i = 0; i < 32; ++i) scr[(2 * i + (lane >> 5)) * 33 + (lane & 31)] = v[i] * ns;
    LDS_WAIT(); asm volatile("" ::: "memory");
    const int c = lane & 7;
#pragma unroll
    for (int j = 0; j < 4; ++j) { const int n = (lane >> 3) + 8 * j; const LAS float* s = scr + (8 * c) * 33 + n;
        u32x4 o; o.x = cvt_pk_bf16(s[0 * 33], s[1 * 33]); o.y = cvt_pk_bf16(s[2 * 33], s[3 * 33]); o.z = cvt_pk_bf16(s[4 * 33], s[5 * 33]); o.w = cvt_pk_bf16(s[6 * 33], s[7 * 33]);
        *(u32x4*)(d.WT + (size_t)(d.drow0 + n) * d.ldt + d.k0 + 8 * c) = o; }
    LDS_WAIT(); asm volatile("" ::: "memory");
}
struct In {
    const float *x, *c, *ctx, *c_ctx, *ada_w, *ada_b, *norm_g, *pool_w, *pool_scale, *w_dqkv, *q_norm, *w_uq, *kv_norm, *w_ukv, *w_o, *w1, *w3, *w2;
};
constexpr int I_F = (D / 64) * (DFF / 32);
constexpr int I_P = (512 / 64) * (512 / 32);
constexpr int I_DQ = (D / 64) * (1088 / 32);
constexpr int I_UQ = (QL / 64) * (NQ / 32), I_UKV = (KVL / 64) * (NKV / 32);
constexpr int I_O = (D / 64) * (D / 32);
constexpr int SEG0 = 0;
constexpr int SEG1 = SEG0 + 3 * I_F + 8 * I_P + 2 * I_DQ;
constexpr int SEG2 = SEG1 + 3 * I_F;
constexpr int SEG3 = SEG2 + I_UQ + I_UKV + I_O;
constexpr int SEG4 = SEG3 + 3 * I_F;
constexpr int SEG5 = SEG4 + 2 * I_F;
constexpr int SEG6 = SEG5 + I_UQ + I_UKV + I_O + I_F;
__device__ __forceinline__ TrD d_ffn(const In& I, unsigned char* ws, int l, int which, int item) {
    if (which < 2) { const int nblk = DFF / 32, kb = item / nblk, nb = item % nblk, n0 = nb * 32;
        return TrD{(which ? I.w3 : I.w1) + (size_t)l * D * DFF, DFF, kb * 64, n0, (bf16_t*)(ws + WS_W13) + (size_t)l * 2 * DFF * D, D, 256 * (n0 >> 7) + 128 * which + (n0 & 127), nullptr, nullptr, 1.f}; }
    const int nblk = D / 32, kb = item / nblk, nb = item % nblk;
    return TrD{I.w2 + (size_t)l * DFF * D, D, kb * 64, nb * 32, (bf16_t*)(ws + WS_W2) + (size_t)l * D * DFF, DFF, nb * 32, nullptr, nullptr, 1.f};
}
__device__ __forceinline__ TrD d_pool(const In& I, unsigned char* ws, int r) { const int jg = r / I_P, item = r % I_P, j = jg >> 2, g = jg & 3, nblk = 512 / 32, kb = item / nblk, nb = item % nblk;
    return TrD{I.pool_w + (size_t)jg * 512 * 512, 512, kb * 64, nb * 32, (bf16_t*)(ws + WS_WPOOL) + (size_t)j * D * 512, 512, g * 512 + nb * 32, nullptr, I.pool_scale + j * D + g * 512, 1.f}; }
__device__ __forceinline__ TrD d_dq(const In& I, unsigned char* ws, int j, int item) { const int nblk = 1088 / 32, kb = item / nblk, nb = item % nblk;
    return TrD{I.w_dqkv + (size_t)j * D * 1088, 1088, kb * 64, nb * 32, (bf16_t*)(ws + WS_WDQKV) + (size_t)j * NDQKV * D, D, nb * 32, nullptr, nullptr, 1.f}; }
__device__ __forceinline__ TrD d_uq(const In& I, unsigned char* ws, int j, int item) { const int nblk = NQ / 32, kb = item / nblk, nb = item % nblk;
    return TrD{I.w_uq + (size_t)j * QL * NQ, NQ, kb * 64, nb * 32, (bf16_t*)(ws + WS_WUP) + (size_t)j * NUP * 512, 512, nb * 32, I.q_norm + j * QL, nullptr, att::SCALE * 1.4426950408889634f}; }
__device__ __forceinline__ TrD d_ukv(const In& I, unsigned char* ws, int j, int item) { const int nblk = NKV / 32, kb = item / nblk, nb = item % nblk;
    return TrD{I.w_ukv + (size_t)j * KVL * NKV, NKV, kb * 64, nb * 32, (bf16_t*)(ws + WS_WUP) + (size_t)j * NUP * 512, 512, NQ + nb * 32, I.kv_norm + j * KVL, nullptr, 1.f}; }
__device__ __forceinline__ TrD d_o(const In& I, unsigned char* ws, int j, int item) { const int nblk = D / 32, kb = item / nblk, nb = item % nblk;
    return TrD{I.w_o + (size_t)j * D * D, D, kb * 64, nb * 32, (bf16_t*)(ws + WS_WO) + (size_t)j * D * D, D, nb * 32, nullptr, nullptr, 1.f}; }
__device__ __forceinline__ TrD tr_desc(const In& I, unsigned char* ws, int r) {
#define PIECE(cnt, expr) if (r < (cnt)) return expr; r -= (cnt);
    PIECE(I_F, d_ffn(I, ws, 0, 0, r)) PIECE(I_F, d_ffn(I, ws, 0, 1, r)) PIECE(I_F, d_ffn(I, ws, 0, 2, r)) PIECE(8 * I_P, d_pool(I, ws, r)) PIECE(I_DQ, d_dq(I, ws, 0, r)) PIECE(I_DQ, d_dq(I, ws, 1, r))
    PIECE(I_F, d_ffn(I, ws, 1, 0, r)) PIECE(I_F, d_ffn(I, ws, 1, 1, r)) PIECE(I_F, d_ffn(I, ws, 1, 2, r))
    PIECE(I_UQ, d_uq(I, ws, 0, r)) PIECE(I_UKV, d_ukv(I, ws, 0, r)) PIECE(I_O, d_o(I, ws, 0, r))
    PIECE(I_F, d_ffn(I, ws, 2, 0, r)) PIECE(I_F, d_ffn(I, ws, 2, 1, r)) PIECE(I_F, d_ffn(I, ws, 2, 2, r))
    PIECE(I_F, d_ffn(I, ws, 3, 0, r)) PIECE(I_F, d_ffn(I, ws, 3, 1, r))
    PIECE(I_UQ, d_uq(I, ws, 1, r)) PIECE(I_UKV, d_ukv(I, ws, 1, r)) PIECE(I_O, d_o(I, ws, 1, r))
    return d_ffn(I, ws, 3, 2, r);
#undef PIECE
}
__device__ __forceinline__ void tr_run(const In& I, unsigned char* ws, int seg_lo, int seg_n, int v, int vs, LAS float* scr, int lane) {
    float vA[32], vB[32]; TrD dA, dB; int it = v;
    if (it < seg_n) { dA = tr_desc(I, ws, seg_lo + it); tr_load(dA, vA, lane); }
    while (it < seg_n) {
        int itn = it + vs;
        if (itn < seg_n) { dB = tr_desc(I, ws, seg_lo + itn); tr_load(dB, vB, lane); }
        tr_finish(dA, vA, scr, lane);
        it = itn; if (it >= seg_n) break;
        itn = it + vs;
        if (itn < seg_n) { dA = tr_desc(I, ws, seg_lo + itn); tr_load(dA, vA, lane); }
        tr_finish(dB, vB, scr, lane);
        it = itn;
    }
}
#ifndef GEMV_DEFER
#define GEMV_DEFER 0
#endif
constexpr int KSPL2 = 64;
template <int KLEN>
__device__ __forceinline__ void gemv_task(const In& I, float* outp, int l, int st, int k0, int lane) {
    constexpr int NHALF = (KLEN + 63) / 64, HL = KLEN < 64 ? KLEN : 64;
    float sv[3][NHALF];
#pragma unroll
    for (int h = 0; h < NHALF; ++h) { const int k = k0 + h * 64 + (lane % HL); const float c0 = I.c[k], c1 = I.c[D + k], c2 = I.c_ctx[k];
        sv[0][h] = c0 / (1.f + __expf(-c0)); sv[1][h] = c1 / (1.f + __expf(-c1)); sv[2][h] = c2 / (1.f + __expf(-c2)); }
    const float* wp = I.ada_w + ((size_t)l * D + k0) * NMOD + st * 256 + lane * 4;
    f32x4 a0 = {0.f, 0.f, 0.f, 0.f}, a1 = a0, a2 = a0;
#pragma unroll
    for (int h = 0; h < NHALF; ++h)
#pragma unroll (KLEN < 64 ? 16 : 8)
        for (int kk = 0; kk < HL; ++kk) { const f32x4 w = __builtin_nontemporal_load((const f32x4*)(wp + (size_t)(h * 64 + kk) * NMOD));
            a0 += w * __shfl(sv[0][h], kk); a1 += w * __shfl(sv[1][h], kk); a2 += w * __shfl(sv[2][h], kk); }
    float* mp = outp + st * 256 + lane * 4;
    *(f32x4*)mp = a0; *(f32x4*)(mp + NMOD) = a1; *(f32x4*)(mp + 2 * NMOD) = a2;
}
__device__ __forceinline__ void filler(const In& I, unsigned char* ws, int gl, int seg_lo, int seg_n, int fi, int fn, LAS float* scr, int lane) {
    int v = fi;
    if (gl > 0) { constexpr int NG2 = (NMOD / 256) * KSPL2; float* mp2 = (float*)(ws + WS_MODP2) + (size_t)(gl - 1) * KSPL2 * 3 * NMOD;
#if GEMV_TWICE
        if (gl == 2) for (int v2 = fi; v2 < NG2; v2 += fn) { const int ks = v2 % KSPL2, st = v2 / KSPL2; gemv_task<D / KSPL2>(I, mp2 + (size_t)ks * 3 * NMOD, gl, st, ks * (D / KSPL2), lane); }
#endif
        for (; v < NG2; v += fn) { const int ks = v % KSPL2, st = v / KSPL2; gemv_task<D / KSPL2>(I, mp2 + (size_t)ks * 3 * NMOD, gl, st, ks * (D / KSPL2), lane); }
        v -= NG2; }
    tr_run(I, ws, seg_lo, seg_n, v, fn, scr, lane);
}

__device__ __forceinline__ void prologue(const In& I, unsigned char* ws, LAS unsigned char* lds, int gw, int ngw, int wave, int lane, int gtid, int ngt) {
    LAS float* scr = (LAS float*)(lds + wave * 16384);
    bf16_t* WDQKV = (bf16_t*)(ws + WS_WDQKV);
    tr_run(I, ws, SEG0, SEG1 - SEG0, gw, ngw, scr, lane);
    { constexpr int PER = (NDQKV - 1088) * D / 8;
        for (int i = gtid; i < 2 * PER; i += ngt) { const int j = i / PER, q = i % PER; *(u32x4*)(WDQKV + (size_t)j * NDQKV * D + (size_t)1088 * D + (size_t)q * 8) = (u32x4){0u, 0u, 0u, 0u}; } }
    if (gtid < 128 * 16) { const int pos = gtid >> 4, f = gtid & 15; const float inv = powf(10000.f, -(float)(2 * f) / 32.f), ang = (float)pos * inv;
        float* tab = (float*)(ws + WS_ROPE); tab[gtid * 2] = cosf(ang); tab[gtid * 2 + 1] = sinf(ang); }
    { float* MODP = (float*)(ws + WS_G); constexpr int NSTRIP = NMOD / 256, KLEN = D / KSPL;
        for (int task = gw; task < (GEMV_DEFER ? 2 : 4) * NSTRIP * KSPL; task += ngw) { const int ks = task % KSPL, st = (task / KSPL) % NSTRIP, l = task / (KSPL * NSTRIP);
            gemv_task<KLEN>(I, MODP + (size_t)ks * 12 * NMOD + (size_t)l * 3 * NMOD, l, st, ks * KLEN, lane); } }
}

struct RN { const float* xin_lat; const float* xin_ctx; const bf16_t* hin; const bf16_t* Y; const float* Yp; int nparts; const float* gate; const float* gY; bf16_t* hout; float* fout;
            const float* gN; const float* shift; const float* scale; bf16_t* U; int nrows; const float* modp; const float* bias; float* mod_out; };
template <bool HAS_Y, bool WRITE_U, bool HIN_F32, bool HOUT_F32, bool MODP_IN = false, bool POOLY = false>
__device__ __forceinline__ void resid_norm(const RN& a, LAS unsigned char* lds, int gw, int ngw, int tid) {
    asm volatile("" : "+v"(tid)); const int lane = tid & 63;
    typedef const GAS char* gcp; typedef GAS char* gp;
    if (MODP_IN) {
        for (int i = (gw * 64 + lane); i < (GEMV_DEFER ? 6 : 12) * NMOD / 4; i += ngw * 64) { f32x4 acc = *(const GAS f32x4*)((gcp)a.bias + 16 * ((size_t)(i / (3 * NMOD / 4)) * (NMOD / 4) + i % (NMOD / 4)));
            for (int p = 0; p < KSPL; ++p) acc += *(const GAS f32x4*)((gcp)a.modp + ((size_t)p * 12 * NMOD + (size_t)i * 4) * 4);
            *(GAS f32x4*)((gp)a.mod_out + (size_t)i * 16) = acc; } }
    for (int i = tid; i < 3 * (D / 4); i += NTHREADS) { const int s = i / (D / 4), c4 = i % (D / 4); LAS f32x4* t = (LAS f32x4*)(lds + s * 24576) + c4;
        if (HAS_Y) t[0] = *(const GAS f32x4*)((gcp)(a.gate + (size_t)s * NMOD) + 16 * c4) * *(const GAS f32x4*)((gcp)a.gY + 16 * c4);
        if (WRITE_U) { f32x4 sc, sh;
            if (MODP_IN) { sh = *(const GAS f32x4*)((gcp)a.bias + 16 * c4); sc = *(const GAS f32x4*)((gcp)a.bias + 16 * (D / 4 + c4));
                for (int p = 0; p < KSPL; ++p) { const float* mp = a.modp + (size_t)p * 12 * NMOD + (size_t)s * NMOD; sh += *(const GAS f32x4*)((gcp)mp + 16 * c4); sc += *(const GAS f32x4*)((gcp)mp + 16 * (D / 4 + c4)); } }
            else { sc = *(const GAS f32x4*)((gcp)(a.scale + (size_t)s * NMOD) + 16 * c4); sh = *(const GAS f32x4*)((gcp)(a.shift + (size_t)s * NMOD) + 16 * c4); }
            t[D / 4] = *(const GAS f32x4*)((gcp)a.gN + 16 * c4) * (sc + 1.f); t[2 * (D / 4)] = sh; } }
    __syncthreads();
    const unsigned l16 = (unsigned)lane * 16u, l8 = (unsigned)lane * 8u;
    const int nrows = a.nrows, nparts = a.nparts;
#define LDF4(base, j) (*(const GAS f32x4*)((gcp)(base) + l16 + 1024u * (j)))
#define LDB4(base, j) (*(const GAS u32x2*)((gcp)(base) + l8 + 512u * (j)))
#define UNPK(w) ((f32x4){bf_lo((w).x), bf_hi((w).x), bf_lo((w).y), bf_hi((w).y)})
#define RN_LOAD(hf, hw, yw, r) do { \
        if (HIN_F32) { const float* hp_ = (r) < TL ? a.xin_lat + (size_t)(r) * D : a.xin_ctx + (size_t)((r) - TL) * D; _Pragma("unroll") for (int j = 0; j < 8; ++j) hf[j] = LDF4(hp_, j); } \
        else { const bf16_t* hp_ = a.hin + (size_t)(r) * D; _Pragma("unroll") for (int j = 0; j < 8; ++j) hw[j] = LDB4(hp_, j); } \
        if (HAS_Y && !POOLY && !((r) >= TL && nparts > 0)) { const bf16_t* yr_ = a.Y + (size_t)(r) * D; _Pragma("unroll") for (int j = 0; j < 8; ++j) yw[j] = LDB4(yr_, j); } } while (0)
#define RN_PROC(hf, hw, yw, r) do { const int s_ = (r) < SEQ ? 0 : ((r) < TL ? 1 : 2); const LAS f32x4* tb_ = (const LAS f32x4*)(lds + s_ * 24576) + lane; f32x4 h[8]; \
        _Pragma("unroll") for (int j = 0; j < 8; ++j) h[j] = HIN_F32 ? hf[j] : UNPK(hw[j]); \
        if (HAS_Y) { f32x4 y[8]; float sy = 0.f; \
            if (POOLY) {   \
                int sb_, L_; if ((r) < TL) { sb_ = ((r) / SEQ) * SEQ; L_ = SEQ; } else { sb_ = TL + (((r) - TL) / CTXL) * CTXL; L_ = CTXL; } const int t_ = (r) - sb_; const bf16_t* zs_ = a.Y + (size_t)sb_ * D; \
                _Pragma("unroll") for (int g = 0; g < 4; ++g) { const int w2_ = 1 << g, lo_ = max(t_ - w2_, 0), hi_ = min(t_ + w2_, L_); const float inv_ = 1.f / (float)(hi_ - lo_); \
                    f32x4 s0_ = {0.f, 0.f, 0.f, 0.f}, s1_ = s0_; \
                    _Pragma("unroll") for (int i = 0; i < 2 * w2_; ++i) { const int q_ = t_ - w2_ + i; const bool ok_ = q_ >= 0 && q_ < L_; const bf16_t* zr_ = zs_ + (size_t)(ok_ ? q_ : t_) * D; \
                        const u32x2 wa_ = LDB4(zr_, 2 * g), wb_ = LDB4(zr_, 2 * g + 1); const float m_ = ok_ ? 1.f : 0.f; s0_ += UNPK(wa_) * m_; s1_ += UNPK(wb_) * m_; } \
                    const bf16_t* zc_ = zs_ + (size_t)t_ * D; const u32x2 ca_ = LDB4(zc_, 2 * g), cb_ = LDB4(zc_, 2 * g + 1); y[2 * g] = s0_ * inv_ - UNPK(ca_); y[2 * g + 1] = s1_ * inv_ - UNPK(cb_); } } \
            else if ((r) >= TL && nparts > 0) { _Pragma("unroll") for (int j = 0; j < 8; ++j) y[j] = (f32x4){0.f, 0.f, 0.f, 0.f}; \
                for (int p = 0; p < nparts; ++p) { const float* yp_ = a.Yp + ((size_t)p * TC + ((r) - TL)) * D; _Pragma("unroll") for (int j = 0; j < 8; ++j) y[j] += LDF4(yp_, j); } } \
            else { _Pragma("unroll") for (int j = 0; j < 8; ++j) y[j] = UNPK(yw[j]); } \
            _Pragma("unroll") for (int j = 0; j < 8; ++j) sy += (y[j][0] * y[j][0] + y[j][1] * y[j][1]) + (y[j][2] * y[j][2] + y[j][3] * y[j][3]); \
            const float rs_ = __builtin_amdgcn_rsqf(wave_sum(sy) * (1.f / D) + RMS_EPS); \
            _Pragma("unroll") for (int j = 0; j < 8; ++j) h[j] += tb_[64 * j] * (y[j] * rs_); } \
        if (HOUT_F32) { float* op_ = a.fout + (size_t)(r) * D; _Pragma("unroll") for (int j = 0; j < 8; ++j) __builtin_nontemporal_store(h[j], (GAS f32x4*)((gp)op_ + l16 + 1024u * j)); } \
        else if (a.hout) { bf16_t* op_ = a.hout + (size_t)(r) * D; _Pragma("unroll") for (int j = 0; j < 8; ++j) { u32x2 w; w.x = cvt_pk_bf16(h[j][0], h[j][1]); w.y = cvt_pk_bf16(h[j][2], h[j][3]); *(GAS u32x2*)((gp)op_ + l8 + 512u * j) = w; } } \
        if (WRITE_U) { float ss = 0.f; \
            _Pragma("unroll") for (int j = 0; j < 8; ++j) ss += (h[j][0] * h[j][0] + h[j][1] * h[j][1]) + (h[j][2] * h[j][2] + h[j][3] * h[j][3]); \
            const float rstd_ = __builtin_amdgcn_rsqf(wave_sum(ss) * (1.f / D) + RMS_EPS); bf16_t* ur_ = a.U + (size_t)(r) * D; \
            _Pragma("unroll") for (int j = 0; j < 8; ++j) { const f32x4 u = (h[j] * rstd_) * tb_[D / 4 + 64 * j] + tb_[2 * (D / 4) + 64 * j]; u32x2 w; w.x = cvt_pk_bf16(u[0], u[1]); w.y = cvt_pk_bf16(u[2], u[3]); \
                *(GAS u32x2*)((gp)ur_ + l8 + 512u * j) = w; } } } while (0)
    f32x4 hfA[8], hfB[8], hfC[8]; u32x2 hwA[8], hwB[8], hwC[8], ywA[8], ywB[8], ywC[8];
    int r = POOLY ? gw : (gw % NWAVES) * (ngw / NWAVES) + gw / NWAVES;
    if (r < nrows) RN_LOAD(hfA, hwA, ywA, r);
    if (r + ngw < nrows) RN_LOAD(hfB, hwB, ywB, r + ngw);
    while (r < nrows) {
        if (r + 2 * ngw < nrows) RN_LOAD(hfC, hwC, ywC, r + 2 * ngw);
        RN_PROC(hfA, hwA, ywA, r);
        r += ngw; if (r >= nrows) break;
        if (r + 2 * ngw < nrows) RN_LOAD(hfA, hwA, ywA, r + 2 * ngw);
        RN_PROC(hfB, hwB, ywB, r);
        r += ngw; if (r >= nrows) break;
        if (r + 2 * ngw < nrows) RN_LOAD(hfB, hwB, ywB, r + 2 * ngw);
        RN_PROC(hfC, hwC, ywC, r);
        r += ngw;
    }
#undef LDF4
#undef LDB4
#undef UNPK
#undef RN_LOAD
#undef RN_PROC
    __syncthreads();
}

__device__ __forceinline__ void krope_phase(const bf16_t* __restrict__ CQKV, bf16_t* __restrict__ KR, const float* __restrict__ tab, int gtid, int ngt) {
    asm volatile("" : "+v"(gtid));
    for (int i = gtid; i < T * 32; i += ngt) { const int r = i >> 5, ax = (i >> 4) & 1, f = i & 15;
        const bf16_t* src = CQKV + (size_t)r * NDQKV + 1024 + ax * 32 + f; const float x1 = bf_lo((unsigned)src[0]), x2 = bf_lo((unsigned)src[16]); float o1 = x1, o2 = x2;
        if (r < TL) { const int t = r & (SEQ - 1), pos = ax ? (t & 63) : (t >> 6); const float c = tab[(pos * 16 + f) * 2], s = tab[(pos * 16 + f) * 2 + 1]; o1 = x1 * c - x2 * s; o2 = x2 * c + x1 * s; }
        bf16_t* dst = KR + (size_t)r * ROPED + ax * 32 + f; dst[0] = (bf16_t)(cvt_pk_bf16(o1, 0.f) & 0xffffu); dst[16] = (bf16_t)(cvt_pk_bf16(o2, 0.f) & 0xffffu); }
}

#ifndef EN_P0
#define EN_P0 1
#endif
#ifndef EN_P1
#define EN_P1 1
#endif
#ifndef EN_S0
#define EN_S0 1
#endif
#ifndef EN_S1
#define EN_S1 1
#endif
#ifndef EN_S2
#define EN_S2 1
#endif
#ifndef EN_S3
#define EN_S3 1
#endif
#ifndef EN_S4
#define EN_S4 1
#endif
#ifndef EN_S5
#define EN_S5 1
#endif
#ifndef EN_S6
#define EN_S6 1
#endif
#ifndef EN_S7
#define EN_S7 1
#endif
struct Args { const float* in[18]; float* out; unsigned char* ws; int ph_lo, ph_hi; };
constexpr int N_PHASES = 34;
constexpr int SPLIT_POOL = 2, SPLIT_WO = 8, SPLIT_FFN2 = 11;

__global__ void __launch_bounds__(NTHREADS, 2) mk_fwd(Args args) {
    extern __shared__ __attribute__((aligned(16))) unsigned char lds_raw[];
    LAS unsigned char* lds = (LAS unsigned char*)lds_raw;
    volatile LAS unsigned* MISC = (volatile LAS unsigned*)(lds + MISC_OFF);
    const int G0 = gridDim.x, bid0 = blockIdx.x;
    unsigned char* ws = args.ws;
    for (int u = threadIdx.x; u < (LDS_BYTES - MISC_OFF) / 4; u += NTHREADS) ((LAS unsigned*)(lds + MISC_OFF))[u] = 0u;
    __syncthreads();
#if MK_PER_PHASE
    const int lo = args.ph_lo, hi = args.ph_hi;
#else
    constexpr int lo = 0, hi = N_PHASES;
#endif
    const bool use_bar = (hi - lo) > 1;
    XcdBarrier bar; bar.bar = (unsigned*)(ws + WS_CTL) + CW_BAR; bar.x = 0; bar.st = MISC + 8;
    if (use_bar) bar = xcd_barrier_post((unsigned*)(ws + WS_CTL) + CW_BAR, MISC + 8);
#define IN(k) (lo <= (k) && (k) < hi)
#define PHASE_END(k) do { if (hi > (k) + 1) xcd_barrier(bar); } while (0)
#define SITE() int tid = threadIdx.x, G = G0, bid = bid0; asm volatile("" : "+v"(tid), "+s"(G), "+s"(bid)); const int lane = tid & 63, wave = __builtin_amdgcn_readfirstlane(tid >> 6), gw = bid * NWAVES + wave, gtid = bid * NTHREADS + tid, ngw = G * NWAVES, ngt = G * NTHREADS; \
               (void)lane; (void)gw; (void)gtid; (void)ngw; (void)ngt; const __attribute__((address_space(4))) char* kp_ = (const __attribute__((address_space(4))) char*)__builtin_amdgcn_kernarg_segment_ptr(); asm volatile("" : "+s"(kp_)); \
               unsigned char* wsl = *(unsigned char* const __attribute__((address_space(4)))*)(kp_ + 19 * 8); asm volatile("" : "+s"(wsl))
#define KIN(k) (*(const float* const __attribute__((address_space(4)))*)(kp_ + (k) * 8))
#define KOUT() (*(float* const __attribute__((address_space(4)))*)(kp_ + 18 * 8))
#define WP(type, off) ((type*)(wsl + (off)))
#define MKIN() In I; I.x = KIN(0); I.c = KIN(1); I.ctx = KIN(2); I.c_ctx = KIN(3); I.ada_w = KIN(4); I.ada_b = KIN(5); I.norm_g = KIN(6); I.pool_w = KIN(7); \
               I.pool_scale = KIN(8); I.w_dqkv = KIN(9); I.q_norm = KIN(10); I.w_uq = KIN(11); I.kv_norm = KIN(12); I.w_ukv = KIN(13); I.w_o = KIN(14); I.w1 = KIN(15); I.w3 = KIN(16); I.w2 = KIN(17)
#define FILL_TAIL(gl, seg_lo, seg_hi) do { const int nshort_ = S.nwg % G; if (bid >= nshort_) { __syncthreads(); MKIN();   \
               filler(I, wsl, (gl), (seg_lo), (seg_hi) - (seg_lo), (bid - nshort_) * NWAVES + wave, (G - nshort_) * NWAVES, (LAS float*)(lds + wave * 16384), lane); } } while (0)

    if (EN_P0 && IN(0)) { SITE();
        MKIN();
        prologue(I, wsl, lds, gw, ngw, wave, lane, gtid, ngt); PHASE_END(0); }
    if (EN_P1 && IN(1)) { SITE();
        RN a; a.xin_lat = KIN(0); a.xin_ctx = KIN(2); a.hin = nullptr; a.Y = nullptr; a.Yp = nullptr; a.nparts = 0; a.gate = nullptr; a.gY = nullptr; a.hout = nullptr; a.fout = nullptr;
        a.gN = KIN(6); a.shift = nullptr; a.scale = nullptr; a.U = WP(bf16_t, WS_U); a.nrows = T; a.modp = WP(const float, WS_G); a.bias = KIN(5); a.mod_out = WP(float, WS_MOD);
        resid_norm<false, true, true, false, true>(a, lds, gw, ngw, tid); PHASE_END(1); }

    for (int L = 0; L < 4; ++L) {
        const int base = 2 + 8 * L, j = L >> 1; const bool pool = (L & 1) == 0;
        const int Mrows = (L == 3) ? TL : T;
        if (EN_S0 && !pool && IN(base + 0)) { SITE(); float* SSQ = WP(float, WS_SSQ);
            pg8::Gemm g{WP(const bf16_t, WS_U), WP(const bf16_t, WS_WDQKV) + (size_t)j * NDQKV * D, T, NDQKV, D, D, D}; pg8::StaticOrder S; S.init(T, NDQKV, D, G, bid);
            pg8::EpiStore E{WP(bf16_t, WS_CQKV), NDQKV, SSQ, SSQ + (size_t)8 * T, 2, 4, 0, 0};
            pg8::gemm_phase<pg8::EpiStore, pg8::StaticOrder>(lds, g, S, E);
            { const int lo_ = L == 1 ? SEG2 : SEG5, hi_ = L == 1 ? SEG3 : SEG6; FILL_TAIL(GEMV_DEFER && L == 1 ? 2 : 0, lo_, hi_); }
            PHASE_END(base + 0); }
        if (EN_S1 && !pool && IN(base + 1)) { SITE(); float* SSQ = WP(float, WS_SSQ);
            krope_phase(WP(const bf16_t, WS_CQKV), WP(bf16_t, WS_KR), WP(const float, WS_ROPE), gtid, ngt);
            pg8::Gemm g{WP(const bf16_t, WS_CQKV), WP(const bf16_t, WS_WUP) + (size_t)j * NUP * 512, T, NUP, 512, NDQKV, 512}; pg8::StaticOrder S; S.init(T, NUP, 512, G, bid);
            pg8::EpiUp E{WP(bf16_t, WS_Q), WP(bf16_t, WS_KV), SSQ, SSQ + (size_t)8 * T};
            pg8::gemm_phase<pg8::EpiUp, pg8::StaticOrder>(lds, g, S, E);
            PHASE_END(base + 1); }
        if (EN_S2 && !pool && IN(base + 2)) { SITE();
            const bf16_t* Qb = WP(const bf16_t, WS_Q); const bf16_t* KV = WP(const bf16_t, WS_KV); bf16_t* P = WP(bf16_t, WS_P);
            const int nlat = NB * NH * (SEQ / 256), nunits = nlat + (L == 1 ? NB * NH : 0);
            for (int u = bid; u < nunits; u += G) {
                att::Unit A;
                if (u < nlat) { const int pair = (u >> 8) * 8 + (u & 7), qb = (u & 255) >> 3, b = pair >> 4, h = pair & 15; const int row0 = b * SEQ + qb * 256;
                    A.Qb = Qb + (size_t)row0 * NQ + h * QKD; A.KVh = KV + h * 256; A.Ob = P + (size_t)row0 * D + h * VD; A.kb_lat = b * SEQ; A.nt_lat = SEQ / 64; A.kb_ctx = TL + b * CTXL; A.NT = SEQ / 64 + CTXL / 64; A.qpos0 = qb * 256; }
                else { const int v = u - nlat, b = v >> 4, h = v & 15; const int row0 = TL + b * CTXL;
                    A.Qb = Qb + (size_t)row0 * NQ + h * QKD; A.KVh = KV + h * 256; A.Ob = P + (size_t)row0 * D + h * VD; A.kb_lat = 0; A.nt_lat = 0; A.kb_ctx = row0; A.NT = CTXL / 64; A.qpos0 = -1; }
                att::attn_unit_auto(A, WP(const bf16_t, WS_KR), WP(const float, WS_ROPE), lds);
            }
            PHASE_END(base + 2); }
        if (EN_S3 && IN(base + 3)) { SITE();
            pg8::Gemm g; pg8::EpiY E{WP(bf16_t, WS_Y), WP(float, WS_YP), D, TL, TC, 0, 0}; pg8::HybridOrder S;
            if (pool) { g = pg8::Gemm{WP(const bf16_t, WS_U), WP(const bf16_t, WS_WPOOL) + (size_t)j * D * 512, Mrows, D, 512, D, 512}; E.a_grp_tiles = 2; E.a_grp_off = 512; S.init(Mrows, Mrows, D, 512, G, bid, 1); }
            else { g = pg8::Gemm{WP(const bf16_t, WS_P), WP(const bf16_t, WS_WO) + (size_t)j * D * D, Mrows, D, D, D, D}; S.init(TL, Mrows, D, D, G, bid, SPLIT_WO); }
            pg8::gemm_phase<pg8::EpiY, pg8::HybridOrder>(lds, g, S, E);
            PHASE_END(base + 3); }
        if (EN_S4 && IN(base + 4)) { SITE(); const float* modL = WP(const float, WS_MOD) + (size_t)L * 3 * NMOD; const float* gL = KIN(6) + (size_t)L * 4 * D;
            RN a; a.xin_lat = KIN(0); a.xin_ctx = KIN(2); a.hin = WP(const bf16_t, WS_H); a.Y = WP(const bf16_t, WS_Y); a.Yp = WP(const float, WS_YP); a.nparts = (!pool && Mrows > TL) ? SPLIT_WO : 0; a.gate = modL + 2 * D; a.gY = gL + D;
            a.hout = WP(bf16_t, WS_H); a.fout = nullptr; a.gN = gL + 2 * D; a.shift = modL + 3 * D; a.scale = modL + 4 * D; a.U = WP(bf16_t, WS_U); a.nrows = Mrows; a.modp = nullptr; a.bias = nullptr; a.mod_out = nullptr;
            if (L == 0) resid_norm<true, true, true, false, false, true>(a, lds, gw, ngw, tid); else if (pool) resid_norm<true, true, false, false, false, true>(a, lds, gw, ngw, tid); else resid_norm<true, true, false, false>(a, lds, gw, ngw, tid);
            PHASE_END(base + 4); }
        if (EN_S5 && IN(base + 5)) { SITE(); pg8::Gemm g{WP(const bf16_t, WS_U), WP(const bf16_t, WS_W13) + (size_t)L * 2 * DFF * D, Mrows, 2 * DFF, D, D, D}; pg8::StaticOrder S; S.init(Mrows, 2 * DFF, D, G, bid);
            pg8::EpiSwiGLU E{WP(bf16_t, WS_G), DFF};
            pg8::gemm_phase<pg8::EpiSwiGLU, pg8::StaticOrder>(lds, g, S, E);
            if (L < 3) { const int lo_ = L == 0 ? SEG1 : L == 1 ? SEG3 : SEG4, hi_ = L == 0 ? SEG2 : L == 1 ? SEG4 : SEG5; FILL_TAIL(GEMV_DEFER && L == 2 ? 3 : 0, lo_, hi_); }
            PHASE_END(base + 5); }
        if (EN_S6 && IN(base + 6)) { SITE();
            pg8::Gemm g{WP(const bf16_t, WS_G), WP(const bf16_t, WS_W2) + (size_t)L * D * DFF, Mrows, D, DFF, DFF, DFF}; pg8::HybridOrder S; S.init(TL, Mrows, D, DFF, G, bid, SPLIT_FFN2);
            pg8::EpiY E{WP(bf16_t, WS_Y), WP(float, WS_YP), D, TL, TC, 0, 0};
            pg8::gemm_phase<pg8::EpiY, pg8::HybridOrder>(lds, g, S, E);
            if (GEMV_DEFER && (L == 1 || L == 2)) { const float* mp2 = WP(const float, WS_MODP2) + (size_t)L * KSPL2 * 3 * NMOD; const float* bias = KIN(5) + (size_t)(L + 1) * NMOD; float* mo = WP(float, WS_MOD) + (size_t)(L + 1) * 3 * NMOD;
                for (int o = gtid; o < 3 * NMOD; o += ngt) { float acc = bias[o % NMOD];
#pragma unroll 16
                    for (int p = 0; p < KSPL2; ++p) acc += mp2[(size_t)p * 3 * NMOD + o];
                    mo[o] = acc; } }
            PHASE_END(base + 6); }
        if (EN_S7 && IN(base + 7)) { SITE(); const float* modL = WP(const float, WS_MOD) + (size_t)L * 3 * NMOD; const float* gL = KIN(6) + (size_t)L * 4 * D;
            RN a; a.xin_lat = nullptr; a.xin_ctx = nullptr; a.hin = WP(const bf16_t, WS_H); a.Y = WP(const bf16_t, WS_Y); a.Yp = WP(const float, WS_YP); a.nparts = L < 3 ? SPLIT_FFN2 : 0; a.gate = modL + 5 * D; a.gY = gL + 3 * D; a.modp = nullptr; a.bias = nullptr; a.mod_out = nullptr;
            if (L < 3) { a.hout = WP(bf16_t, WS_H); a.fout = nullptr; a.gN = gL + 4 * D; a.shift = modL + 3 * NMOD; a.scale = modL + 3 * NMOD + D; a.U = WP(bf16_t, WS_U); a.nrows = T;
                resid_norm<true, true, false, false>(a, lds, gw, ngw, tid); }
            else { a.hout = nullptr; a.fout = KOUT(); a.gN = nullptr; a.shift = nullptr; a.scale = nullptr; a.U = nullptr; a.nrows = TL;
                resid_norm<true, false, false, true>(a, lds, gw, ngw, tid); }
            PHASE_END(base + 7); }
    }
#undef IN
#undef PHASE_END
}

extern "C" void kernel_launch(void* const* d_in, const int* in_sizes, int n_in, void* d_out, int out_size, void* d_ws, size_t ws_size, hipStream_t stream) {
    static int grid = 0;
    if (grid == 0) {
        if (n_in != 18 || in_sizes[0] != TL * D || out_size != TL * D || ws_size < WS_END) { fprintf(stderr, "kernel_launch: unexpected shapes (n_in %d, in0 %d, out %d, ws %zu); nothing launched\n", n_in, n_in > 0 ? in_sizes[0] : -1, out_size, ws_size); grid = -1; return; }
        int dev = 0, cus = 0, per_cu = 0;
        if (hipGetDevice(&dev) != hipSuccess || hipDeviceGetAttribute(&cus, hipDeviceAttributeMultiprocessorCount, dev) != hipSuccess) { grid = -1; return; }
        if (hipFuncSetAttribute((const void*)mk_fwd, hipFuncAttributeMaxDynamicSharedMemorySize, LDS_BYTES) != hipSuccess) { fprintf(stderr, "kernel_launch: hipFuncSetAttribute failed\n"); grid = -1; return; }
        if (hipOccupancyMaxActiveBlocksPerMultiprocessor(&per_cu, (const void*)mk_fwd, NTHREADS, LDS_BYTES) != hipSuccess || per_cu < 1) { fprintf(stderr, "kernel_launch: occupancy query says %d blocks per CU\n", per_cu); }
        (void)hipGetLastError();
        grid = cus;
    }
    if (grid < 0) return;
    if (hipMemsetAsync((char*)d_ws + WS_CTL, 0, CTL_ZERO_BYTES, stream) != hipSuccess) return;
    Args a{};
    for (int i = 0; i < 18; ++i) a.in[i] = (const float*)d_in[i];
    a.out = (float*)d_out; a.ws = (unsigned char*)d_ws;
#if MK_PER_PHASE
    for (int p = 0; p < N_PHASES; ++p) { const int k = p - 2, L = k >> 3, s = k & 7; if (p >= 2 && (L & 1) == 0 && s <= 2) continue;
        a.ph_lo = p; a.ph_hi = p + 1; hipLaunchKernelGGL(mk_fwd, dim3(grid), dim3(NTHREADS), LDS_BYTES, stream, a); }
#else
    a.ph_lo = 0; a.ph_hi = N_PHASES; hipLaunchKernelGGL(mk_fwd, dim3(grid), dim3(NTHREADS), LDS_BYTES, stream, a);
#endif
    const hipError_t le = hipPeekAtLastError();
    if (le != hipSuccess) fprintf(stderr, "kernel_launch: launch failed: %s\n", hipGetErrorName(le));
}
```

```cpp
#include <hip/hip_runtime.h>
#include <cstdio>
#include <cstdint>

#ifndef MK_PER_PHASE
#define MK_PER_PHASE 0
#endif

#define LAS __attribute__((address_space(3)))
#define GAS __attribute__((address_space(1)))
typedef unsigned short bf16_t;
typedef short bf16x8 __attribute__((ext_vector_type(8)));
typedef short s16x4 __attribute__((ext_vector_type(4)));
typedef float f32x4 __attribute__((ext_vector_type(4)));
typedef float f32x2 __attribute__((ext_vector_type(2)));
typedef float f32x16 __attribute__((ext_vector_type(16)));
typedef unsigned u32x4 __attribute__((ext_vector_type(4)));
typedef unsigned u32x2 __attribute__((ext_vector_type(2)));

constexpr int D = 2048, SEQ = 8192, NB = 2, CTXL = 256, TL = NB * SEQ, TC = NB * CTXL, T = TL + TC;
constexpr int DFF = 5632, NH = 16, QKD = 192, NOPE = 128, ROPED = 64, VD = 128, QL = 512, KVL = 512;
constexpr int NDQKV = 1280;
constexpr int NQ = NH * QKD, NKV = NH * (NOPE + VD), NUP = NQ + NKV;
constexpr int NMOD = 6 * D;
constexpr float RMS_EPS = 1e-6f;
constexpr int NWAVES = 8, NTHREADS = 512;

__device__ __forceinline__ unsigned cvt_pk_bf16(float lo, float hi) { unsigned r; asm volatile("v_cvt_pk_bf16_f32 %0, %1, %2" : "=v"(r) : "v"(lo), "v"(hi)); return r; }
__device__ __forceinline__ float bf_lo(unsigned w) { return __uint_as_float(w << 16); }
__device__ __forceinline__ float bf_hi(unsigned w) { return __uint_as_float(w & 0xffff0000u); }
__device__ __forceinline__ float wave_sum(float v) {
#pragma unroll
    for (int o = 1; o < 64; o <<= 1) v += __shfl_xor(v, o);
    return v;
}

namespace pg8 {
constexpr int BM = 256, BK = 64, HALF = 128, HTB = HALF * BK * 2, STAGE_BYTES = 8 * HTB, NXCD = 8, WGM = 4;
__host__ __device__ __forceinline__ int lds_byte(int r, int c) { const int st = (r >> 4) * 2 + (c >> 5), rr = r & 15, cc = c & 31, ob = rr * 64 + cc * 2; return st * 1024 + (ob ^ (((ob >> 9) & 1) << 5)); }
__host__ __device__ __forceinline__ void stage_rc(int b, int& R, int& C) { const int st = b / 1024, sb = b % 1024, swz = sb ^ (((sb >> 9) & 1) << 5); R = (st >> 1) * 16 + swz / 64; C = (st & 1) * 32 + (swz % 64) / 2; }
__host__ __device__ __forceinline__ int perm32(int rho) { const int n = rho >> 4, i = rho & 15; return 8 * (i >> 2) + 4 * n + (i & 3); }

struct Unit { int pm, pn, kt0, nkt, part; };
struct Gemm { const bf16_t* A; const bf16_t* Bt; int M, N, K, lda, ldb; };

struct StaticOrder {
    int nM, nN, nwg, G, c, nkt;
    __host__ __device__ void init(int M, int N, int K, int G_, int c_) { nM = M / BM; nN = N / BM; nwg = nM * nN; G = G_; c = c_; nkt = K / BK; }
    __host__ __device__ bool next(int i, Unit& u) const {
        const long L = (long)i * G + c; if (L >= nwg) return false;
        int wgid = (int)L; { const int q = nwg / NXCD, r = nwg % NXCD, xcd = wgid % NXCD, off = wgid / NXCD; wgid = (xcd < r ? xcd * (q + 1) : r * (q + 1) + (xcd - r) * q) + off; }
        const int nig = WGM * nN, gid = wgid / nig, fm = gid * WGM, gsz = (nM - fm) < WGM ? (nM - fm) : WGM;
        u.pm = fm + ((wgid % nig) % gsz); u.pn = (wgid % nig) / gsz; u.kt0 = 0; u.nkt = nkt; u.part = -1; return true;
    }
};
struct HybridOrder {
    StaticOrder full; int nfull, nsplit, S, nktp, nN, pm0, G, c;
    __host__ __device__ void init(int Mfull, int Mtot, int N, int K, int G_, int c_, int S_) { full.init(Mfull, N, K, G_, c_); nfull = full.nwg; nN = N / BM; pm0 = Mfull / BM; S = S_; nktp = (K / BK) / S_;
        nsplit = ((Mtot - Mfull) / BM) * nN * S_; G = G_; c = c_; }
    __host__ __device__ bool next(int i, Unit& u) const {
        const long L = (long)i * G + c; if (L < nfull) return full.next(i, u);
        const int e = (int)(L - nfull); if (e >= nsplit) return false;
        const int part = e % S, tile = e / S; u.pm = pm0 + tile / nN; u.pn = tile % nN; u.kt0 = part * nktp; u.nkt = nktp; u.part = part; return true;
    }
};

template <class Epi, class Sched, bool ALIGN_EPI = true>
__device__ __forceinline__ void gemm_phase(LAS unsigned char* lds, const Gemm g, const Sched& S, const Epi& E) {
    int tid = threadIdx.x; asm volatile("" : "+v"(tid));
    const int wid = __builtin_amdgcn_readfirstlane(tid >> 6), lane = tid & 63, wr = wid >> 2, wc = wid & 3, fr = lane & 15, fq = lane >> 4;
    unsigned voffA[2], voffB[2];
#pragma unroll
    for (int i = 0; i < 2; ++i) { int R, C; stage_rc(tid * 16 + i * 8192, R, C); const int Rb = (R & ~31) + perm32(R & 31);
        voffA[i] = (unsigned)(R * g.lda + C) * 2u; voffB[i] = (unsigned)(Rb * g.ldb + C) * 2u; }
    const size_t kstep = (size_t)(BK * 2);
    const size_t hstepA = (size_t)HALF * g.lda * 2, hstepB = (size_t)HALF * g.ldb * 2;
    const size_t tstepA = 2 * hstepA, tstepB = 2 * hstepB;
    const unsigned ldsw = (unsigned)wid * 1024u;
    const int aoff = lds_byte(wr * 64 + fr, fq * 8), boff = lds_byte(wc * 32 + fr, fq * 8);
#define PG8_SA(b, h) (((b) * 2 + (h)) * HTB)
#define PG8_SB(b, h) ((4 + (b) * 2 + (h)) * HTB)
#define PG8_STAGE(bufoff, gbase, voff) do { _Pragma("unroll") for (int _i = 0; _i < 2; ++_i) \
        __builtin_amdgcn_global_load_lds((const unsigned*)((const char*)(gbase) + (voff)[_i]), (LAS unsigned*)(lds + (bufoff) + ldsw + _i * 8192), 16, 0, 0); } while (0)
#define PG8_LDA(dst, b, h) do { _Pragma("unroll") for (int m = 0; m < 4; ++m) _Pragma("unroll") for (int k = 0; k < 2; ++k) dst[m][k] = *(const LAS bf16x8*)(lds + PG8_SA(b, h) + aoff + m * 2048 + k * 1024); } while (0)
#define PG8_LDB(dst, b, h) do { _Pragma("unroll") for (int n = 0; n < 2; ++n) _Pragma("unroll") for (int k = 0; k < 2; ++k) dst[n][k] = *(const LAS bf16x8*)(lds + PG8_SB(b, h) + boff + n * 2048 + k * 1024); } while (0)
#define PG8_MMA(ai, bj, At, Bt) do { __builtin_amdgcn_s_setprio(1); _Pragma("unroll") for (int m = 0; m < 4; ++m) _Pragma("unroll") for (int n = 0; n < 2; ++n) _Pragma("unroll") for (int k = 0; k < 2; ++k) \
        acc[ai][bj][m][n] = __builtin_amdgcn_mfma_f32_16x16x32_bf16(Bt[n][k], At[m][k], acc[ai][bj][m][n], 0, 0, 0); __builtin_amdgcn_s_setprio(0); } while (0)
#define PG8_WAIT_V(n) asm volatile("s_waitcnt vmcnt(" #n ")" ::: "memory")
#define PG8_WAIT_L(n) asm volatile("s_waitcnt lgkmcnt(" #n ")" ::: "memory")
#define PG8_BAR __builtin_amdgcn_s_barrier()
#define PG8_SCHED __builtin_amdgcn_sched_barrier(0)
    Unit cur, nxt; int ui = 0;
    if (!S.next(0, cur)) return;
    f32x4 acc[2][2][4][2];
#pragma unroll
    for (int a = 0; a < 2; ++a)
#pragma unroll
        for (int b = 0; b < 2; ++b)
#pragma unroll
            for (int m = 0; m < 4; ++m)
#pragma unroll
                for (int n = 0; n < 2; ++n) acc[a][b][m][n] = (f32x4){0.f, 0.f, 0.f, 0.f};
    bf16x8 At[4][2], B0[2][2], B1[2][2];
    const char* cA = (const char*)g.A + (size_t)cur.pm * tstepA + (size_t)E.a_off(cur.pn) * 2 + (size_t)cur.kt0 * kstep; const char* cB = (const char*)g.Bt + (size_t)cur.pn * tstepB + (size_t)cur.kt0 * kstep;
    PG8_STAGE(PG8_SB(0, 0), cB, voffB); PG8_STAGE(PG8_SB(0, 1), cB + hstepB, voffB); PG8_STAGE(PG8_SA(0, 0), cA, voffA); PG8_STAGE(PG8_SA(0, 1), cA + hstepA, voffA);
    if (wr == 1) PG8_BAR;
    PG8_WAIT_V(2); PG8_BAR;
    PG8_STAGE(PG8_SB(1, 0), cB + kstep, voffB); PG8_STAGE(PG8_SA(1, 0), cA + kstep, voffA); PG8_STAGE(PG8_SB(1, 1), cB + hstepB + kstep, voffB);
    PG8_WAIT_V(6); PG8_BAR;
    for (;;) {
        const bool has_next = S.next(ui + 1, nxt);
        const char* nA = has_next ? (const char*)g.A + (size_t)nxt.pm * tstepA + (size_t)E.a_off(nxt.pn) * 2 + (size_t)nxt.kt0 * kstep : cA; const char* nB = has_next ? (const char*)g.Bt + (size_t)nxt.pn * tstepB + (size_t)nxt.kt0 * kstep : cB;
        const int nt = cur.nkt;
        asm volatile(".p2align 6");
        for (int t = 0; t < nt; t += 2) {
            const bool last = (t == nt - 2);
            const char* a1 = cA + (size_t)(t + 1) * kstep;
            const char* a2 = last ? nA : cA + (size_t)(t + 2) * kstep; const char* b2 = last ? nB : cB + (size_t)(t + 2) * kstep;
            const char* a3 = a2 + kstep; const char* b3 = b2 + kstep;
            PG8_LDB(B0, 0, 0); PG8_LDB(B1, 0, 1); PG8_SCHED; PG8_LDA(At, 0, 0); PG8_STAGE(PG8_SA(1, 1), a1 + hstepA, voffA);
            PG8_WAIT_V(8); PG8_WAIT_L(0); PG8_BAR; PG8_MMA(0, 0, At, B0); PG8_MMA(0, 1, At, B1); PG8_BAR; PG8_SCHED;
            PG8_LDA(At, 0, 1); PG8_STAGE(PG8_SB(0, 0), b2, voffB); PG8_STAGE(PG8_SB(0, 1), b2 + hstepB, voffB); PG8_STAGE(PG8_SA(0, 0), a2, voffA);
            PG8_WAIT_V(8); PG8_WAIT_L(0); PG8_BAR; PG8_MMA(1, 0, At, B0); PG8_MMA(1, 1, At, B1); PG8_BAR; PG8_SCHED;
            PG8_LDB(B0, 1, 0); PG8_LDB(B1, 1, 1); PG8_SCHED; PG8_LDA(At, 1, 0); PG8_STAGE(PG8_SA(0, 1), a2 + hstepA, voffA);
            PG8_WAIT_V(8); PG8_WAIT_L(0); PG8_BAR; PG8_MMA(0, 0, At, B0); PG8_MMA(0, 1, At, B1); PG8_BAR; PG8_SCHED;
            PG8_LDA(At, 1, 1); PG8_STAGE(PG8_SB(1, 0), b3, voffB); PG8_STAGE(PG8_SB(1, 1), b3 + hstepB, voffB); PG8_STAGE(PG8_SA(1, 0), a3, voffA);
            PG8_WAIT_V(8); PG8_WAIT_L(0); PG8_BAR; PG8_MMA(1, 0, At, B0); PG8_MMA(1, 1, At, B1); PG8_BAR; PG8_SCHED;
        }
        if constexpr (ALIGN_EPI) { if (wr == 0) PG8_BAR; }
        E(acc, cur, wr, wc, fr, fq);
        if (!has_next) break;
#pragma unroll
        for (int a = 0; a < 2; ++a)
#pragma unroll
            for (int b = 0; b < 2; ++b)
#pragma unroll
                for (int m = 0; m < 4; ++m)
#pragma unroll
                    for (int n = 0; n < 2; ++n) acc[a][b][m][n] = (f32x4){0.f, 0.f, 0.f, 0.f};
        cur = nxt; cA = nA; cB = nB; ++ui;
        if constexpr (ALIGN_EPI) { if (wr == 1) PG8_BAR; }
    }
    PG8_WAIT_V(0);
    if constexpr (!ALIGN_EPI) { if (wr == 0) PG8_BAR; }
    PG8_BAR;
#undef PG8_SA
#undef PG8_SB
#undef PG8_STAGE
#undef PG8_LDA
#undef PG8_LDB
#undef PG8_MMA
#undef PG8_WAIT_V
#undef PG8_WAIT_L
#undef PG8_BAR
#undef PG8_SCHED
}

#ifndef EPI_SC1
#define EPI_SC1 0
#endif
__device__ __forceinline__ void st16(void* p, u32x4 w) {
#if EPI_SC1
    asm volatile("global_store_dwordx4 %0, %1, off sc1\n\ts_nop 1" :: "v"(p), "v"(w) : "memory");
#else
    *(u32x4*)p = w;
#endif
}
struct EpiStore {
    bf16_t* O; int ldc; float* ssq0; float* ssq1; int split0, split1; int a_grp_tiles, a_grp_off;
    __device__ __forceinline__ int a_off(int pn) const { return a_grp_tiles ? (pn / a_grp_tiles) * a_grp_off : 0; }
    __device__ __forceinline__ void operator()(const f32x4 (&acc)[2][2][4][2], const Unit& u, int wr, int wc, int fr, int fq) const {
        const int row0 = u.pm * BM + wr * 64 + fr, col0 = u.pn * BM + wc * 32 + 8 * fq;
        float* ssq = u.pn < split0 ? ssq0 : (u.pn < split1 ? ssq1 : nullptr);
#pragma unroll
        for (int ai = 0; ai < 2; ++ai)
#pragma unroll
            for (int m = 0; m < 4; ++m) { const int row = row0 + ai * HALF + m * 16; bf16_t* rowp = O + (size_t)row * ldc + col0; float s = 0.f;
#pragma unroll
                for (int bj = 0; bj < 2; ++bj) { const f32x4 v0 = acc[ai][bj][m][0], v1 = acc[ai][bj][m][1];
                    s += (v0[0] * v0[0] + v0[1] * v0[1]) + (v0[2] * v0[2] + v0[3] * v0[3]) + (v1[0] * v1[0] + v1[1] * v1[1]) + (v1[2] * v1[2] + v1[3] * v1[3]);
                    u32x4 w; w.x = cvt_pk_bf16(v0[0], v0[1]); w.y = cvt_pk_bf16(v0[2], v0[3]); w.z = cvt_pk_bf16(v1[0], v1[1]); w.w = cvt_pk_bf16(v1[2], v1[3]);
                    st16(rowp + bj * HALF, w); }
                if (ssq) { s += __shfl_xor(s, 16); s += __shfl_xor(s, 32); if (fq == 0) ssq[(size_t)row * 8 + (u.pn & 1) * 4 + wc] = s; } }
    }
};
struct EpiY {
    bf16_t* O; float* Yp; int ldc, row_split, nsplit_rows; int a_grp_tiles, a_grp_off;
    __device__ __forceinline__ int a_off(int pn) const { return a_grp_tiles ? (pn / a_grp_tiles) * a_grp_off : 0; }
    __device__ __forceinline__ void operator()(const f32x4 (&acc)[2][2][4][2], const Unit& u, int wr, int wc, int fr, int fq) const {
        const int row0 = u.pm * BM + wr * 64 + fr, col0 = u.pn * BM + wc * 32 + 8 * fq;
        if (u.part < 0) {
#pragma unroll
            for (int ai = 0; ai < 2; ++ai)
#pragma unroll
                for (int m = 0; m < 4; ++m) { bf16_t* rowp = O + (size_t)(row0 + ai * HALF + m * 16) * ldc + col0;
#pragma unroll
                    for (int bj = 0; bj < 2; ++bj) { const f32x4 v0 = acc[ai][bj][m][0], v1 = acc[ai][bj][m][1];
                        u32x4 w; w.x = cvt_pk_bf16(v0[0], v0[1]); w.y = cvt_pk_bf16(v0[2], v0[3]); w.z = cvt_pk_bf16(v1[0], v1[1]); w.w = cvt_pk_bf16(v1[2], v1[3]);
                        st16(rowp + bj * HALF, w); } }
        } else { float* slab = Yp + (size_t)u.part * nsplit_rows * ldc;
#pragma unroll
            for (int ai = 0; ai < 2; ++ai)
#pragma unroll
                for (int m = 0; m < 4; ++m) { float* rowp = slab + (size_t)(row0 + ai * HALF + m * 16 - row_split) * ldc + col0;
#pragma unroll
                    for (int bj = 0; bj < 2; ++bj) { *(f32x4*)(rowp + bj * HALF) = acc[ai][bj][m][0]; *(f32x4*)(rowp + bj * HALF + 4) = acc[ai][bj][m][1]; } }
        }
    }
};
struct EpiSwiGLU {
    bf16_t* O; int ldc;
    __device__ __forceinline__ int a_off(int) const { return 0; }
    __device__ __forceinline__ void operator()(const f32x4 (&acc)[2][2][4][2], const Unit& u, int wr, int wc, int fr, int fq) const {
        const int row0 = u.pm * BM + wr * 64 + fr, col0 = u.pn * HALF + wc * 32 + 8 * fq;
#pragma unroll
        for (int ai = 0; ai < 2; ++ai)
#pragma unroll
            for (int m = 0; m < 4; ++m) { const int row = row0 + ai * HALF + m * 16; float gv[8];
#pragma unroll
                for (int n = 0; n < 2; ++n)
#pragma unroll
                    for (int j = 0; j < 4; ++j) { const float a = acc[ai][0][m][n][j], b = acc[ai][1][m][n][j]; gv[n * 4 + j] = a * __builtin_amdgcn_rcpf(1.f + __expf(-a)) * b; }
                u32x4 w; w.x = cvt_pk_bf16(gv[0], gv[1]); w.y = cvt_pk_bf16(gv[2], gv[3]); w.z = cvt_pk_bf16(gv[4], gv[5]); w.w = cvt_pk_bf16(gv[6], gv[7]);
                st16(O + (size_t)row * ldc + col0, w); }
    }
};
struct EpiUp {
    bf16_t* Q; bf16_t* KV; const float* ssq_q; const float* ssq_kv;
    __device__ __forceinline__ int a_off(int pn) const { return pn < NQ / BM ? 0 : QL; }
    __device__ __forceinline__ void operator()(const f32x4 (&acc)[2][2][4][2], const Unit& u, int wr, int wc, int fr, int fq) const {
        const bool isq = u.pn < NQ / BM; const int ldc = isq ? NQ : NKV; bf16_t* O = isq ? Q : KV; const float* ssq = isq ? ssq_q : ssq_kv;
        const int row0 = u.pm * BM + wr * 64 + fr, col0 = (isq ? u.pn : u.pn - NQ / BM) * BM + wc * 32 + 8 * fq;
        float rs[2][4];
#pragma unroll
        for (int ai = 0; ai < 2; ++ai)
#pragma unroll
            for (int m = 0; m < 4; ++m) { const int row = row0 + ai * HALF + m * 16;
                const f32x4 sa = *(const f32x4*)(ssq + (size_t)row * 8), sb = *(const f32x4*)(ssq + (size_t)row * 8 + 4);
                rs[ai][m] = __builtin_amdgcn_rsqf((((sa[0] + sa[1]) + (sa[2] + sa[3])) + ((sb[0] + sb[1]) + (sb[2] + sb[3]))) * (1.f / 512.f) + RMS_EPS); }
#pragma unroll
        for (int ai = 0; ai < 2; ++ai)
#pragma unroll
            for (int m = 0; m < 4; ++m) { const int row = row0 + ai * HALF + m * 16; bf16_t* rowp = O + (size_t)row * ldc + col0;
#pragma unroll
                for (int bj = 0; bj < 2; ++bj) { const f32x4 v0 = acc[ai][bj][m][0] * rs[ai][m], v1 = acc[ai][bj][m][1] * rs[ai][m];
                    u32x4 w; w.x = cvt_pk_bf16(v0[0], v0[1]); w.y = cvt_pk_bf16(v0[2], v0[3]); w.z = cvt_pk_bf16(v1[0], v1[1]); w.w = cvt_pk_bf16(v1[2], v1[3]);
                    st16(rowp + bj * HALF, w); } }
    }
};
}
namespace att {
constexpr int QBLK = 32, KVBLK = 64;
constexpr float SCALE = 0.07216878364870322f;
constexpr float THR = 8.f;
#ifndef ATT_SDEPTH
#define ATT_SDEPTH 1
#endif
constexpr int SDEPTH = ATT_SDEPTH;
constexpr int SHM_V = KVBLK * VD * 2, SHM_K = KVBLK * QKD * 2;
constexpr int LDS_BYTES = 2 * SHM_V + 2 * SHM_K + NWAVES * 64 * 4;
#define KOFF(row, ch) ((row) * 384 + ((((ch) ^ (((row) >> 1) & 7))) << 4))
#define SBAR() __builtin_amdgcn_sched_barrier(0)
__device__ __forceinline__ int crow(int r, int hi) { return (r & 3) + 8 * (r >> 2) + 4 * hi; }

__device__ __forceinline__ void finishSM(f32x16& p0, f32x16& p1, float alpha, float& l_reg, bf16x8& pa0, bf16x8& pa1, bf16x8& pa2, bf16x8& pa3) {
#pragma unroll
    for (int r = 0; r < 16; ++r) p1[r] = __builtin_amdgcn_exp2f(p1[r]);
    float ps = 0;
#pragma unroll
    for (int r = 0; r < 16; ++r) ps += p0[r];
#pragma unroll
    for (int r = 0; r < 16; ++r) ps += p1[r];
    { auto rr = __builtin_amdgcn_permlane32_swap(__float_as_uint(ps), __float_as_uint(ps), false, false);
      ps = __uint_as_float(rr[0]) + __uint_as_float(rr[1]); }
    l_reg = l_reg * alpha + ps;
#define PK8(P, BASE, OUT) do { u32x4 w = {cvt_pk_bf16(P[BASE + 0], P[BASE + 1]), cvt_pk_bf16(P[BASE + 2], P[BASE + 3]), cvt_pk_bf16(P[BASE + 4], P[BASE + 5]), cvt_pk_bf16(P[BASE + 6], P[BASE + 7])}; \
    OUT = *reinterpret_cast<bf16x8*>(&w); } while (0)
    PK8(p0, 0, pa0); PK8(p0, 8, pa1); PK8(p1, 0, pa2); PK8(p1, 8, pa3);
#undef PK8
}
__device__ __forceinline__ int v_st(int k, int c) { const int kk = (k & ~0xC) | ((k & 4) << 1) | ((k & 8) >> 1); return ((kk >> 3) * 4 + (c >> 5)) * 512 + ((kk & 7) * 32 + (c & 31)) * 2; }
__device__ __forceinline__ int v_rd_base(int lane) { return ((lane & 3) << 3) | (((lane >> 2) & 3) << 6) | (((lane >> 4) & 1) << 5) | (((lane >> 5) & 1) << 8); }
constexpr int v_rd_off(int d0, int ks, int half) { return d0 * 512 + ks * 4096 + half * 2048; }
template <int OFF> __device__ __forceinline__ s16x4 tr_read(int vb) {
    s16x4 r; asm volatile("ds_read_b64_tr_b16 %0, %1 offset:%2" : "=&v"(r) : "v"(vb), "i"(OFF) : "memory"); return r;
}
template <int D0> __device__ __forceinline__ void pv_one(f32x16& od, int vb, bf16x8 pa0, bf16x8 pa1, bf16x8 pa2, bf16x8 pa3) {
    const s16x4 l0 = tr_read<v_rd_off(D0, 0, 0)>(vb), h0 = tr_read<v_rd_off(D0, 0, 1)>(vb), l1 = tr_read<v_rd_off(D0, 1, 0)>(vb), h1 = tr_read<v_rd_off(D0, 1, 1)>(vb);
    const s16x4 l2 = tr_read<v_rd_off(D0, 2, 0)>(vb), h2 = tr_read<v_rd_off(D0, 2, 1)>(vb), l3 = tr_read<v_rd_off(D0, 3, 0)>(vb), h3 = tr_read<v_rd_off(D0, 3, 1)>(vb);
    asm volatile("s_waitcnt lgkmcnt(0)" ::: "memory"); SBAR();
#define PK(L, H) (bf16x8){L[0], L[1], L[2], L[3], H[0], H[1], H[2], H[3]}
    od = __builtin_amdgcn_mfma_f32_32x32x16_bf16(pa0, PK(l0, h0), od, 0, 0, 0);
    od = __builtin_amdgcn_mfma_f32_32x32x16_bf16(pa1, PK(l1, h1), od, 0, 0, 0);
    od = __builtin_amdgcn_mfma_f32_32x32x16_bf16(pa2, PK(l2, h2), od, 0, 0, 0);
    od = __builtin_amdgcn_mfma_f32_32x32x16_bf16(pa3, PK(l3, h3), od, 0, 0, 0);
#undef PK
}
__device__ __forceinline__ void pv_d0(f32x16* o, int vb, bf16x8 pa0, bf16x8 pa1, bf16x8 pa2, bf16x8 pa3) {
    pv_one<0>(o[0], vb, pa0, pa1, pa2, pa3); pv_one<1>(o[1], vb, pa0, pa1, pa2, pa3); pv_one<2>(o[2], vb, pa0, pa1, pa2, pa3); pv_one<3>(o[3], vb, pa0, pa1, pa2, pa3);
}
__device__ __forceinline__ void rope8(bf16x8& x1, bf16x8& x2, const float* tab) {
    u32x4 a = *reinterpret_cast<u32x4*>(&x1), b = *reinterpret_cast<u32x4*>(&x2), oa, ob;
#pragma unroll
    for (int w = 0; w < 4; ++w) {
        const f32x4 cs = *reinterpret_cast<const f32x4*>(tab + 4 * w);
        const float a0 = bf_lo(a[w]), a1 = bf_hi(a[w]), b0 = bf_lo(b[w]), b1 = bf_hi(b[w]);
        oa[w] = cvt_pk_bf16(a0 * cs[0] - b0 * cs[1], a1 * cs[2] - b1 * cs[3]);
        ob[w] = cvt_pk_bf16(b0 * cs[0] + a0 * cs[1], b1 * cs[2] + a1 * cs[3]);
    }
    x1 = *reinterpret_cast<bf16x8*>(&oa); x2 = *reinterpret_cast<bf16x8*>(&ob);
}

struct Unit { const bf16_t* Qb; const bf16_t* KVh; bf16_t* Ob; int kb_lat, nt_lat, kb_ctx, NT, qpos0; };

constexpr int SLOT = 40960, KR_OFF = 16384, V_OFF = 24576, LDS2_BYTES = 3 * SLOT + NWAVES * 64 * 4;
constexpr float THRL = THR * 1.4426950408889634f;
#ifndef ATT_MARGIN
#define ATT_MARGIN 100.f
#endif
__device__ __forceinline__ void qkt2n(f32x16& p0, f32x16& p1, LAS const char* lds, int kn, int kr, const bf16x8* qr, const f32x16& negm) {
#pragma unroll
    for (int d0 = 0; d0 < 8; ++d0) { const int a = kn ^ (d0 << 5);
        const bf16x8 b0 = *reinterpret_cast<LAS const bf16x8*>(lds + a), b1 = *reinterpret_cast<LAS const bf16x8*>(lds + a + 32 * 256);
        if (d0 == 0) { p0 = __builtin_amdgcn_mfma_f32_32x32x16_bf16(b0, qr[0], negm, 0, 0, 0); p1 = __builtin_amdgcn_mfma_f32_32x32x16_bf16(b1, qr[0], negm, 0, 0, 0); }
        else { p0 = __builtin_amdgcn_mfma_f32_32x32x16_bf16(b0, qr[d0], p0, 0, 0, 0); p1 = __builtin_amdgcn_mfma_f32_32x32x16_bf16(b1, qr[d0], p1, 0, 0, 0); } }
#pragma unroll
    for (int d0 = 0; d0 < 4; ++d0) { const int a = kr ^ (d0 << 5);
        const bf16x8 b0 = *reinterpret_cast<LAS const bf16x8*>(lds + a), b1 = *reinterpret_cast<LAS const bf16x8*>(lds + a + 32 * 128);
        p0 = __builtin_amdgcn_mfma_f32_32x32x16_bf16(b0, qr[8 + d0], p0, 0, 0, 0); p1 = __builtin_amdgcn_mfma_f32_32x32x16_bf16(b1, qr[8 + d0], p1, 0, 0, 0); }
}
template <bool FIRST>
__device__ __forceinline__ void partialSM2(f32x16& p0, f32x16& p1, float& m_reg, f32x16& negm, float& alpha, float margin = 0.f) {
    float pmax = p0[0];
#pragma unroll
    for (int r = 1; r < 16; ++r) pmax = fmaxf(pmax, p0[r]);
#pragma unroll
    for (int r = 0; r < 16; ++r) pmax = fmaxf(pmax, p1[r]);
    { auto rr = __builtin_amdgcn_permlane32_swap(__float_as_uint(pmax), __float_as_uint(pmax), false, false);
      pmax = fmaxf(__uint_as_float(rr[0]), __uint_as_float(rr[1])); }
    alpha = 1.f;
    if (FIRST || !__builtin_expect(__all(pmax <= THRL), 1)) {
        const float delta = FIRST ? pmax + margin : fmaxf(pmax, 0.f);
        if (!FIRST) alpha = __builtin_amdgcn_exp2f(-delta);
        m_reg += delta;
#pragma unroll
        for (int r = 0; r < 16; ++r) { p0[r] -= delta; p1[r] -= delta; negm[r] = -m_reg; }
    }
#pragma unroll
    for (int r = 0; r < 16; ++r) p0[r] = __builtin_amdgcn_exp2f(p0[r]);
}
__device__ __forceinline__ void exp_half(f32x16& p0) {
#pragma unroll
    for (int r = 0; r < 16; ++r) p0[r] = __builtin_amdgcn_exp2f(p0[r]);
}
template <bool FIXM>
__device__ __forceinline__ void attn_unit6(const Unit& U, const bf16_t* __restrict__ KR, const float* __restrict__ ropetab, LAS unsigned char* lds) {
    int tid = threadIdx.x; asm volatile("" : "+v"(tid));
    const int wid = __builtin_amdgcn_readfirstlane(tid >> 6), lane = tid & 63, r32 = lane & 31, hi = lane >> 5;
    LAS float* wsf = (LAS float*)(lds + 3 * SLOT) + wid * 64; LAS float* li_l = wsf; LAS float* al_l = wsf + 32;
    float m_reg = 0.f, l_reg = 0; f32x16 o[4] = {}; bf16x8 qr[12]; f32x16 negm = {};
    const bf16_t* Qw = U.Qb + (size_t)(wid * QBLK + r32) * NQ + hi * 8;
#pragma unroll
    for (int d0 = 0; d0 < 12; ++d0) qr[d0] = *reinterpret_cast<const bf16x8*>(Qw + d0 * 16);
    if (U.qpos0 >= 0) { const int t = U.qpos0 + wid * QBLK + r32, pr = t >> 6, pc = t & 63;
        rope8(qr[8], qr[9], ropetab + (pr * 16 + hi * 8) * 2); rope8(qr[10], qr[11], ropetab + (pc * 16 + hi * 8) * 2); }
    unsigned von[2], vov[2], vor;
#pragma unroll
    for (int i = 0; i < 2; ++i) { const int p = (wid * 2 + i) * 64 + lane;
        { const int row = p >> 4, c = (p & 15) ^ (row & 15); von[i] = (unsigned)(row * (NKV * 2) + c * 16); }
        { const int sub = p >> 5, within = p & 31, k = (sub >> 2) * 8 + (within >> 2), c = (sub & 3) * 32 + (within & 3) * 8;     vov[i] = (unsigned)(k * (NKV * 2) + NOPE * 2 + c * 2); } }
    { const int p = wid * 64 + lane, row = p >> 3, c = (p & 7) ^ ((row >> 1) & 7); vor = (unsigned)(row * (ROPED * 2) + c * 16); }
    const int kn0 = r32 * 256 + ((hi ^ (r32 & 15)) << 4), kr0 = KR_OFF + r32 * 128 + ((hi ^ ((r32 >> 1) & 7)) << 4), vb0 = (int)(uintptr_t)lds + V_OFF + v_rd_base(lane);
    const int nt_lat = U.nt_lat, kb_lat = U.kb_lat, kb_ctx = U.kb_ctx - 64 * nt_lat, NT = U.NT;
    const bf16_t* KVh = U.KVh;
    const unsigned ldsw2 = (unsigned)wid * 2048u, ldsw1 = (unsigned)wid * 1024u;
#define KROW(j) (((j) < nt_lat ? kb_lat : kb_ctx) + 64 * (j))
#define DMA(j, so) do { const size_t _k = (size_t)KROW(j); const char* _kv = (const char*)KVh + _k * (NKV * 2); const char* _kr = (const char*)KR + _k * (ROPED * 2); \
    __builtin_amdgcn_global_load_lds((const unsigned*)(_kv + von[0]), (LAS unsigned*)(lds + (so) + ldsw2), 16, 0, 0); \
    __builtin_amdgcn_global_load_lds((const unsigned*)(_kv + von[1]), (LAS unsigned*)(lds + (so) + ldsw2 + 1024), 16, 0, 0); \
    __builtin_amdgcn_global_load_lds((const unsigned*)(_kr + vor), (LAS unsigned*)(lds + (so) + KR_OFF + ldsw1), 16, 0, 0); \
    __builtin_amdgcn_global_load_lds((const unsigned*)(_kv + vov[0]), (LAS unsigned*)(lds + (so) + V_OFF + ldsw2), 16, 0, 0); \
    __builtin_amdgcn_global_load_lds((const unsigned*)(_kv + vov[1]), (LAS unsigned*)(lds + (so) + V_OFF + ldsw2 + 1024), 16, 0, 0); } while (0)
#define TILE_BAR() asm volatile("s_waitcnt vmcnt(0) lgkmcnt(0)\n\ts_barrier" ::: "memory")
#define RESC2(a) do { if (__any((a) < 1.f)) { if (hi == 0) al_l[r32] = (a); asm volatile("s_waitcnt lgkmcnt(0)" ::: "memory"); \
    _Pragma("unroll") for (int d = 0; d < 4; ++d) _Pragma("unroll") for (int r = 0; r < 16; ++r) o[d][r] *= al_l[crow(r, hi)]; } } while (0)
    f32x16 pA0, pA1, pB0, pB1; float alA, alB; bf16x8 pa0, pa1, pa2, pa3;
    int s_prev = 0, s_cur = SLOT, s_next = 2 * SLOT;
    DMA(0, 0); DMA(1, SLOT); TILE_BAR();
    qkt2n(pA0, pA1, (LAS const char*)lds, kn0, kr0, qr, negm); partialSM2<true>(pA0, pA1, m_reg, negm, alA, FIXM ? ATT_MARGIN : 0.f);
    asm volatile(".p2align 6");
    for (int j = 1; j + 1 < NT; j += 2) {
        DMA(j + 1, s_next); SBAR();
        qkt2n(pB0, pB1, (LAS const char*)lds, kn0 + s_cur, kr0 + s_cur, qr, negm);
        finishSM(pA0, pA1, alA, l_reg, pa0, pa1, pa2, pa3); SBAR();
        pv_d0(o, vb0 + s_prev, pa0, pa1, pa2, pa3); if (FIXM) { alB = 1.f; exp_half(pB0); } else partialSM2<false>(pB0, pB1, m_reg, negm, alB);
        if (!FIXM) RESC2(alB); TILE_BAR();
        { const int t = s_prev; s_prev = s_cur; s_cur = s_next; s_next = t; }
        if (j + 2 < NT) DMA(j + 2, s_next); SBAR();
        qkt2n(pA0, pA1, (LAS const char*)lds, kn0 + s_cur, kr0 + s_cur, qr, negm);
        finishSM(pB0, pB1, alB, l_reg, pa0, pa1, pa2, pa3); SBAR();
        pv_d0(o, vb0 + s_prev, pa0, pa1, pa2, pa3); if (FIXM) { alA = 1.f; exp_half(pA0); } else partialSM2<false>(pA0, pA1, m_reg, negm, alA);
        if (!FIXM) RESC2(alA); TILE_BAR();
        { const int t = s_prev; s_prev = s_cur; s_cur = s_next; s_next = t; }
    }
    SBAR(); qkt2n(pB0, pB1, (LAS const char*)lds, kn0 + s_cur, kr0 + s_cur, qr, negm);
    finishSM(pA0, pA1, alA, l_reg, pa0, pa1, pa2, pa3); SBAR();
    pv_d0(o, vb0 + s_prev, pa0, pa1, pa2, pa3); if (FIXM) { alB = 1.f; exp_half(pB0); } else partialSM2<false>(pB0, pB1, m_reg, negm, alB);
    if (!FIXM) RESC2(alB);
    finishSM(pB0, pB1, alB, l_reg, pa0, pa1, pa2, pa3); SBAR();
    pv_d0(o, vb0 + s_cur, pa0, pa1, pa2, pa3);
    if (FIXM) { const bool okl = (l_reg > 0.f) && (l_reg < 1e30f); const bool okw = __all(okl); if (lane == 0) ((LAS unsigned*)(lds + LDS2_BYTES))[wid] = okw ? 1u : 0u; }
    if (hi == 0) li_l[r32] = l_reg; asm volatile("s_waitcnt lgkmcnt(0)" ::: "memory");
    float rli[16];
#pragma unroll
    for (int r = 0; r < 16; ++r) rli[r] = __builtin_amdgcn_rcpf(li_l[crow(r, hi)]);
    asm volatile("s_waitcnt lgkmcnt(0)\n\ts_barrier" ::: "memory");
    { constexpr int OP = 272; LAS unsigned char* st = lds + wid * (32 * OP);
#pragma unroll
      for (int r = 0; r < 16; ++r) { const int orow = crow(r, hi);
#pragma unroll
        for (int d0 = 0; d0 < 4; ++d0) *(LAS bf16_t*)(st + orow * OP + (d0 * 32 + r32) * 2) = (bf16_t)(cvt_pk_bf16(o[d0][r] * rli[r], 0.f) & 0xffffu); }
      asm volatile("s_waitcnt lgkmcnt(0)" ::: "memory");
      bf16_t* Ow = U.Ob + (size_t)(wid * QBLK) * D;
#pragma unroll
      for (int i = 0; i < 8; ++i) { const int row = (lane >> 4) + 4 * i, ch = lane & 15;
        const u32x4 w = *(const LAS u32x4*)(st + row * OP + ch * 16); *(u32x4*)(Ow + (size_t)row * D + ch * 8) = w; } }
    TILE_BAR();
#undef KROW
#undef DMA
#undef TILE_BAR
#undef RESC2
}


typedef float f32x4_t __attribute__((ext_vector_type(4)));
__device__ __forceinline__ void attn_unit7(const Unit& U, const bf16_t* __restrict__ KR, const float* __restrict__ ropetab, LAS unsigned char* lds) {
    int tid = threadIdx.x; asm volatile("" : "+v"(tid));
    const int wid = __builtin_amdgcn_readfirstlane(tid >> 6), lane = tid & 63, c16 = lane & 15, g = lane >> 4;
    f32x4_t o[8][2]; bf16x8 qr[2][6]; f32x4_t negm[2]; float l_reg[2] = {0.f, 0.f};
#pragma unroll
    for (int t = 0; t < 8; ++t)
#pragma unroll
        for (int u = 0; u < 2; ++u) o[t][u] = (f32x4_t){0.f, 0.f, 0.f, 0.f};
    const int xg = g < 2 ? g : g + 2;
#pragma unroll
    for (int u = 0; u < 2; ++u) { const bf16_t* Qw = U.Qb + (size_t)(wid * QBLK + 16 * u + c16) * NQ;
#pragma unroll
        for (int s = 0; s < 4; ++s) qr[u][s] = *reinterpret_cast<const bf16x8*>(Qw + 32 * s + 8 * g);
        qr[u][4] = *reinterpret_cast<const bf16x8*>(Qw + NOPE + 8 * xg); qr[u][5] = *reinterpret_cast<const bf16x8*>(Qw + NOPE + 8 * (xg + 2));
        if (U.qpos0 >= 0) { const int t = U.qpos0 + wid * QBLK + 16 * u + c16, pos = g < 2 ? (t >> 6) : (t & 63); rope8(qr[u][4], qr[u][5], ropetab + (pos * 16 + (g & 1) * 8) * 2); } }
    unsigned von[2], vov[2], vor;
#pragma unroll
    for (int i = 0; i < 2; ++i) { const int p = (wid * 2 + i) * 64 + lane;
        { const int row = p >> 4, c = (p & 15) ^ (row & 15); von[i] = (unsigned)(row * (NKV * 2) + c * 16); }
        { const int sub = p >> 5, within = p & 31, k = (sub >> 2) * 8 + (within >> 2), c = (sub & 3) * 32 + (((within & 3) * 8) ^ (((within >> 4) & 1) << 4)); vov[i] = (unsigned)(k * (NKV * 2) + NOPE * 2 + c * 2); } }
    { const int p = wid * 64 + lane, row = p >> 3, c = (p & 7) ^ ((row >> 1) & 7); vor = (unsigned)(row * (ROPED * 2) + c * 16); }
    const int kn0 = c16 * 256 + ((g ^ c16) << 4), kr0 = KR_OFF + c16 * 128 + ((xg ^ ((c16 >> 1) & 7)) << 4);
    const int vbe = (int)(uintptr_t)lds + V_OFF + (g >> 1) * 2048 + (4 * (g & 1) + (c16 >> 2)) * 64 + 32 * (g & 1) + 8 * (c16 & 3), vbo = vbe ^ 32;
    const int nt_lat = U.nt_lat, kb_lat = U.kb_lat, kb_ctx = U.kb_ctx - 64 * nt_lat, NT = U.NT;
    const bf16_t* KVh = U.KVh;
    const unsigned ldsw2 = (unsigned)wid * 2048u, ldsw1 = (unsigned)wid * 1024u;
#define KROW(j) (((j) < nt_lat ? kb_lat : kb_ctx) + 64 * (j))
#define DMA(j, so) do { const size_t _k = (size_t)KROW(j); const char* _kv = (const char*)KVh + _k * (NKV * 2); const char* _kr = (const char*)KR + _k * (ROPED * 2); \
    __builtin_amdgcn_global_load_lds((const unsigned*)(_kv + von[0]), (LAS unsigned*)(lds + (so) + ldsw2), 16, 0, 0); \
    __builtin_amdgcn_global_load_lds((const unsigned*)(_kv + von[1]), (LAS unsigned*)(lds + (so) + ldsw2 + 1024), 16, 0, 0); \
    __builtin_amdgcn_global_load_lds((const unsigned*)(_kr + vor), (LAS unsigned*)(lds + (so) + KR_OFF + ldsw1), 16, 0, 0); \
    __builtin_amdgcn_global_load_lds((const unsigned*)(_kv + vov[0]), (LAS unsigned*)(lds + (so) + V_OFF + ldsw2), 16, 0, 0); \
    __builtin_amdgcn_global_load_lds((const unsigned*)(_kv + vov[1]), (LAS unsigned*)(lds + (so) + V_OFF + ldsw2 + 1024), 16, 0, 0); } while (0)
#define TILE_BAR() asm volatile("s_waitcnt vmcnt(0) lgkmcnt(0)\n\ts_barrier" ::: "memory")
#define MFMA16(A, B, C) __builtin_amdgcn_mfma_f32_16x16x32_bf16(A, B, C, 0, 0, 0)
#define KRD(dst, addr, off) asm volatile("ds_read_b128 %0, %1 offset:%2" : "=&v"(dst) : "v"(addr), "i"(off) : "memory")
#define KRD4(K, s, stp) do { const int _a = (s) < 4 ? (_kn ^ ((s) << 6)) : (_kr ^ (((s) - 4) << 5)); KRD(K[0], _a, 0); KRD(K[1], _a, (stp)); KRD(K[2], _a, 2 * (stp)); KRD(K[3], _a, 3 * (stp)); } while (0)
#define QKM(K, s) do { _Pragma("unroll") for (int a = 0; a < 4; ++a) _Pragma("unroll") for (int u = 0; u < 2; ++u) P_[u][a] = MFMA16(K[a], qr[u][s], (s) == 0 ? negm[u] : P_[u][a]); } while (0)
#define QK7(P, so) do { auto& P_ = P; const int _kn = (int)(uintptr_t)lds + kn0 + (so), _kr = (int)(uintptr_t)lds + kr0 + (so); bf16x8 ka[4], kb[4]; \
    KRD4(ka, 0, 4096); \
    KRD4(kb, 1, 4096); asm volatile("s_waitcnt lgkmcnt(4)" ::: "memory"); SBAR(); QKM(ka, 0); SBAR(); \
    KRD4(ka, 2, 4096); asm volatile("s_waitcnt lgkmcnt(4)" ::: "memory"); SBAR(); QKM(kb, 1); SBAR(); \
    KRD4(kb, 3, 4096); asm volatile("s_waitcnt lgkmcnt(4)" ::: "memory"); SBAR(); QKM(ka, 2); SBAR(); \
    KRD4(ka, 4, 2048); asm volatile("s_waitcnt lgkmcnt(4)" ::: "memory"); SBAR(); QKM(kb, 3); SBAR(); \
    KRD4(kb, 5, 2048); asm volatile("s_waitcnt lgkmcnt(4)" ::: "memory"); SBAR(); QKM(ka, 4); SBAR(); \
    asm volatile("s_waitcnt lgkmcnt(0)" ::: "memory"); SBAR(); QKM(kb, 5); } while (0)
#define EXPH7(P, A0) do { _Pragma("unroll") for (int u = 0; u < 2; ++u) _Pragma("unroll") for (int a = (A0); a < (A0) + 2; ++a) _Pragma("unroll") for (int r = 0; r < 4; ++r) P[u][a][r] = __builtin_amdgcn_exp2f(P[u][a][r]); } while (0)
#define FIN7(P) do { EXPH7(P, 2); \
    _Pragma("unroll") for (int u = 0; u < 2; ++u) { float ps = 0.f; _Pragma("unroll") for (int a = 0; a < 4; ++a) ps += (P[u][a][0] + P[u][a][1]) + (P[u][a][2] + P[u][a][3]); l_reg[u] += ps; \
        _Pragma("unroll") for (int ks = 0; ks < 2; ++ks) { u32x4 w = {cvt_pk_bf16(P[u][2 * ks][0], P[u][2 * ks][1]), cvt_pk_bf16(P[u][2 * ks][2], P[u][2 * ks][3]), \
            cvt_pk_bf16(P[u][2 * ks + 1][0], P[u][2 * ks + 1][1]), cvt_pk_bf16(P[u][2 * ks + 1][2], P[u][2 * ks + 1][3])}; pk[ks][u] = *reinterpret_cast<bf16x8*>(&w); } } } while (0)
#define TR7(dst, vb, a, t) asm volatile("ds_read_b64_tr_b16 %0, %1 offset:%2" : "=&v"(dst) : "v"(vb), "i"((a) * 4096 + ((t) >> 1) * 512) : "memory")
#define RD4(E, t) do { if ((t) & 1) { TR7(E[0], vb1_, 0, t); TR7(E[1], vb1_, 1, t); TR7(E[2], vb1_, 2, t); TR7(E[3], vb1_, 3, t); } else { TR7(E[0], vb0_, 0, t); TR7(E[1], vb0_, 1, t); TR7(E[2], vb0_, 2, t); TR7(E[3], vb0_, 3, t); } } while (0)
#define MM4(E, t) do { \
        const bf16x8 v0 = (bf16x8){E[0][0], E[0][1], E[0][2], E[0][3], E[1][0], E[1][1], E[1][2], E[1][3]}, v1 = (bf16x8){E[2][0], E[2][1], E[2][2], E[2][3], E[3][0], E[3][1], E[3][2], E[3][3]}; \
        o[t][0] = MFMA16(v0, pk[0][0], o[t][0]); o[t][1] = MFMA16(v0, pk[0][1], o[t][1]); o[t][0] = MFMA16(v1, pk[1][0], o[t][0]); o[t][1] = MFMA16(v1, pk[1][1], o[t][1]); } while (0)
#define PV7(so) do { const int vb0_ = vbe + (so), vb1_ = vbo + (so); s16x4 ea[4], eb[4]; \
        RD4(ea, 0); \
        RD4(eb, 1); asm volatile("s_waitcnt lgkmcnt(4)" ::: "memory"); SBAR(); MM4(ea, 0); SBAR(); \
        RD4(ea, 2); asm volatile("s_waitcnt lgkmcnt(4)" ::: "memory"); SBAR(); MM4(eb, 1); SBAR(); \
        RD4(eb, 3); asm volatile("s_waitcnt lgkmcnt(4)" ::: "memory"); SBAR(); MM4(ea, 2); SBAR(); \
        RD4(ea, 4); asm volatile("s_waitcnt lgkmcnt(4)" ::: "memory"); SBAR(); MM4(eb, 3); SBAR(); \
        RD4(eb, 5); asm volatile("s_waitcnt lgkmcnt(4)" ::: "memory"); SBAR(); MM4(ea, 4); SBAR(); \
        RD4(ea, 6); asm volatile("s_waitcnt lgkmcnt(4)" ::: "memory"); SBAR(); MM4(eb, 5); SBAR(); \
        RD4(eb, 7); asm volatile("s_waitcnt lgkmcnt(4)" ::: "memory"); SBAR(); MM4(ea, 6); SBAR(); \
        asm volatile("s_waitcnt lgkmcnt(0)" ::: "memory"); SBAR(); MM4(eb, 7); } while (0)
    f32x4_t pA[2][4], pB[2][4]; bf16x8 pk[2][2];
    negm[0] = negm[1] = (f32x4_t){0.f, 0.f, 0.f, 0.f};
    int s_prev = 0, s_cur = SLOT, s_next = 2 * SLOT;
    DMA(0, 0); DMA(1, SLOT); TILE_BAR();
    QK7(pA, 0);
#pragma unroll
    for (int u = 0; u < 2; ++u) { float pmax = pA[u][0][0];
#pragma unroll
        for (int a = 0; a < 4; ++a)
#pragma unroll
            for (int r = 0; r < 4; ++r) pmax = fmaxf(pmax, pA[u][a][r]);
        pmax = fmaxf(pmax, __shfl_xor(pmax, 16)); pmax = fmaxf(pmax, __shfl_xor(pmax, 32));
        const float delta = pmax + ATT_MARGIN; negm[u] = (f32x4_t){-delta, -delta, -delta, -delta};
#pragma unroll
        for (int a = 0; a < 4; ++a)
#pragma unroll
            for (int r = 0; r < 4; ++r) pA[u][a][r] -= delta; }
    EXPH7(pA, 0);
    asm volatile(".p2align 6");
    for (int j = 1; j + 1 < NT; j += 2) {
        DMA(j + 1, s_next); SBAR();
        QK7(pB, s_cur); FIN7(pA); SBAR();
        PV7(s_prev); EXPH7(pB, 0); TILE_BAR();
        { const int t = s_prev; s_prev = s_cur; s_cur = s_next; s_next = t; }
        if (j + 2 < NT) DMA(j + 2, s_next); SBAR();
        QK7(pA, s_cur); FIN7(pB); SBAR();
        PV7(s_prev); EXPH7(pA, 0); TILE_BAR();
        { const int t = s_prev; s_prev = s_cur; s_cur = s_next; s_next = t; }
    }
    SBAR(); QK7(pB, s_cur); FIN7(pA); SBAR();
    PV7(s_prev); EXPH7(pB, 0);
    FIN7(pB); SBAR();
    PV7(s_cur);
    float rl[2]; bool okl = true;
#pragma unroll
    for (int u = 0; u < 2; ++u) { float l = l_reg[u]; l += __shfl_xor(l, 16); l += __shfl_xor(l, 32); okl = okl && (l > 0.f) && (l < 1e30f); rl[u] = __builtin_amdgcn_rcpf(l); }
    { const bool okw = __all(okl); if (lane == 0) ((LAS unsigned*)(lds + LDS2_BYTES))[wid] = okw ? 1u : 0u; }
    asm volatile("s_waitcnt vmcnt(0) lgkmcnt(0)\n\ts_barrier" ::: "memory");
    { constexpr int OP = 272; LAS unsigned char* st = lds + wid * (32 * OP);
#pragma unroll
      for (int u = 0; u < 2; ++u)
#pragma unroll
        for (int t = 0; t < 8; ++t) { u32x2 w; w.x = cvt_pk_bf16(o[t][u][0] * rl[u], o[t][u][1] * rl[u]); w.y = cvt_pk_bf16(o[t][u][2] * rl[u], o[t][u][3] * rl[u]);
            *(LAS u32x2*)(st + (16 * u + c16) * OP + (16 * t + 4 * g) * 2) = w; }
      asm volatile("s_waitcnt lgkmcnt(0)" ::: "memory");
      bf16_t* Ow = U.Ob + (size_t)(wid * QBLK) * D;
#pragma unroll
      for (int i = 0; i < 8; ++i) { const int row = (lane >> 4) + 4 * i, ch = lane & 15;
        const u32x4 w = *(const LAS u32x4*)(st + row * OP + ch * 16); *(u32x4*)(Ow + (size_t)row * D + ch * 8) = w; } }
    TILE_BAR();
#undef KROW
#undef DMA
#undef TILE_BAR
#undef MFMA16
#undef QK7
#undef KRD
#undef KRD4
#undef QKM
#undef EXPH7
#undef FIN7
#undef PV7
#undef TR7
#undef RD4
#undef MM4
}

#ifndef ATT_FAST_FIRST
#define ATT_FAST_FIRST 1
#endif
#ifndef ATT_FORCE_SAFE
#define ATT_FORCE_SAFE 0
#endif
__device__ __forceinline__ void attn_unit_auto(const Unit& U, const bf16_t* __restrict__ KR, const float* __restrict__ ropetab, LAS unsigned char* lds) {
#if ATT_FAST_FIRST
    attn_unit7(U, KR, ropetab, lds);
    const LAS unsigned* fl = (const LAS unsigned*)(lds + LDS2_BYTES);
    unsigned okc = 0; for (int w = 0; w < NWAVES; ++w) okc += fl[w];
    if (ATT_FORCE_SAFE || __builtin_amdgcn_readfirstlane(okc) != (unsigned)NWAVES) attn_unit6<false>(U, KR, ropetab, lds);
#else
    attn_unit6<false>(U, KR, ropetab, lds);
#endif
}
}
constexpr size_t MiB = 1u << 20;
constexpr int CW_TMO = 0, CW_BAR = 4096;
constexpr int KSPL = 16;
constexpr size_t WS_CTL = 0;
constexpr size_t WS_MOD = 64 * 1024;
constexpr size_t WS_SSQ = 1 * MiB;
constexpr size_t CTL_ZERO_BYTES = 64 * 1024;
constexpr size_t WS_ROPE = 3 * MiB;
constexpr size_t WS_W13 = 4 * MiB;
constexpr size_t WS_W2 = 180 * MiB;
constexpr size_t WS_WPOOL = 268 * MiB;
constexpr size_t WS_WDQKV = 272 * MiB;
constexpr size_t WS_WUP = 282 * MiB;
constexpr size_t WS_WO = 296 * MiB;
constexpr size_t WS_H = 312 * MiB;
constexpr size_t WS_U = 444 * MiB;
constexpr size_t WS_Y = 510 * MiB;
constexpr size_t WS_P = 576 * MiB;
constexpr size_t WS_G = 642 * MiB;
constexpr size_t WS_CQKV = 824 * MiB;
constexpr size_t WS_Q = 866 * MiB;
constexpr size_t WS_KV = 965 * MiB;
constexpr size_t WS_KR = 1097 * MiB;
constexpr size_t WS_YP = 1100 * MiB;
constexpr size_t WS_MODP2 = 1148 * MiB;
constexpr size_t WS_END = 1176 * MiB;
static_assert(WS_W13 + (size_t)4 * 11264 * 2048 * 2 <= WS_W2 && WS_W2 + (size_t)4 * 2048 * 5632 * 2 <= WS_WPOOL && WS_H + (size_t)T * D * 4 <= WS_U && WS_U + (size_t)T * D * 2 <= WS_Y, "ws map");
static_assert(WS_G + (size_t)T * DFF * 2 <= WS_CQKV && WS_CQKV + (size_t)T * NDQKV * 2 <= WS_Q && WS_Q + (size_t)T * NQ * 2 <= WS_KV && WS_KV + (size_t)T * NKV * 2 <= WS_KR && WS_KR + (size_t)T * ROPED * 2 <= WS_YP && WS_YP + (size_t)11 * TC * D * 4 <= WS_MODP2 && WS_MODP2 + (size_t)3 * 64 * 3 * NMOD * 4 <= WS_END, "ws map");
static_assert(WS_MOD + (size_t)4 * 3 * NMOD * 4 <= WS_SSQ && WS_SSQ + (size_t)16 * T * 4 <= WS_ROPE && (CW_BAR + 3456) * 4 <= (int)CTL_ZERO_BYTES, "ctl map");

constexpr int RING_BYTES = 131072, MISC_OFF = RING_BYTES, LDS_BYTES = 147456;
static_assert(att::LDS_BYTES <= RING_BYTES && att::LDS2_BYTES + 64 <= RING_BYTES, "attention LDS");

#define XB_TMO      128
#define XB_XCNT(j)  (256  + 64 * (j))
#define XB_XSUB(j)  (1280 + 64 * (j))
#define XB_XGEN(j)  (2304 + 64 * (j))
#define XB_TOP      3328
#define XB_TOPGEN   3392
#define XCD_BAR_WORDS 3456
#define XB_SPIN_CAP (1u << 22)
__device__ __forceinline__ unsigned xb_ld(unsigned* p)              { return __hip_atomic_load(p, __ATOMIC_RELAXED, __HIP_MEMORY_SCOPE_AGENT); }
__device__ __forceinline__ unsigned xb_add(unsigned* p, unsigned v) { return __hip_atomic_fetch_add(p, v, __ATOMIC_RELAXED, __HIP_MEMORY_SCOPE_AGENT); }
__device__ __forceinline__ unsigned xb_xcc_id() { return (unsigned)__builtin_amdgcn_s_getreg((3 << 11) | 20) & 0xFu; }
#define XB_SPIN(cond, bar) do { unsigned _sp = 0; while (cond) { __builtin_amdgcn_s_sleep(1); \
    if ((++_sp & 255u) == 0u) { if (xb_ld(&(bar)[XB_TMO])) break; if (_sp > XB_SPIN_CAP) { atomicAdd(&(bar)[XB_TMO], 1u); break; } } } } while (0)
struct XcdBarrier { unsigned* bar; unsigned x; volatile LAS unsigned* st; };
__device__ __forceinline__ XcdBarrier xcd_barrier_post(unsigned* bar, volatile LAS unsigned* st) {
    XcdBarrier b; b.bar = bar; b.x = xb_xcc_id(); b.st = st;
    if (threadIdx.x == 0) (void)xb_add(&bar[XB_XCNT(b.x)], 1u);
    return b;
}
__device__ __forceinline__ void xcd_barrier_complete(unsigned* bar, unsigned x, unsigned& nloc, unsigned& nx) {
    const unsigned G = gridDim.x * gridDim.y * gridDim.z;
    unsigned sum, cnt, mine, sp = 0u;
    for (;;) {
        sum = 0u; cnt = 0u; mine = 0u;
#pragma unroll
        for (unsigned j = 0; j < 16; ++j) { const unsigned c = xb_ld(&bar[XB_XCNT(j)]); sum += c; cnt += (c > 0u) ? 1u : 0u; mine = (j == x) ? c : mine; }
        if (sum == G) break;
        __builtin_amdgcn_s_sleep(1);
        if ((++sp & 255u) == 0u) { if (xb_ld(&bar[XB_TMO])) break; if (sp > XB_SPIN_CAP) { atomicAdd(&bar[XB_TMO], 1u); break; } }
    }
    nloc = mine > 0u ? mine : 1u; nx = cnt > 0u ? cnt : 1u;
}
__device__ __forceinline__ void xcd_barrier(const XcdBarrier& b) {
    asm volatile("s_waitcnt vmcnt(0)" ::: "memory");
    __syncthreads();
    if (threadIdx.x == 0) {
        unsigned* bar = b.bar; asm volatile("" : "+s"(bar));
        __builtin_amdgcn_s_waitcnt(0);
        const unsigned bx = xb_xcc_id();
        unsigned nloc = b.st[0], nx = b.st[1];
        if (nloc == 0u) { xcd_barrier_complete(bar, bx, nloc, nx); b.st[0] = nloc; b.st[1] = nx; }
        const unsigned old = xb_add(&bar[XB_XSUB(bx)], 1u);
        const unsigned gen = old / nloc;
        if (old + 1u == (gen + 1u) * nloc) {
            __builtin_amdgcn_fence(__ATOMIC_RELEASE, "agent");
            asm volatile("s_waitcnt vmcnt(0)" ::: "memory");
            const unsigned og = xb_add(&bar[XB_TOP], 1u);
            const unsigned tg = og / nx;
            if (og + 1u == (tg + 1u) * nx) xb_add(&bar[XB_TOPGEN], 1u);
            else XB_SPIN(xb_ld(&bar[XB_TOPGEN]) == tg, bar);
            __builtin_amdgcn_fence(__ATOMIC_ACQUIRE, "agent");
            xb_add(&bar[XB_XGEN(bx)], 1u);
            asm volatile("s_waitcnt vmcnt(0)" ::: "memory");
        } else {
            XB_SPIN(xb_ld(&bar[XB_XGEN(bx)]) == gen, bar);
            __builtin_amdgcn_fence(__ATOMIC_ACQUIRE, "agent");
            asm volatile("s_waitcnt vmcnt(0)" ::: "memory");
        }
    }
    __syncthreads();
}

#define LDS_WAIT() asm volatile("s_waitcnt lgkmcnt(0)" ::: "memory")
struct TrD { const float* W; int ldw, k0, n0; bf16_t* WT; int ldt, drow0; const float* ksc; const float* nsc; float mul; };
__device__ __forceinline__ void tr_load(const TrD& d, float (&v)[32], int lane) {
    const float* wp = d.W + (size_t)(d.k0 + (lane >> 5)) * d.ldw + d.n0 + (lane & 31);
#pragma unroll
    for (int i = 0; i < 32; ++i) v[i] = __builtin_nontemporal_load(wp + (size_t)(2 * i) * d.ldw);
}
__device__ __forceinline__ void tr_finish(const TrD& d, float (&v)[32], LAS float* scr, int lane) {
    const float ns = (d.nsc ? d.nsc[d.n0 + (lane & 31)] : 1.f) * d.mul;
    if (d.ksc) {
#pragma unroll
        for (int i = 0; i < 32; ++i) v[i] *= d.ksc[d.k0 + 2 * i + (lane >> 5)]; }
#pragma unroll
    for (int i = 0; i < 32; ++i) scr[(2 * i + (lane >> 5)) * 33 + (lane & 31)] = v[i] * ns;
    LDS_WAIT(); asm volatile("" ::: "memory");
    const int c = lane & 7;
#pragma unroll
    for (int j = 0; j < 4; ++j) { const int n = (lane >> 3) + 8 * j; const LAS float* s = scr + (8 * c) * 33 + n;
        u32x4 o; o.x = cvt_pk_bf16(s[0 * 33], s[1 * 33]); o.y = cvt_pk_bf16(s[2 * 33], s[3 * 33]); o.z = cvt_pk_bf16(s[4 * 33], s[5 * 33]); o.w = cvt_pk_bf16(s[6 * 33], s[7 * 33]);
        *(u32x4*)(d.WT + (size_t)(d.drow0 + n) * d.ldt + d.k0 + 8 * c) = o; }
    LDS_WAIT(); asm volatile("" ::: "memory");
}
struct In {
    const float *x, *c, *ctx, *c_ctx, *ada_w, *ada_b, *norm_g, *pool_w, *pool_scale, *w_dqkv, *q_norm, *w_uq, *kv_norm, *w_ukv, *w_o, *w1, *w3, *w2;
};
constexpr int I_F = (D / 64) * (DFF / 32);
constexpr int I_P = (512 / 64) * (512 / 32);
constexpr int I_DQ = (D / 64) * (1088 / 32);
constexpr int I_UQ = (QL / 64) * (NQ / 32), I_UKV = (KVL / 64) * (NKV / 32);
constexpr int I_O = (D / 64) * (D / 32);
constexpr int SEG0 = 0;
constexpr int SEG1 = SEG0 + 3 * I_F + 8 * I_P + 2 * I_DQ;
constexpr int SEG2 = SEG1 + 3 * I_F;
constexpr int SEG3 = SEG2 + I_UQ + I_UKV + I_O;
constexpr int SEG4 = SEG3 + 3 * I_F;
constexpr int SEG5 = SEG4 + 2 * I_F;
constexpr int SEG6 = SEG5 + I_UQ + I_UKV + I_O + I_F;
__device__ __forceinline__ TrD d_ffn(const In& I, unsigned char* ws, int l, int which, int item) {
    if (which < 2) { const int nblk = DFF / 32, kb = item / nblk, nb = item % nblk, n0 = nb * 32;
        return TrD{(which ? I.w3 : I.w1) + (size_t)l * D * DFF, DFF, kb * 64, n0, (bf16_t*)(ws + WS_W13) + (size_t)l * 2 * DFF * D, D, 256 * (n0 >> 7) + 128 * which + (n0 & 127), nullptr, nullptr, 1.f}; }
    const int nblk = D / 32, kb = item / nblk, nb = item % nblk;
    return TrD{I.w2 + (size_t)l * DFF * D, D, kb * 64, nb * 32, (bf16_t*)(ws + WS_W2) + (size_t)l * D * DFF, DFF, nb * 32, nullptr, nullptr, 1.f};
}
__device__ __forceinline__ TrD d_pool(const In& I, unsigned char* ws, int r) { const int jg = r / I_P, item = r % I_P, j = jg >> 2, g = jg & 3, nblk = 512 / 32, kb = item / nblk, nb = item % nblk;
    return TrD{I.pool_w + (size_t)jg * 512 * 512, 512, kb * 64, nb * 32, (bf16_t*)(ws + WS_WPOOL) + (size_t)j * D * 512, 512, g * 512 + nb * 32, nullptr, I.pool_scale + j * D + g * 512, 1.f}; }
__device__ __forceinline__ TrD d_dq(const In& I, unsigned char* ws, int j, int item) { const int nblk = 1088 / 32, kb = item / nblk, nb = item % nblk;
    return TrD{I.w_dqkv + (size_t)j * D * 1088, 1088, kb * 64, nb * 32, (bf16_t*)(ws + WS_WDQKV) + (size_t)j * NDQKV * D, D, nb * 32, nullptr, nullptr, 1.f}; }
__device__ __forceinline__ TrD d_uq(const In& I, unsigned char* ws, int j, int item) { const int nblk = NQ / 32, kb = item / nblk, nb = item % nblk;
    return TrD{I.w_uq + (size_t)j * QL * NQ, NQ, kb * 64, nb * 32, (bf16_t*)(ws + WS_WUP) + (size_t)j * NUP * 512, 512, nb * 32, I.q_norm + j * QL, nullptr, att::SCALE * 1.4426950408889634f}; }
__device__ __forceinline__ TrD d_ukv(const In& I, unsigned char* ws, int j, int item) { const int nblk = NKV / 32, kb = item / nblk, nb = item % nblk;
    return TrD{I.w_ukv + (size_t)j * KVL * NKV, NKV, kb * 64, nb * 32, (bf16_t*)(ws + WS_WUP) + (size_t)j * NUP * 512, 512, NQ + nb * 32, I.kv_norm + j * KVL, nullptr, 1.f}; }
__device__ __forceinline__ TrD d_o(const In& I, unsigned char* ws, int j, int item) { const int nblk = D / 32, kb = item / nblk, nb = item % nblk;
    return TrD{I.w_o + (size_t)j * D * D, D, kb * 64, nb * 32, (bf16_t*)(ws + WS_WO) + (size_t)j * D * D, D, nb * 32, nullptr, nullptr, 1.f}; }
__device__ __forceinline__ TrD tr_desc(const In& I, unsigned char* ws, int r) {
#define PIECE(cnt, expr) if (r < (cnt)) return expr; r -= (cnt);
    PIECE(I_F, d_ffn(I, ws, 0, 0, r)) PIECE(I_F, d_ffn(I, ws, 0, 1, r)) PIECE(I_F, d_ffn(I, ws, 0, 2, r)) PIECE(8 * I_P, d_pool(I, ws, r)) PIECE(I_DQ, d_dq(I, ws, 0, r)) PIECE(I_DQ, d_dq(I, ws, 1, r))
    PIECE(I_F, d_ffn(I, ws, 1, 0, r)) PIECE(I_F, d_ffn(I, ws, 1, 1, r)) PIECE(I_F, d_ffn(I, ws, 1, 2, r))
    PIECE(I_UQ, d_uq(I, ws, 0, r)) PIECE(I_UKV, d_ukv(I, ws, 0, r)) PIECE(I_O, d_o(I, ws, 0, r))
    PIECE(I_F, d_ffn(I, ws, 2, 0, r)) PIECE(I_F, d_ffn(I, ws, 2, 1, r)) PIECE(I_F, d_ffn(I, ws, 2, 2, r))
    PIECE(I_F, d_ffn(I, ws, 3, 0, r)) PIECE(I_F, d_ffn(I, ws, 3, 1, r))
    PIECE(I_UQ, d_uq(I, ws, 1, r)) PIECE(I_UKV, d_ukv(I, ws, 1, r)) PIECE(I_O, d_o(I, ws, 1, r))
    return d_ffn(I, ws, 3, 2, r);
#undef PIECE
}
__device__ __forceinline__ void tr_run(const In& I, unsigned char* ws, int seg_lo, int seg_n, int v, int vs, LAS float* scr, int lane) {
    float vA[32], vB[32]; TrD dA, dB; int it = v;
    if (it < seg_n) { dA = tr_desc(I, ws, seg_lo + it); tr_load(dA, vA, lane); }
    while (it < seg_n) {
        int itn = it + vs;
        if (itn < seg_n) { dB = tr_desc(I, ws, seg_lo + itn); tr_load(dB, vB, lane); }
        tr_finish(dA, vA, scr, lane);
        it = itn; if (it >= seg_n) break;
        itn = it + vs;
        if (itn < seg_n) { dA = tr_desc(I, ws, seg_lo + itn); tr_load(dA, vA, lane); }
        tr_finish(dB, vB, scr, lane);
        it = itn;
    }
}
#ifndef GEMV_DEFER
#define GEMV_DEFER 0
#endif
constexpr int KSPL2 = 64;
template <int KLEN>
__device__ __forceinline__ void gemv_task(const In& I, float* outp, int l, int st, int k0, int lane) {
    constexpr int NHALF = (KLEN + 63) / 64, HL = KLEN < 64 ? KLEN : 64;
    float sv[3][NHALF];
#pragma unroll
    for (int h = 0; h < NHALF; ++h) { const int k = k0 + h * 64 + (lane % HL); const float c0 = I.c[k], c1 = I.c[D + k], c2 = I.c_ctx[k];
        sv[0][h] = c0 / (1.f + __expf(-c0)); sv[1][h] = c1 / (1.f + __expf(-c1)); sv[2][h] = c2 / (1.f + __expf(-c2)); }
    const float* wp = I.ada_w + ((size_t)l * D + k0) * NMOD + st * 256 + lane * 4;
    f32x4 a0 = {0.f, 0.f, 0.f, 0.f}, a1 = a0, a2 = a0;
#pragma unroll
    for (int h = 0; h < NHALF; ++h)
#pragma unroll (KLEN < 64 ? 16 : 8)
        for (int kk = 0; kk < HL; ++kk) { const f32x4 w = __builtin_nontemporal_load((const f32x4*)(wp + (size_t)(h * 64 + kk) * NMOD));
            a0 += w * __shfl(sv[0][h], kk); a1 += w * __shfl(sv[1][h], kk); a2 += w * __shfl(sv[2][h], kk); }
    float* mp = outp + st * 256 + lane * 4;
    *(f32x4*)mp = a0; *(f32x4*)(mp + NMOD) = a1; *(f32x4*)(mp + 2 * NMOD) = a2;
}
__device__ __forceinline__ void filler(const In& I, unsigned char* ws, int gl, int seg_lo, int seg_n, int fi, int fn, LAS float* scr, int lane) {
    int v = fi;
    if (gl > 0) { constexpr int NG2 = (NMOD / 256) * KSPL2; float* mp2 = (float*)(ws + WS_MODP2) + (size_t)(gl - 1) * KSPL2 * 3 * NMOD;
#if GEMV_TWICE
        if (gl == 2) for (int v2 = fi; v2 < NG2; v2 += fn) { const int ks = v2 % KSPL2, st = v2 / KSPL2; gemv_task<D / KSPL2>(I, mp2 + (size_t)ks * 3 * NMOD, gl, st, ks * (D / KSPL2), lane); }
#endif
        for (; v < NG2; v += fn) { const int ks = v % KSPL2, st = v / KSPL2; gemv_task<D / KSPL2>(I, mp2 + (size_t)ks * 3 * NMOD, gl, st, ks * (D / KSPL2), lane); }
        v -= NG2; }
    tr_run(I, ws, seg_lo, seg_n, v, fn, scr, lane);
}

__device__ __forceinline__ void prologue(const In& I, unsigned char* ws, LAS unsigned char* lds, int gw, int ngw, int wave, int lane, int gtid, int ngt) {
    LAS float* scr = (LAS float*)(lds + wave * 16384);
    bf16_t* WDQKV = (bf16_t*)(ws + WS_WDQKV);
    tr_run(I, ws, SEG0, SEG1 - SEG0, gw, ngw, scr, lane);
    { constexpr int PER = (NDQKV - 1088) * D / 8;
        for (int i = gtid; i < 2 * PER; i += ngt) { const int j = i / PER, q = i % PER; *(u32x4*)(WDQKV + (size_t)j * NDQKV * D + (size_t)1088 * D + (size_t)q * 8) = (u32x4){0u, 0u, 0u, 0u}; } }
    if (gtid < 128 * 16) { const int pos = gtid >> 4, f = gtid & 15; const float inv = powf(10000.f, -(float)(2 * f) / 32.f), ang = (float)pos * inv;
        float* tab = (float*)(ws + WS_ROPE); tab[gtid * 2] = cosf(ang); tab[gtid * 2 + 1] = sinf(ang); }
    { float* MODP = (float*)(ws + WS_G); constexpr int NSTRIP = NMOD / 256, KLEN = D / KSPL;
        for (int task = gw; task < (GEMV_DEFER ? 2 : 4) * NSTRIP * KSPL; task += ngw) { const int ks = task % KSPL, st = (task / KSPL) % NSTRIP, l = task / (KSPL * NSTRIP);
            gemv_task<KLEN>(I, MODP + (size_t)ks * 12 * NMOD + (size_t)l * 3 * NMOD, l, st, ks * KLEN, lane); } }
}

struct RN { const float* xin_lat; const float* xin_ctx; const bf16_t* hin; const bf16_t* Y; const float* Yp; int nparts; const float* gate; const float* gY; bf16_t* hout; float* fout;
            const float* gN; const float* shift; const float* scale; bf16_t* U; int nrows; const float* modp; const float* bias; float* mod_out; };
template <bool HAS_Y, bool WRITE_U, bool HIN_F32, bool HOUT_F32, bool MODP_IN = false, bool POOLY = false>
__device__ __forceinline__ void resid_norm(const RN& a, LAS unsigned char* lds, int gw, int ngw, int tid) {
    asm volatile("" : "+v"(tid)); const int lane = tid & 63;
    typedef const GAS char* gcp; typedef GAS char* gp;
    if (MODP_IN) {
        for (int i = (gw * 64 + lane); i < (GEMV_DEFER ? 6 : 12) * NMOD / 4; i += ngw * 64) { f32x4 acc = *(const GAS f32x4*)((gcp)a.bias + 16 * ((size_t)(i / (3 * NMOD / 4)) * (NMOD / 4) + i % (NMOD / 4)));
            for (int p = 0; p < KSPL; ++p) acc += *(const GAS f32x4*)((gcp)a.modp + ((size_t)p * 12 * NMOD + (size_t)i * 4) * 4);
            *(GAS f32x4*)((gp)a.mod_out + (size_t)i * 16) = acc; } }
    for (int i = tid; i < 3 * (D / 4); i += NTHREADS) { const int s = i / (D / 4), c4 = i % (D / 4); LAS f32x4* t = (LAS f32x4*)(lds + s * 24576) + c4;
        if (HAS_Y) t[0] = *(const GAS f32x4*)((gcp)(a.gate + (size_t)s * NMOD) + 16 * c4) * *(const GAS f32x4*)((gcp)a.gY + 16 * c4);
        if (WRITE_U) { f32x4 sc, sh;
            if (MODP_IN) { sh = *(const GAS f32x4*)((gcp)a.bias + 16 * c4); sc = *(const GAS f32x4*)((gcp)a.bias + 16 * (D / 4 + c4));
                for (int p = 0; p < KSPL; ++p) { const float* mp = a.modp + (size_t)p * 12 * NMOD + (size_t)s * NMOD; sh += *(const GAS f32x4*)((gcp)mp + 16 * c4); sc += *(const GAS f32x4*)((gcp)mp + 16 * (D / 4 + c4)); } }
            else { sc = *(const GAS f32x4*)((gcp)(a.scale + (size_t)s * NMOD) + 16 * c4); sh = *(const GAS f32x4*)((gcp)(a.shift + (size_t)s * NMOD) + 16 * c4); }
            t[D / 4] = *(const GAS f32x4*)((gcp)a.gN + 16 * c4) * (sc + 1.f); t[2 * (D / 4)] = sh; } }
    __syncthreads();
    const unsigned l16 = (unsigned)lane * 16u, l8 = (unsigned)lane * 8u;
    const int nrows = a.nrows, nparts = a.nparts;
#define LDF4(base, j) (*(const GAS f32x4*)((gcp)(base) + l16 + 1024u * (j)))
#define LDB4(base, j) (*(const GAS u32x2*)((gcp)(base) + l8 + 512u * (j)))
#define UNPK(w) ((f32x4){bf_lo((w).x), bf_hi((w).x), bf_lo((w).y), bf_hi((w).y)})
#define RN_LOAD(hf, hw, yw, r) do { \
        if (HIN_F32) { const float* hp_ = (r) < TL ? a.xin_lat + (size_t)(r) * D : a.xin_ctx + (size_t)((r) - TL) * D; _Pragma("unroll") for (int j = 0; j < 8; ++j) hf[j] = LDF4(hp_, j); } \
        else { const bf16_t* hp_ = a.hin + (size_t)(r) * D; _Pragma("unroll") for (int j = 0; j < 8; ++j) hw[j] = LDB4(hp_, j); } \
        if (HAS_Y && !POOLY && !((r) >= TL && nparts > 0)) { const bf16_t* yr_ = a.Y + (size_t)(r) * D; _Pragma("unroll") for (int j = 0; j < 8; ++j) yw[j] = LDB4(yr_, j); } } while (0)
#define RN_PROC(hf, hw, yw, r) do { const int s_ = (r) < SEQ ? 0 : ((r) < TL ? 1 : 2); const LAS f32x4* tb_ = (const LAS f32x4*)(lds + s_ * 24576) + lane; f32x4 h[8]; \
        _Pragma("unroll") for (int j = 0; j < 8; ++j) h[j] = HIN_F32 ? hf[j] : UNPK(hw[j]); \
        if (HAS_Y) { f32x4 y[8]; float sy = 0.f; \
            if (POOLY) {   \
                int sb_, L_; if ((r) < TL) { sb_ = ((r) / SEQ) * SEQ; L_ = SEQ; } else { sb_ = TL + (((r) - TL) / CTXL) * CTXL; L_ = CTXL; } const int t_ = (r) - sb_; const bf16_t* zs_ = a.Y + (size_t)sb_ * D; \
                _Pragma("unroll") for (int g = 0; g < 4; ++g) { const int w2_ = 1 << g, lo_ = max(t_ - w2_, 0), hi_ = min(t_ + w2_, L_); const float inv_ = 1.f / (float)(hi_ - lo_); \
                    f32x4 s0_ = {0.f, 0.f, 0.f, 0.f}, s1_ = s0_; \
                    _Pragma("unroll") for (int i = 0; i < 2 * w2_; ++i) { const int q_ = t_ - w2_ + i; const bool ok_ = q_ >= 0 && q_ < L_; const bf16_t* zr_ = zs_ + (size_t)(ok_ ? q_ : t_) * D; \
                        const u32x2 wa_ = LDB4(zr_, 2 * g), wb_ = LDB4(zr_, 2 * g + 1); const float m_ = ok_ ? 1.f : 0.f; s0_ += UNPK(wa_) * m_; s1_ += UNPK(wb_) * m_; } \
                    const bf16_t* zc_ = zs_ + (size_t)t_ * D; const u32x2 ca_ = LDB4(zc_, 2 * g), cb_ = LDB4(zc_, 2 * g + 1); y[2 * g] = s0_ * inv_ - UNPK(ca_); y[2 * g + 1] = s1_ * inv_ - UNPK(cb_); } } \
            else if ((r) >= TL && nparts > 0) { _Pragma("unroll") for (int j = 0; j < 8; ++j) y[j] = (f32x4){0.f, 0.f, 0.f, 0.f}; \
                for (int p = 0; p < nparts; ++p) { const float* yp_ = a.Yp + ((size_t)p * TC + ((r) - TL)) * D; _Pragma("unroll") for (int j = 0; j < 8; ++j) y[j] += LDF4(yp_, j); } } \
            else { _Pragma("unroll") for (int j = 0; j < 8; ++j) y[j] = UNPK(yw[j]); } \
            _Pragma("unroll") for (int j = 0; j < 8; ++j) sy += (y[j][0] * y[j][0] + y[j][1] * y[j][1]) + (y[j][2] * y[j][2] + y[j][3] * y[j][3]); \
            const float rs_ = __builtin_amdgcn_rsqf(wave_sum(sy) * (1.f / D) + RMS_EPS); \
            _Pragma("unroll") for (int j = 0; j < 8; ++j) h[j] += tb_[64 * j] * (y[j] * rs_); } \
        if (HOUT_F32) { float* op_ = a.fout + (size_t)(r) * D; _Pragma("unroll") for (int j = 0; j < 8; ++j) __builtin_nontemporal_store(h[j], (GAS f32x4*)((gp)op_ + l16 + 1024u * j)); } \
        else if (a.hout) { bf16_t* op_ = a.hout + (size_t)(r) * D; _Pragma("unroll") for (int j = 0; j < 8; ++j) { u32x2 w; w.x = cvt_pk_bf16(h[j][0], h[j][1]); w.y = cvt_pk_bf16(h[j][2], h[j][3]); *(GAS u32x2*)((gp)op_ + l8 + 512u * j) = w; } } \
        if (WRITE_U) { float ss = 0.f; \
            _Pragma("unroll") for (int j = 0; j < 8; ++j) ss += (h[j][0] * h[j][0] + h[j][1] * h[j][1]) + (h[j][2] * h[j][2] + h[j][3] * h[j][3]); \
            const float rstd_ = __builtin_amdgcn_rsqf(wave_sum(ss) * (1.f / D) + RMS_EPS); bf16_t* ur_ = a.U + (size_t)(r) * D; \
            _Pragma("unroll") for (int j = 0; j < 8; ++j) { const f32x4 u = (h[j] * rstd_) * tb_[D / 4 + 64 * j] + tb_[2 * (D / 4) + 64 * j]; u32x2 w; w.x = cvt_pk_bf16(u[0], u[1]); w.y = cvt_pk_bf16(u[2], u[3]); \
                *(GAS u32x2*)((gp)ur_ + l8 + 512u * j) = w; } } } while (0)
    f32x4 hfA[8], hfB[8], hfC[8]; u32x2 hwA[8], hwB[8], hwC[8], ywA[8], ywB[8], ywC[8];
    int r = POOLY ? gw : (gw % NWAVES) * (ngw / NWAVES) + gw / NWAVES;
    if (r < nrows) RN_LOAD(hfA, hwA, ywA, r);
    if (r + ngw < nrows) RN_LOAD(hfB, hwB, ywB, r + ngw);
    while (r < nrows) {
        if (r + 2 * ngw < nrows) RN_LOAD(hfC, hwC, ywC, r + 2 * ngw);
        RN_PROC(hfA, hwA, ywA, r);
        r += ngw; if (r >= nrows) break;
        if (r + 2 * ngw < nrows) RN_LOAD(hfA, hwA, ywA, r + 2 * ngw);
        RN_PROC(hfB, hwB, ywB, r);
        r += ngw; if (r >= nrows) break;
        if (r + 2 * ngw < nrows) RN_LOAD(hfB, hwB, ywB, r + 2 * ngw);
        RN_PROC(hfC, hwC, ywC, r);
        r += ngw;
    }
#undef LDF4
#undef LDB4
#undef UNPK
#undef RN_LOAD
#undef RN_PROC
    __syncthreads();
}

__device__ __forceinline__ void krope_phase(const bf16_t* __restrict__ CQKV, bf16_t* __restrict__ KR, const float* __restrict__ tab, int gtid, int ngt) {
    asm volatile("" : "+v"(gtid));
    for (int i = gtid; i < T * 32; i += ngt) { const int r = i >> 5, ax = (i >> 4) & 1, f = i & 15;
        const bf16_t* src = CQKV + (size_t)r * NDQKV + 1024 + ax * 32 + f; const float x1 = bf_lo((unsigned)src[0]), x2 = bf_lo((unsigned)src[16]); float o1 = x1, o2 = x2;
        if (r < TL) { const int t = r & (SEQ - 1), pos = ax ? (t & 63) : (t >> 6); const float c = tab[(pos * 16 + f) * 2], s = tab[(pos * 16 + f) * 2 + 1]; o1 = x1 * c - x2 * s; o2 = x2 * c + x1 * s; }
        bf16_t* dst = KR + (size_t)r * ROPED + ax * 32 + f; dst[0] = (bf16_t)(cvt_pk_bf16(o1, 0.f) & 0xffffu); dst[16] = (bf16_t)(cvt_pk_bf16(o2, 0.f) & 0xffffu); }
}

#ifndef EN_P0
#define EN_P0 1
#endif
#ifndef EN_P1
#define EN_P1 1
#endif
#ifndef EN_S0
#define EN_S0 1
#endif
#ifndef EN_S1
#define EN_S1 1
#endif
#ifndef EN_S2
#define EN_S2 1
#endif
#ifndef EN_S3
#define EN_S3 1
#endif
#ifndef EN_S4
#define EN_S4 1
#endif
#ifndef EN_S5
#define EN_S5 1
#endif
#ifndef EN_S6
#define EN_S6 1
#endif
#ifndef EN_S7
#define EN_S7 1
#endif
struct Args { const float* in[18]; float* out; unsigned char* ws; int ph_lo, ph_hi; };
constexpr int N_PHASES = 34;
constexpr int SPLIT_POOL = 2, SPLIT_WO = 8, SPLIT_FFN2 = 11;

__global__ void __launch_bounds__(NTHREADS, 2) mk_fwd(Args args) {
    extern __shared__ __attribute__((aligned(16))) unsigned char lds_raw[];
    LAS unsigned char* lds = (LAS unsigned char*)lds_raw;
    volatile LAS unsigned* MISC = (volatile LAS unsigned*)(lds + MISC_OFF);
    const int G0 = gridDim.x, bid0 = blockIdx.x;
    unsigned char* ws = args.ws;
    for (int u = threadIdx.x; u < (LDS_BYTES - MISC_OFF) / 4; u += NTHREADS) ((LAS unsigned*)(lds + MISC_OFF))[u] = 0u;
    __syncthreads();
#if MK_PER_PHASE
    const int lo = args.ph_lo, hi = args.ph_hi;
#else
    constexpr int lo = 0, hi = N_PHASES;
#endif
    const bool use_bar = (hi - lo) > 1;
    XcdBarrier bar; bar.bar = (unsigned*)(ws + WS_CTL) + CW_BAR; bar.x = 0; bar.st = MISC + 8;
    if (use_bar) bar = xcd_barrier_post((unsigned*)(ws + WS_CTL) + CW_BAR, MISC + 8);
#define IN(k) (lo <= (k) && (k) < hi)
#define PHASE_END(k) do { if (hi > (k) + 1) xcd_barrier(bar); } while (0)
#define SITE() int tid = threadIdx.x, G = G0, bid = bid0; asm volatile("" : "+v"(tid), "+s"(G), "+s"(bid)); const int lane = tid & 63, wave = __builtin_amdgcn_readfirstlane(tid >> 6), gw = bid * NWAVES + wave, gtid = bid * NTHREADS + tid, ngw = G * NWAVES, ngt = G * NTHREADS; \
               (void)lane; (void)gw; (void)gtid; (void)ngw; (void)ngt; const __attribute__((address_space(4))) char* kp_ = (const __attribute__((address_space(4))) char*)__builtin_amdgcn_kernarg_segment_ptr(); asm volatile("" : "+s"(kp_)); \
               unsigned char* wsl = *(unsigned char* const __attribute__((address_space(4)))*)(kp_ + 19 * 8); asm volatile("" : "+s"(wsl))
#define KIN(k) (*(const float* const __attribute__((address_space(4)))*)(kp_ + (k) * 8))
#define KOUT() (*(float* const __attribute__((address_space(4)))*)(kp_ + 18 * 8))
#define WP(type, off) ((type*)(wsl + (off)))
#define MKIN() In I; I.x = KIN(0); I.c = KIN(1); I.ctx = KIN(2); I.c_ctx = KIN(3); I.ada_w = KIN(4); I.ada_b = KIN(5); I.norm_g = KIN(6); I.pool_w = KIN(7); \
               I.pool_scale = KIN(8); I.w_dqkv = KIN(9); I.q_norm = KIN(10); I.w_uq = KIN(11); I.kv_norm = KIN(12); I.w_ukv = KIN(13); I.w_o = KIN(14); I.w1 = KIN(15); I.w3 = KIN(16); I.w2 = KIN(17)
#define FILL_TAIL(gl, seg_lo, seg_hi) do { const int nshort_ = S.nwg % G; if (bid >= nshort_) { __syncthreads(); MKIN();   \
               filler(I, wsl, (gl), (seg_lo), (seg_hi) - (seg_lo), (bid - nshort_) * NWAVES + wave, (G - nshort_) * NWAVES, (LAS float*)(lds + wave * 16384), lane); } } while (0)

    if (EN_P0 && IN(0)) { SITE();
        MKIN();
        prologue(I, wsl, lds, gw, ngw, wave, lane, gtid, ngt); PHASE_END(0); }
    if (EN_P1 && IN(1)) { SITE();
        RN a; a.xin_lat = KIN(0); a.xin_ctx = KIN(2); a.hin = nullptr; a.Y = nullptr; a.Yp = nullptr; a.nparts = 0; a.gate = nullptr; a.gY = nullptr; a.hout = nullptr; a.fout = nullptr;
        a.gN = KIN(6); a.shift = nullptr; a.scale = nullptr; a.U = WP(bf16_t, WS_U); a.nrows = T; a.modp = WP(const float, WS_G); a.bias = KIN(5); a.mod_out = WP(float, WS_MOD);
        resid_norm<false, true, true, false, true>(a, lds, gw, ngw, tid); PHASE_END(1); }

    for (int L = 0; L < 4; ++L) {
        const int base = 2 + 8 * L, j = L >> 1; const bool pool = (L & 1) == 0;
        const int Mrows = (L == 3) ? TL : T;
        if (EN_S0 && !pool && IN(base + 0)) { SITE(); float* SSQ = WP(float, WS_SSQ);
            pg8::Gemm g{WP(const bf16_t, WS_U), WP(const bf16_t, WS_WDQKV) + (size_t)j * NDQKV * D, T, NDQKV, D, D, D}; pg8::StaticOrder S; S.init(T, NDQKV, D, G, bid);
            pg8::EpiStore E{WP(bf16_t, WS_CQKV), NDQKV, SSQ, SSQ + (size_t)8 * T, 2, 4, 0, 0};
            pg8::gemm_phase<pg8::EpiStore, pg8::StaticOrder>(lds, g, S, E);
            { const int lo_ = L == 1 ? SEG2 : SEG5, hi_ = L == 1 ? SEG3 : SEG6; FILL_TAIL(GEMV_DEFER && L == 1 ? 2 : 0, lo_, hi_); }
            PHASE_END(base + 0); }
        if (EN_S1 && !pool && IN(base + 1)) { SITE(); float* SSQ = WP(float, WS_SSQ);
            krope_phase(WP(const bf16_t, WS_CQKV), WP(bf16_t, WS_KR), WP(const float, WS_ROPE), gtid, ngt);
            pg8::Gemm g{WP(const bf16_t, WS_CQKV), WP(const bf16_t, WS_WUP) + (size_t)j * NUP * 512, T, NUP, 512, NDQKV, 512}; pg8::StaticOrder S; S.init(T, NUP, 512, G, bid);
            pg8::EpiUp E{WP(bf16_t, WS_Q), WP(bf16_t, WS_KV), SSQ, SSQ + (size_t)8 * T};
            pg8::gemm_phase<pg8::EpiUp, pg8::StaticOrder>(lds, g, S, E);
            PHASE_END(base + 1); }
        if (EN_S2 && !pool && IN(base + 2)) { SITE();
            const bf16_t* Qb = WP(const bf16_t, WS_Q); const bf16_t* KV = WP(const bf16_t, WS_KV); bf16_t* P = WP(bf16_t, WS_P);
            const int nlat = NB * NH * (SEQ / 256), nunits = nlat + (L == 1 ? NB * NH : 0);
            for (int u = bid; u < nunits; u += G) {
                att::Unit A;
                if (u < nlat) { const int pair = (u >> 8) * 8 + (u & 7), qb = (u & 255) >> 3, b = pair >> 4, h = pair & 15; const int row0 = b * SEQ + qb * 256;
                    A.Qb = Qb + (size_t)row0 * NQ + h * QKD; A.KVh = KV + h * 256; A.Ob = P + (size_t)row0 * D + h * VD; A.kb_lat = b * SEQ; A.nt_lat = SEQ / 64; A.kb_ctx = TL + b * CTXL; A.NT = SEQ / 64 + CTXL / 64; A.qpos0 = qb * 256; }
                else { const int v = u - nlat, b = v >> 4, h = v & 15; const int row0 = TL + b * CTXL;
                    A.Qb = Qb + (size_t)row0 * NQ + h * QKD; A.KVh = KV + h * 256; A.Ob = P + (size_t)row0 * D + h * VD; A.kb_lat = 0; A.nt_lat = 0; A.kb_ctx = row0; A.NT = CTXL / 64; A.qpos0 = -1; }
                att::attn_unit_auto(A, WP(const bf16_t, WS_KR), WP(const float, WS_ROPE), lds);
            }
            PHASE_END(base + 2); }
        if (EN_S3 && IN(base + 3)) { SITE();
            pg8::Gemm g; pg8::EpiY E{WP(bf16_t, WS_Y), WP(float, WS_YP), D, TL, TC, 0, 0}; pg8::HybridOrder S;
            if (pool) { g = pg8::Gemm{WP(const bf16_t, WS_U), WP(const bf16_t, WS_WPOOL) + (size_t)j * D * 512, Mrows, D, 512, D, 512}; E.a_grp_tiles = 2; E.a_grp_off = 512; S.init(Mrows, Mrows, D, 512, G, bid, 1); }
            else { g = pg8::Gemm{WP(const bf16_t, WS_P), WP(const bf16_t, WS_WO) + (size_t)j * D * D, Mrows, D, D, D, D}; S.init(TL, Mrows, D, D, G, bid, SPLIT_WO); }
            pg8::gemm_phase<pg8::EpiY, pg8::HybridOrder>(lds, g, S, E);
            PHASE_END(base + 3); }
        if (EN_S4 && IN(base + 4)) { SITE(); const float* modL = WP(const float, WS_MOD) + (size_t)L * 3 * NMOD; const float* gL = KIN(6) + (size_t)L * 4 * D;
            RN a; a.xin_lat = KIN(0); a.xin_ctx = KIN(2); a.hin = WP(const bf16_t, WS_H); a.Y = WP(const bf16_t, WS_Y); a.Yp = WP(const float, WS_YP); a.nparts = (!pool && Mrows > TL) ? SPLIT_WO : 0; a.gate = modL + 2 * D; a.gY = gL + D;
            a.hout = WP(bf16_t, WS_H); a.fout = nullptr; a.gN = gL + 2 * D; a.shift = modL + 3 * D; a.scale = modL + 4 * D; a.U = WP(bf16_t, WS_U); a.nrows = Mrows; a.modp = nullptr; a.bias = nullptr; a.mod_out = nullptr;
            if (L == 0) resid_norm<true, true, true, false, false, true>(a, lds, gw, ngw, tid); else if (pool) resid_norm<true, true, false, false, false, true>(a, lds, gw, ngw, tid); else resid_norm<true, true, false, false>(a, lds, gw, ngw, tid);
            PHASE_END(base + 4); }
        if (EN_S5 && IN(base + 5)) { SITE(); pg8::Gemm g{WP(const bf16_t, WS_U), WP(const bf16_t, WS_W13) + (size_t)L * 2 * DFF * D, Mrows, 2 * DFF, D, D, D}; pg8::StaticOrder S; S.init(Mrows, 2 * DFF, D, G, bid);
            pg8::EpiSwiGLU E{WP(bf16_t, WS_G), DFF};
            pg8::gemm_phase<pg8::EpiSwiGLU, pg8::StaticOrder>(lds, g, S, E);
            if (L < 3) { const int lo_ = L == 0 ? SEG1 : L == 1 ? SEG3 : SEG4, hi_ = L == 0 ? SEG2 : L == 1 ? SEG4 : SEG5; FILL_TAIL(GEMV_DEFER && L == 2 ? 3 : 0, lo_, hi_); }
            PHASE_END(base + 5); }
        if (EN_S6 && IN(base + 6)) { SITE();
            pg8::Gemm g{WP(const bf16_t, WS_G), WP(const bf16_t, WS_W2) + (size_t)L * D * DFF, Mrows, D, DFF, DFF, DFF}; pg8::HybridOrder S; S.init(TL, Mrows, D, DFF, G, bid, SPLIT_FFN2);
            pg8::EpiY E{WP(bf16_t, WS_Y), WP(float, WS_YP), D, TL, TC, 0, 0};
            pg8::gemm_phase<pg8::EpiY, pg8::HybridOrder>(lds, g, S, E);
            if (GEMV_DEFER && (L == 1 || L == 2)) { const float* mp2 = WP(const float, WS_MODP2) + (size_t)L * KSPL2 * 3 * NMOD; const float* bias = KIN(5) + (size_t)(L + 1) * NMOD; float* mo = WP(float, WS_MOD) + (size_t)(L + 1) * 3 * NMOD;
                for (int o = gtid; o < 3 * NMOD; o += ngt) { float acc = bias[o % NMOD];
#pragma unroll 16
                    for (int p = 0; p < KSPL2; ++p) acc += mp2[(size_t)p * 3 * NMOD + o];
                    mo[o] = acc; } }
            PHASE_END(base + 6); }
        if (EN_S7 && IN(base + 7)) { SITE(); const float* modL = WP(const float, WS_MOD) + (size_t)L * 3 * NMOD; const float* gL = KIN(6) + (size_t)L * 4 * D;
            RN a; a.xin_lat = nullptr; a.xin_ctx = nullptr; a.hin = WP(const bf16_t, WS_H); a.Y = WP(const bf16_t, WS_Y); a.Yp = WP(const float, WS_YP); a.nparts = L < 3 ? SPLIT_FFN2 : 0; a.gate = modL + 5 * D; a.gY = gL + 3 * D; a.modp = nullptr; a.bias = nullptr; a.mod_out = nullptr;
            if (L < 3) { a.hout = WP(bf16_t, WS_H); a.fout = nullptr; a.gN = gL + 4 * D; a.shift = modL + 3 * NMOD; a.scale = modL + 3 * NMOD + D; a.U = WP(bf16_t, WS_U); a.nrows = T;
                resid_norm<true, true, false, false>(a, lds, gw, ngw, tid); }
            else { a.hout = nullptr; a.fout = KOUT(); a.gN = nullptr; a.shift = nullptr; a.scale = nullptr; a.U = nullptr; a.nrows = TL;
                resid_norm<true, false, false, true>(a, lds, gw, ngw, tid); }
            PHASE_END(base + 7); }
    }
#undef IN
#undef PHASE_END
}

extern "C" void kernel_launch(void* const* d_in, const int* in_sizes, int n_in, void* d_out, int out_size, void* d_ws, size_t ws_size, hipStream_t stream) {
    static int grid = 0;
    if (grid == 0) {
        if (n_in != 18 || in_sizes[0] != TL * D || out_size != TL * D || ws_size < WS_END) { fprintf(stderr, "kernel_launch: unexpected shapes (n_in %d, in0 %d, out %d, ws %zu); nothing launched\n", n_in, n_in > 0 ? in_sizes[0] : -1, out_size, ws_size); grid = -1; return; }
        int dev = 0, cus = 0, per_cu = 0;
        if (hipGetDevice(&dev) != hipSuccess || hipDeviceGetAttribute(&cus, hipDeviceAttributeMultiprocessorCount, dev) != hipSuccess) { grid = -1; return; }
        if (hipFuncSetAttribute((const void*)mk_fwd, hipFuncAttributeMaxDynamicSharedMemorySize, LDS_BYTES) != hipSuccess) { fprintf(stderr, "kernel_launch: hipFuncSetAttribute failed\n"); grid = -1; return; }
        if (hipOccupancyMaxActiveBlocksPerMultiprocessor(&per_cu, (const void*)mk_fwd, NTHREADS, LDS_BYTES) != hipSuccess || per_cu < 1) { fprintf(stderr, "kernel_launch: occupancy query says %d blocks per CU\n", per_cu); }
        (void)hipGetLastError();
        grid = cus;
    }
    if (grid < 0) return;
    if (hipMemsetAsync((char*)d_ws + WS_CTL, 0, CTL_ZERO_BYTES, stream) != hipSuccess) return;
    Args a{};
    for (int i = 0; i < 18; ++i) a.in[i] = (const float*)d_in[i];
    a.out = (float*)d_out; a.ws = (unsigned char*)d_ws;
#if MK_PER_PHASE
    for (int p = 0; p < N_PHASES; ++p) { const int k = p - 2, L = k >> 3, s = k & 7; if (p >= 2 && (L & 1) == 0 && s <= 2) continue;
        a.ph_lo = p; a.ph_hi = p + 1; hipLaunchKernelGGL(mk_fwd, dim3(grid), dim3(NTHREADS), LDS_BYTES, stream, a); }
#else
    a.ph_lo = 0; a.ph_hi = N_PHASES; hipLaunchKernelGGL(mk_fwd, dim3(grid), dim3(NTHREADS), LDS_BYTES, stream, a);
#endif
    const hipError_t le = hipPeekAtLastError();
    if (le != hipSuccess) fprintf(stderr, "kernel_launch: launch failed: %s\n", hipGetErrorName(le));
}
```

```cpp
#include <hip/hip_runtime.h>
#include <cstdio>
#include <cstdint>

#ifndef MK_PER_PHASE
#define MK_PER_PHASE 0
#endif

#define LAS __attribute__((address_space(3)))
#define GAS __attribute__((address_space(1)))
typedef unsigned short bf16_t;
typedef short bf16x8 __attribute__((ext_vector_type(8)));
typedef short s16x4 __attribute__((ext_vector_type(4)));
typedef float f32x4 __attribute__((ext_vector_type(4)));
typedef float f32x2 __attribute__((ext_vector_type(2)));
typedef float f32x16 __attribute__((ext_vector_type(16)));
typedef unsigned u32x4 __attribute__((ext_vector_type(4)));
typedef unsigned u32x2 __attribute__((ext_vector_type(2)));

constexpr int D = 2048, SEQ = 8192, NB = 2, CTXL = 256, TL = NB * SEQ, TC = NB * CTXL, T = TL + TC;
constexpr int DFF = 5632, NH = 16, QKD = 192, NOPE = 128, ROPED = 64, VD = 128, QL = 512, KVL = 512;
constexpr int NDQKV = 1280;
constexpr int NQ = NH * QKD, NKV = NH * (NOPE + VD), NUP = NQ + NKV;
constexpr int NMOD = 6 * D;
constexpr float RMS_EPS = 1e-6f;
constexpr int NWAVES = 8, NTHREADS = 512;

__device__ __forceinline__ unsigned cvt_pk_bf16(float lo, float hi) { unsigned r; asm volatile("v_cvt_pk_bf16_f32 %0, %1, %2" : "=v"(r) : "v"(lo), "v"(hi)); return r; }
__device__ __forceinline__ float bf_lo(unsigned w) { return __uint_as_float(w << 16); }
__device__ __forceinline__ float bf_hi(unsigned w) { return __uint_as_float(w & 0xffff0000u); }
__device__ __forceinline__ float wave_sum(float v) {
    int ln_ = threadIdx.x & 63; asm volatile("" : "+v"(ln_));
#pragma unroll
    for (int o = 1; o < 64; o <<= 1) v += __int_as_float(__builtin_amdgcn_ds_bpermute((ln_ ^ o) << 2, __float_as_int(v)));
    return v;
}

namespace pg8 {
constexpr int BM = 256, BK = 64, HALF = 128, HTB = HALF * BK * 2, STAGE_BYTES = 8 * HTB, NXCD = 8, WGM = 4;
__host__ __device__ __forceinline__ int lds_byte(int r, int c) { const int st = (r >> 4) * 2 + (c >> 5), rr = r & 15, cc = c & 31, ob = rr * 64 + cc * 2; return st * 1024 + (ob ^ (((ob >> 9) & 1) << 5)); }
__host__ __device__ __forceinline__ void stage_rc(int b, int& R, int& C) { const int st = b / 1024, sb = b % 1024, swz = sb ^ (((sb >> 9) & 1) << 5); R = (st >> 1) * 16 + swz / 64; C = (st & 1) * 32 + (swz % 64) / 2; }
__host__ __device__ __forceinline__ int perm32(int rho) { const int n = rho >> 4, i = rho & 15; return 8 * (i >> 2) + 4 * n + (i & 3); }

struct Unit { int pm, pn, kt0, nkt, part; };
struct Gemm { const bf16_t* A; const bf16_t* Bt; int M, N, K, lda, ldb; };

struct StaticOrder {
    int nM, nN, nwg, G, c, nkt;
    __host__ __device__ void init(int M, int N, int K, int G_, int c_) { nM = M / BM; nN = N / BM; nwg = nM * nN; G = G_; c = c_; nkt = K / BK; }
    __host__ __device__ bool next(int i, Unit& u) const {
        const long L = (long)i * G + c; if (L >= nwg) return false;
        int wgid = (int)L; { const int q = nwg / NXCD, r = nwg % NXCD, xcd = wgid % NXCD, off = wgid / NXCD; wgid = (xcd < r ? xcd * (q + 1) : r * (q + 1) + (xcd - r) * q) + off; }
        const int nig = WGM * nN, gid = wgid / nig, fm = gid * WGM, gsz = (nM - fm) < WGM ? (nM - fm) : WGM;
        u.pm = fm + ((wgid % nig) % gsz); u.pn = (wgid % nig) / gsz; u.kt0 = 0; u.nkt = nkt; u.part = -1; return true;
    }
};
struct HybridOrder {
    StaticOrder full; int nfull, nsplit, S, nktp, nN, pm0, G, c;
    __host__ __device__ void init(int Mfull, int Mtot, int N, int K, int G_, int c_, int S_) { full.init(Mfull, N, K, G_, c_); nfull = full.nwg; nN = N / BM; pm0 = Mfull / BM; S = S_; nktp = (K / BK) / S_;
        nsplit = ((Mtot - Mfull) / BM) * nN * S_; G = G_; c = c_; }
    __host__ __device__ bool next(int i, Unit& u) const {
        const long L = (long)i * G + c; if (L < nfull) return full.next(i, u);
        const int e = (int)(L - nfull); if (e >= nsplit) return false;
        const int part = e % S, tile = e / S; u.pm = pm0 + tile / nN; u.pn = tile % nN; u.kt0 = part * nktp; u.nkt = nktp; u.part = part; return true;
    }
};

template <class Epi, class Sched, bool ALIGN_EPI = true>
__device__ __forceinline__ void gemm_phase(LAS unsigned char* lds, const Gemm g, const Sched& S, const Epi& E) {
    int tid = threadIdx.x; asm volatile("" : "+v"(tid));
    const int wid = __builtin_amdgcn_readfirstlane(tid >> 6), lane = tid & 63, wr = wid >> 2, wc = wid & 3, fr = lane & 15, fq = lane >> 4;
    unsigned voffA[2], voffB[2];
#pragma unroll
    for (int i = 0; i < 2; ++i) { int R, C; stage_rc(tid * 16 + i * 8192, R, C); const int Rb = (R & ~31) + perm32(R & 31);
        voffA[i] = (unsigned)(R * g.lda + C) * 2u; voffB[i] = (unsigned)(Rb * g.ldb + C) * 2u; }
    const size_t kstep = (size_t)(BK * 2);
    const size_t hstepA = (size_t)HALF * g.lda * 2, hstepB = (size_t)HALF * g.ldb * 2;
    const size_t tstepA = 2 * hstepA, tstepB = 2 * hstepB;
    const unsigned ldsw = (unsigned)wid * 1024u;
    const int aoff = lds_byte(wr * 64 + fr, fq * 8), boff = lds_byte(wc * 32 + fr, fq * 8);
#define PG8_SA(b, h) (((b) * 2 + (h)) * HTB)
#define PG8_SB(b, h) ((4 + (b) * 2 + (h)) * HTB)
#define PG8_STAGE(bufoff, gbase, voff) do { _Pragma("unroll") for (int _i = 0; _i < 2; ++_i) \
        __builtin_amdgcn_global_load_lds((const unsigned*)((const char*)(gbase) + (voff)[_i]), (LAS unsigned*)(lds + (bufoff) + ldsw + _i * 8192), 16, 0, 0); } while (0)
#define PG8_LDA(dst, b, h) do { _Pragma("unroll") for (int m = 0; m < 4; ++m) _Pragma("unroll") for (int k = 0; k < 2; ++k) dst[m][k] = *(const LAS bf16x8*)(lds + PG8_SA(b, h) + aoff + m * 2048 + k * 1024); } while (0)
#define PG8_LDB(dst, b, h) do { _Pragma("unroll") for (int n = 0; n < 2; ++n) _Pragma("unroll") for (int k = 0; k < 2; ++k) dst[n][k] = *(const LAS bf16x8*)(lds + PG8_SB(b, h) + boff + n * 2048 + k * 1024); } while (0)
#define PG8_MMA(ai, bj, At, Bt) do { __builtin_amdgcn_s_setprio(1); _Pragma("unroll") for (int m = 0; m < 4; ++m) _Pragma("unroll") for (int n = 0; n < 2; ++n) _Pragma("unroll") for (int k = 0; k < 2; ++k) \
        acc[ai][bj][m][n] = __builtin_amdgcn_mfma_f32_16x16x32_bf16(Bt[n][k], At[m][k], acc[ai][bj][m][n], 0, 0, 0); __builtin_amdgcn_s_setprio(0); } while (0)
#define PG8_WAIT_V(n) asm volatile("s_waitcnt vmcnt(" #n ")" ::: "memory")
#define PG8_WAIT_L(n) asm volatile("s_waitcnt lgkmcnt(" #n ")" ::: "memory")
#define PG8_BAR __builtin_amdgcn_s_barrier()
#define PG8_SCHED __builtin_amdgcn_sched_barrier(0)
    Unit cur, nxt; int ui = 0;
    if (!S.next(0, cur)) return;
    f32x4 acc[2][2][4][2];
#pragma unroll
    for (int a = 0; a < 2; ++a)
#pragma unroll
        for (int b = 0; b < 2; ++b)
#pragma unroll
            for (int m = 0; m < 4; ++m)
#pragma unroll
                for (int n = 0; n < 2; ++n) acc[a][b][m][n] = (f32x4){0.f, 0.f, 0.f, 0.f};
    bf16x8 At[4][2], B0[2][2], B1[2][2];
    const char* cA = (const char*)g.A + (size_t)cur.pm * tstepA + (size_t)E.a_off(cur.pn) * 2 + (size_t)cur.kt0 * kstep; const char* cB = (const char*)g.Bt + (size_t)cur.pn * tstepB + (size_t)cur.kt0 * kstep;
    PG8_STAGE(PG8_SB(0, 0), cB, voffB); PG8_STAGE(PG8_SB(0, 1), cB + hstepB, voffB); PG8_STAGE(PG8_SA(0, 0), cA, voffA); PG8_STAGE(PG8_SA(0, 1), cA + hstepA, voffA);
    if (wr == 1) PG8_BAR;
    PG8_WAIT_V(2); PG8_BAR;
    PG8_STAGE(PG8_SB(1, 0), cB + kstep, voffB); PG8_STAGE(PG8_SA(1, 0), cA + kstep, voffA); PG8_STAGE(PG8_SB(1, 1), cB + hstepB + kstep, voffB);
    PG8_WAIT_V(6); PG8_BAR;
    for (;;) {
        const bool has_next = S.next(ui + 1, nxt);
        const char* nA = has_next ? (const char*)g.A + (size_t)nxt.pm * tstepA + (size_t)E.a_off(nxt.pn) * 2 + (size_t)nxt.kt0 * kstep : cA; const char* nB = has_next ? (const char*)g.Bt + (size_t)nxt.pn * tstepB + (size_t)nxt.kt0 * kstep : cB;
        const int nt = cur.nkt;
        asm volatile(".p2align 6");
        for (int t = 0; t < nt; t += 2) {
            const bool last = (t == nt - 2);
            const char* a1 = cA + (size_t)(t + 1) * kstep;
            const char* a2 = last ? nA : cA + (size_t)(t + 2) * kstep; const char* b2 = last ? nB : cB + (size_t)(t + 2) * kstep;
            const char* a3 = a2 + kstep; const char* b3 = b2 + kstep;
            PG8_LDB(B0, 0, 0); PG8_LDB(B1, 0, 1); PG8_SCHED; PG8_LDA(At, 0, 0); PG8_STAGE(PG8_SA(1, 1), a1 + hstepA, voffA);
            PG8_WAIT_V(8); PG8_WAIT_L(0); PG8_BAR; PG8_MMA(0, 0, At, B0); PG8_MMA(0, 1, At, B1); PG8_BAR; PG8_SCHED;
            PG8_LDA(At, 0, 1); PG8_STAGE(PG8_SB(0, 0), b2, voffB); PG8_STAGE(PG8_SB(0, 1), b2 + hstepB, voffB); PG8_STAGE(PG8_SA(0, 0), a2, voffA);
            PG8_WAIT_V(8); PG8_WAIT_L(0); PG8_BAR; PG8_MMA(1, 0, At, B0); PG8_MMA(1, 1, At, B1); PG8_BAR; PG8_SCHED;
            PG8_LDB(B0, 1, 0); PG8_LDB(B1, 1, 1); PG8_SCHED; PG8_LDA(At, 1, 0); PG8_STAGE(PG8_SA(0, 1), a2 + hstepA, voffA);
            PG8_WAIT_V(8); PG8_WAIT_L(0); PG8_BAR; PG8_MMA(0, 0, At, B0); PG8_MMA(0, 1, At, B1); PG8_BAR; PG8_SCHED;
            PG8_LDA(At, 1, 1); PG8_STAGE(PG8_SB(1, 0), b3, voffB); PG8_STAGE(PG8_SB(1, 1), b3 + hstepB, voffB); PG8_STAGE(PG8_SA(1, 0), a3, voffA);
            PG8_WAIT_V(8); PG8_WAIT_L(0); PG8_BAR; PG8_MMA(1, 0, At, B0); PG8_MMA(1, 1, At, B1); PG8_BAR; PG8_SCHED;
        }
        if constexpr (ALIGN_EPI) { if (wr == 0) PG8_BAR; }
        E(acc, cur, wr, wc, fr, fq);
        if (!has_next) break;
#pragma unroll
        for (int a = 0; a < 2; ++a)
#pragma unroll
            for (int b = 0; b < 2; ++b)
#pragma unroll
                for (int m = 0; m < 4; ++m)
#pragma unroll
                    for (int n = 0; n < 2; ++n) acc[a][b][m][n] = (f32x4){0.f, 0.f, 0.f, 0.f};
        cur = nxt; cA = nA; cB = nB; ++ui;
        if constexpr (ALIGN_EPI) { if (wr == 1) PG8_BAR; }
    }
    PG8_WAIT_V(0);
    if constexpr (!ALIGN_EPI) { if (wr == 0) PG8_BAR; }
    PG8_BAR;
#undef PG8_SA
#undef PG8_SB
#undef PG8_STAGE
#undef PG8_LDA
#undef PG8_LDB
#undef PG8_MMA
#undef PG8_WAIT_V
#undef PG8_WAIT_L
#undef PG8_BAR
#undef PG8_SCHED
}

#ifndef EPI_SC1
#define EPI_SC1 0
#endif
__device__ __forceinline__ void st16(void* p, u32x4 w) {
#if EPI_SC1
    asm volatile("global_store_dwordx4 %0, %1, off sc1\n\ts_nop 1" :: "v"(p), "v"(w) : "memory");
#else
    *(u32x4*)p = w;
#endif
}
struct EpiStore {
    bf16_t* O; int ldc; float* ssq0; float* ssq1; int split0, split1; int a_grp_tiles, a_grp_off;
    __device__ __forceinline__ int a_off(int pn) const { return a_grp_tiles ? (pn / a_grp_tiles) * a_grp_off : 0; }
    __device__ __forceinline__ void operator()(const f32x4 (&acc)[2][2][4][2], const Unit& u, int wr, int wc, int fr, int fq) const {
        const int row0 = u.pm * BM + wr * 64 + fr, col0 = u.pn * BM + wc * 32 + 8 * fq;
        float* ssq = u.pn < split0 ? ssq0 : (u.pn < split1 ? ssq1 : nullptr);
#pragma unroll
        for (int ai = 0; ai < 2; ++ai)
#pragma unroll
            for (int m = 0; m < 4; ++m) { const int row = row0 + ai * HALF + m * 16; bf16_t* rowp = O + (size_t)row * ldc + col0; float s = 0.f;
#pragma unroll
                for (int bj = 0; bj < 2; ++bj) { const f32x4 v0 = acc[ai][bj][m][0], v1 = acc[ai][bj][m][1];
                    s += (v0[0] * v0[0] + v0[1] * v0[1]) + (v0[2] * v0[2] + v0[3] * v0[3]) + (v1[0] * v1[0] + v1[1] * v1[1]) + (v1[2] * v1[2] + v1[3] * v1[3]);
                    u32x4 w; w.x = cvt_pk_bf16(v0[0], v0[1]); w.y = cvt_pk_bf16(v0[2], v0[3]); w.z = cvt_pk_bf16(v1[0], v1[1]); w.w = cvt_pk_bf16(v1[2], v1[3]);
                    st16(rowp + bj * HALF, w); }
                if (ssq) { const int ln_ = (fq << 4) | fr; s += __int_as_float(__builtin_amdgcn_ds_bpermute((ln_ ^ 16) << 2, __float_as_int(s))); s += __int_as_float(__builtin_amdgcn_ds_bpermute((ln_ ^ 32) << 2, __float_as_int(s))); if (fq == 0) ssq[(size_t)row * 8 + (u.pn & 1) * 4 + wc] = s; } }
    }
};
struct EpiY {
    bf16_t* O; float* Yp; int ldc, row_split, nsplit_rows; int a_grp_tiles, a_grp_off;
    __device__ __forceinline__ int a_off(int pn) const { return a_grp_tiles ? (pn / a_grp_tiles) * a_grp_off : 0; }
    __device__ __forceinline__ void operator()(const f32x4 (&acc)[2][2][4][2], const Unit& u, int wr, int wc, int fr, int fq) const {
        const int row0 = u.pm * BM + wr * 64 + fr, col0 = u.pn * BM + wc * 32 + 8 * fq;
        if (u.part < 0) {
#pragma unroll
            for (int ai = 0; ai < 2; ++ai)
#pragma unroll
                for (int m = 0; m < 4; ++m) { bf16_t* rowp = O + (size_t)(row0 + ai * HALF + m * 16) * ldc + col0;
#pragma unroll
                    for (int bj = 0; bj < 2; ++bj) { const f32x4 v0 = acc[ai][bj][m][0], v1 = acc[ai][bj][m][1];
                        u32x4 w; w.x = cvt_pk_bf16(v0[0], v0[1]); w.y = cvt_pk_bf16(v0[2], v0[3]); w.z = cvt_pk_bf16(v1[0], v1[1]); w.w = cvt_pk_bf16(v1[2], v1[3]);
                        st16(rowp + bj * HALF, w); } }
        } else { float* slab = Yp + (size_t)u.part * nsplit_rows * ldc;
#pragma unroll
            for (int ai = 0; ai < 2; ++ai)
#pragma unroll
                for (int m = 0; m < 4; ++m) { float* rowp = slab + (size_t)(row0 + ai * HALF + m * 16 - row_split) * ldc + col0;
#pragma unroll
                    for (int bj = 0; bj < 2; ++bj) { *(f32x4*)(rowp + bj * HALF) = acc[ai][bj][m][0]; *(f32x4*)(rowp + bj * HALF + 4) = acc[ai][bj][m][1]; } }
        }
    }
};
struct EpiSwiGLU {
    bf16_t* O; int ldc;
    __device__ __forceinline__ int a_off(int) const { return 0; }
    __device__ __forceinline__ void operator()(const f32x4 (&acc)[2][2][4][2], const Unit& u, int wr, int wc, int fr, int fq) const {
        const int row0 = u.pm * BM + wr * 64 + fr, col0 = u.pn * HALF + wc * 32 + 8 * fq;
#pragma unroll
        for (int ai = 0; ai < 2; ++ai)
#pragma unroll
            for (int m = 0; m < 4; ++m) { const int row = row0 + ai * HALF + m * 16; float gv[8];
#pragma unroll
                for (int n = 0; n < 2; ++n)
#pragma unroll
                    for (int j = 0; j < 4; ++j) { const float a = acc[ai][0][m][n][j], b = acc[ai][1][m][n][j]; gv[n * 4 + j] = a * __builtin_amdgcn_rcpf(1.f + __expf(-a)) * b; }
                u32x4 w; w.x = cvt_pk_bf16(gv[0], gv[1]); w.y = cvt_pk_bf16(gv[2], gv[3]); w.z = cvt_pk_bf16(gv[4], gv[5]); w.w = cvt_pk_bf16(gv[6], gv[7]);
                st16(O + (size_t)row * ldc + col0, w); }
    }
};
struct EpiUp {
    bf16_t* Q; bf16_t* KV; const float* ssq_q; const float* ssq_kv;
    __device__ __forceinline__ int a_off(int pn) const { return pn < NQ / BM ? 0 : QL; }
    __device__ __forceinline__ void operator()(const f32x4 (&acc)[2][2][4][2], const Unit& u, int wr, int wc, int fr, int fq) const {
        const bool isq = u.pn < NQ / BM; const int ldc = isq ? NQ : NKV; bf16_t* O = isq ? Q : KV; const float* ssq = isq ? ssq_q : ssq_kv;
        const int row0 = u.pm * BM + wr * 64 + fr, col0 = (isq ? u.pn : u.pn - NQ / BM) * BM + wc * 32 + 8 * fq;
        float rs[2][4];
#pragma unroll
        for (int ai = 0; ai < 2; ++ai)
#pragma unroll
            for (int m = 0; m < 4; ++m) { const int row = row0 + ai * HALF + m * 16;
                const f32x4 sa = *(const f32x4*)(ssq + (size_t)row * 8), sb = *(const f32x4*)(ssq + (size_t)row * 8 + 4);
                rs[ai][m] = __builtin_amdgcn_rsqf((((sa[0] + sa[1]) + (sa[2] + sa[3])) + ((sb[0] + sb[1]) + (sb[2] + sb[3]))) * (1.f / 512.f) + RMS_EPS); }
#pragma unroll
        for (int ai = 0; ai < 2; ++ai)
#pragma unroll
            for (int m = 0; m < 4; ++m) { const int row = row0 + ai * HALF + m * 16; bf16_t* rowp = O + (size_t)row * ldc + col0;
#pragma unroll
                for (int bj = 0; bj < 2; ++bj) { const f32x4 v0 = acc[ai][bj][m][0] * rs[ai][m], v1 = acc[ai][bj][m][1] * rs[ai][m];
                    u32x4 w; w.x = cvt_pk_bf16(v0[0], v0[1]); w.y = cvt_pk_bf16(v0[2], v0[3]); w.z = cvt_pk_bf16(v1[0], v1[1]); w.w = cvt_pk_bf16(v1[2], v1[3]);
                    st16(rowp + bj * HALF, w); } }
    }
};
}
namespace att {
constexpr int QBLK = 32, KVBLK = 64;
constexpr float SCALE = 0.07216878364870322f;
constexpr float THR = 8.f;
#ifndef ATT_SDEPTH
#define ATT_SDEPTH 1
#endif
constexpr int SDEPTH = ATT_SDEPTH;
constexpr int SHM_V = KVBLK * VD * 2, SHM_K = KVBLK * QKD * 2;
constexpr int LDS_BYTES = 2 * SHM_V + 2 * SHM_K + NWAVES * 64 * 4;
#define KOFF(row, ch) ((row) * 384 + ((((ch) ^ (((row) >> 1) & 7))) << 4))
#define SBAR() __builtin_amdgcn_sched_barrier(0)
__device__ __forceinline__ int crow(int r, int hi) { return (r & 3) + 8 * (r >> 2) + 4 * hi; }

__device__ __forceinline__ void finishSM(f32x16& p0, f32x16& p1, float alpha, float& l_reg, bf16x8& pa0, bf16x8& pa1, bf16x8& pa2, bf16x8& pa3) {
#pragma unroll
    for (int r = 0; r < 16; ++r) p1[r] = __builtin_amdgcn_exp2f(p1[r]);
    float ps = 0;
#pragma unroll
    for (int r = 0; r < 16; ++r) ps += p0[r];
#pragma unroll
    for (int r = 0; r < 16; ++r) ps += p1[r];
    { auto rr = __builtin_amdgcn_permlane32_swap(__float_as_uint(ps), __float_as_uint(ps), false, false);
      ps = __uint_as_float(rr[0]) + __uint_as_float(rr[1]); }
    l_reg = l_reg * alpha + ps;
#define PK8(P, BASE, OUT) do { u32x4 w = {cvt_pk_bf16(P[BASE + 0], P[BASE + 1]), cvt_pk_bf16(P[BASE + 2], P[BASE + 3]), cvt_pk_bf16(P[BASE + 4], P[BASE + 5]), cvt_pk_bf16(P[BASE + 6], P[BASE + 7])}; \
    OUT = *reinterpret_cast<bf16x8*>(&w); } while (0)
    PK8(p0, 0, pa0); PK8(p0, 8, pa1); PK8(p1, 0, pa2); PK8(p1, 8, pa3);
#undef PK8
}
__device__ __forceinline__ int v_st(int k, int c) { const int kk = (k & ~0xC) | ((k & 4) << 1) | ((k & 8) >> 1); return ((kk >> 3) * 4 + (c >> 5)) * 512 + ((kk & 7) * 32 + (c & 31)) * 2; }
__device__ __forceinline__ int v_rd_base(int lane) { return ((lane & 3) << 3) | (((lane >> 2) & 3) << 6) | (((lane >> 4) & 1) << 5) | (((lane >> 5) & 1) << 8); }
constexpr int v_rd_off(int d0, int ks, int half) { return d0 * 512 + ks * 4096 + half * 2048; }
template <int OFF> __device__ __forceinline__ s16x4 tr_read(int vb) {
    s16x4 r; asm volatile("ds_read_b64_tr_b16 %0, %1 offset:%2" : "=&v"(r) : "v"(vb), "i"(OFF) : "memory"); return r;
}
template <int D0> __device__ __forceinline__ void pv_one(f32x16& od, int vb, bf16x8 pa0, bf16x8 pa1, bf16x8 pa2, bf16x8 pa3) {
    const s16x4 l0 = tr_read<v_rd_off(D0, 0, 0)>(vb), h0 = tr_read<v_rd_off(D0, 0, 1)>(vb), l1 = tr_read<v_rd_off(D0, 1, 0)>(vb), h1 = tr_read<v_rd_off(D0, 1, 1)>(vb);
    const s16x4 l2 = tr_read<v_rd_off(D0, 2, 0)>(vb), h2 = tr_read<v_rd_off(D0, 2, 1)>(vb), l3 = tr_read<v_rd_off(D0, 3, 0)>(vb), h3 = tr_read<v_rd_off(D0, 3, 1)>(vb);
    asm volatile("s_waitcnt lgkmcnt(0)" ::: "memory"); SBAR();
#define PK(L, H) (bf16x8){L[0], L[1], L[2], L[3], H[0], H[1], H[2], H[3]}
    od = __builtin_amdgcn_mfma_f32_32x32x16_bf16(pa0, PK(l0, h0), od, 0, 0, 0);
    od = __builtin_amdgcn_mfma_f32_32x32x16_bf16(pa1, PK(l1, h1), od, 0, 0, 0);
    od = __builtin_amdgcn_mfma_f32_32x32x16_bf16(pa2, PK(l2, h2), od, 0, 0, 0);
    od = __builtin_amdgcn_mfma_f32_32x32x16_bf16(pa3, PK(l3, h3), od, 0, 0, 0);
#undef PK
}
__device__ __forceinline__ void pv_d0(f32x16* o, int vb, bf16x8 pa0, bf16x8 pa1, bf16x8 pa2, bf16x8 pa3) {
    pv_one<0>(o[0], vb, pa0, pa1, pa2, pa3); pv_one<1>(o[1], vb, pa0, pa1, pa2, pa3); pv_one<2>(o[2], vb, pa0, pa1, pa2, pa3); pv_one<3>(o[3], vb, pa0, pa1, pa2, pa3);
}
__device__ __forceinline__ void rope8(bf16x8& x1, bf16x8& x2, const float* tab) {
    u32x4 a = *reinterpret_cast<u32x4*>(&x1), b = *reinterpret_cast<u32x4*>(&x2), oa, ob;
#pragma unroll
    for (int w = 0; w < 4; ++w) {
        const f32x4 cs = *reinterpret_cast<const f32x4*>(tab + 4 * w);
        const float a0 = bf_lo(a[w]), a1 = bf_hi(a[w]), b0 = bf_lo(b[w]), b1 = bf_hi(b[w]);
        oa[w] = cvt_pk_bf16(a0 * cs[0] - b0 * cs[1], a1 * cs[2] - b1 * cs[3]);
        ob[w] = cvt_pk_bf16(b0 * cs[0] + a0 * cs[1], b1 * cs[2] + a1 * cs[3]);
    }
    x1 = *reinterpret_cast<bf16x8*>(&oa); x2 = *reinterpret_cast<bf16x8*>(&ob);
}

struct Unit { const bf16_t* Qb; const bf16_t* KVh; bf16_t* Ob; int kb_lat, nt_lat, kb_ctx, NT, qpos0; };

constexpr int SLOT = 40960, KR_OFF = 16384, V_OFF = 24576, LDS2_BYTES = 3 * SLOT + NWAVES * 64 * 4;
constexpr float THRL = THR * 1.4426950408889634f;
#ifndef ATT_MARGIN
#define ATT_MARGIN 100.f
#endif
__device__ __forceinline__ void qkt2n(f32x16& p0, f32x16& p1, LAS const char* lds, int kn, int kr, const bf16x8* qr, const f32x16& negm) {
#pragma unroll
    for (int d0 = 0; d0 < 8; ++d0) { const int a = kn ^ (d0 << 5);
        const bf16x8 b0 = *reinterpret_cast<LAS const bf16x8*>(lds + a), b1 = *reinterpret_cast<LAS const bf16x8*>(lds + a + 32 * 256);
        if (d0 == 0) { p0 = __builtin_amdgcn_mfma_f32_32x32x16_bf16(b0, qr[0], negm, 0, 0, 0); p1 = __builtin_amdgcn_mfma_f32_32x32x16_bf16(b1, qr[0], negm, 0, 0, 0); }
        else { p0 = __builtin_amdgcn_mfma_f32_32x32x16_bf16(b0, qr[d0], p0, 0, 0, 0); p1 = __builtin_amdgcn_mfma_f32_32x32x16_bf16(b1, qr[d0], p1, 0, 0, 0); } }
#pragma unroll
    for (int d0 = 0; d0 < 4; ++d0) { const int a = kr ^ (d0 << 5);
        const bf16x8 b0 = *reinterpret_cast<LAS const bf16x8*>(lds + a), b1 = *reinterpret_cast<LAS const bf16x8*>(lds + a + 32 * 128);
        p0 = __builtin_amdgcn_mfma_f32_32x32x16_bf16(b0, qr[8 + d0], p0, 0, 0, 0); p1 = __builtin_amdgcn_mfma_f32_32x32x16_bf16(b1, qr[8 + d0], p1, 0, 0, 0); }
}
template <bool FIRST>
__device__ __forceinline__ void partialSM2(f32x16& p0, f32x16& p1, float& m_reg, f32x16& negm, float& alpha, float margin = 0.f) {
    float pmax = p0[0];
#pragma unroll
    for (int r = 1; r < 16; ++r) pmax = fmaxf(pmax, p0[r]);
#pragma unroll
    for (int r = 0; r < 16; ++r) pmax = fmaxf(pmax, p1[r]);
    { auto rr = __builtin_amdgcn_permlane32_swap(__float_as_uint(pmax), __float_as_uint(pmax), false, false);
      pmax = fmaxf(__uint_as_float(rr[0]), __uint_as_float(rr[1])); }
    alpha = 1.f;
    if (FIRST || !__builtin_expect(__all(pmax <= THRL), 1)) {
        const float delta = FIRST ? pmax + margin : fmaxf(pmax, 0.f);
        if (!FIRST) alpha = __builtin_amdgcn_exp2f(-delta);
        m_reg += delta;
#pragma unroll
        for (int r = 0; r < 16; ++r) { p0[r] -= delta; p1[r] -= delta; negm[r] = -m_reg; }
    }
#pragma unroll
    for (int r = 0; r < 16; ++r) p0[r] = __builtin_amdgcn_exp2f(p0[r]);
}
__device__ __forceinline__ void exp_half(f32x16& p0) {
#pragma unroll
    for (int r = 0; r < 16; ++r) p0[r] = __builtin_amdgcn_exp2f(p0[r]);
}
template <bool FIXM>
__device__ __forceinline__ void attn_unit6(const Unit& U, const bf16_t* __restrict__ KR, const float* __restrict__ ropetab, LAS unsigned char* lds) {
    int tid = threadIdx.x; asm volatile("" : "+v"(tid));
    const int wid = __builtin_amdgcn_readfirstlane(tid >> 6), lane = tid & 63, r32 = lane & 31, hi = lane >> 5;
    LAS float* wsf = (LAS float*)(lds + 3 * SLOT) + wid * 64; LAS float* li_l = wsf; LAS float* al_l = wsf + 32;
    float m_reg = 0.f, l_reg = 0; f32x16 o[4] = {}; bf16x8 qr[12]; f32x16 negm = {};
    const bf16_t* Qw = U.Qb + (size_t)(wid * QBLK + r32) * NQ + hi * 8;
#pragma unroll
    for (int d0 = 0; d0 < 12; ++d0) qr[d0] = *reinterpret_cast<const bf16x8*>(Qw + d0 * 16);
    if (U.qpos0 >= 0) { const int t = U.qpos0 + wid * QBLK + r32, pr = t >> 6, pc = t & 63;
        rope8(qr[8], qr[9], ropetab + (pr * 16 + hi * 8) * 2); rope8(qr[10], qr[11], ropetab + (pc * 16 + hi * 8) * 2); }
    unsigned von[2], vov[2], vor;
#pragma unroll
    for (int i = 0; i < 2; ++i) { const int p = (wid * 2 + i) * 64 + lane;
        { const int row = p >> 4, c = (p & 15) ^ (row & 15); von[i] = (unsigned)(row * (NKV * 2) + c * 16); }
        { const int sub = p >> 5, within = p & 31, k = (sub >> 2) * 8 + (within >> 2), c = (sub & 3) * 32 + (within & 3) * 8;     vov[i] = (unsigned)(k * (NKV * 2) + NOPE * 2 + c * 2); } }
    { const int p = wid * 64 + lane, row = p >> 3, c = (p & 7) ^ ((row >> 1) & 7); vor = (unsigned)(row * (ROPED * 2) + c * 16); }
    const int kn0 = r32 * 256 + ((hi ^ (r32 & 15)) << 4), kr0 = KR_OFF + r32 * 128 + ((hi ^ ((r32 >> 1) & 7)) << 4), vb0 = (int)(uintptr_t)lds + V_OFF + v_rd_base(lane);
    const int nt_lat = U.nt_lat, kb_lat = U.kb_lat, kb_ctx = U.kb_ctx - 64 * nt_lat, NT = U.NT;
    const bf16_t* KVh = U.KVh;
    const unsigned ldsw2 = (unsigned)wid * 2048u, ldsw1 = (unsigned)wid * 1024u;
#define KROW(j) (((j) < nt_lat ? kb_lat : kb_ctx) + 64 * (j))
#define DMA(j, so) do { const size_t _k = (size_t)KROW(j); const char* _kv = (const char*)KVh + _k * (NKV * 2); const char* _kr = (const char*)KR + _k * (ROPED * 2); \
    __builtin_amdgcn_global_load_lds((const unsigned*)(_kv + von[0]), (LAS unsigned*)(lds + (so) + ldsw2), 16, 0, 0); \
    __builtin_amdgcn_global_load_lds((const unsigned*)(_kv + von[1]), (LAS unsigned*)(lds + (so) + ldsw2 + 1024), 16, 0, 0); \
    __builtin_amdgcn_global_load_lds((const unsigned*)(_kr + vor), (LAS unsigned*)(lds + (so) + KR_OFF + ldsw1), 16, 0, 0); \
    __builtin_amdgcn_global_load_lds((const unsigned*)(_kv + vov[0]), (LAS unsigned*)(lds + (so) + V_OFF + ldsw2), 16, 0, 0); \
    __builtin_amdgcn_global_load_lds((const unsigned*)(_kv + vov[1]), (LAS unsigned*)(lds + (so) + V_OFF + ldsw2 + 1024), 16, 0, 0); } while (0)
#define TILE_BAR() asm volatile("s_waitcnt vmcnt(0) lgkmcnt(0)\n\ts_barrier" ::: "memory")
#define RESC2(a) do { if (__any((a) < 1.f)) { if (hi == 0) al_l[r32] = (a); asm volatile("s_waitcnt lgkmcnt(0)" ::: "memory"); \
    _Pragma("unroll") for (int d = 0; d < 4; ++d) _Pragma("unroll") for (int r = 0; r < 16; ++r) o[d][r] *= al_l[crow(r, hi)]; } } while (0)
    f32x16 pA0, pA1, pB0, pB1; float alA, alB; bf16x8 pa0, pa1, pa2, pa3;
    int s_prev = 0, s_cur = SLOT, s_next = 2 * SLOT;
    DMA(0, 0); DMA(1, SLOT); TILE_BAR();
    qkt2n(pA0, pA1, (LAS const char*)lds, kn0, kr0, qr, negm); partialSM2<true>(pA0, pA1, m_reg, negm, alA, FIXM ? ATT_MARGIN : 0.f);
    asm volatile(".p2align 6");
    for (int j = 1; j + 1 < NT; j += 2) {
        DMA(j + 1, s_next); SBAR();
        qkt2n(pB0, pB1, (LAS const char*)lds, kn0 + s_cur, kr0 + s_cur, qr, negm);
        finishSM(pA0, pA1, alA, l_reg, pa0, pa1, pa2, pa3); SBAR();
        pv_d0(o, vb0 + s_prev, pa0, pa1, pa2, pa3); if (FIXM) { alB = 1.f; exp_half(pB0); } else partialSM2<false>(pB0, pB1, m_reg, negm, alB);
        if (!FIXM) RESC2(alB); TILE_BAR();
        { const int t = s_prev; s_prev = s_cur; s_cur = s_next; s_next = t; }
        if (j + 2 < NT) DMA(j + 2, s_next); SBAR();
        qkt2n(pA0, pA1, (LAS const char*)lds, kn0 + s_cur, kr0 + s_cur, qr, negm);
        finishSM(pB0, pB1, alB, l_reg, pa0, pa1, pa2, pa3); SBAR();
        pv_d0(o, vb0 + s_prev, pa0, pa1, pa2, pa3); if (FIXM) { alA = 1.f; exp_half(pA0); } else partialSM2<false>(pA0, pA1, m_reg, negm, alA);
        if (!FIXM) RESC2(alA); TILE_BAR();
        { const int t = s_prev; s_prev = s_cur; s_cur = s_next; s_next = t; }
    }
    SBAR(); qkt2n(pB0, pB1, (LAS const char*)lds, kn0 + s_cur, kr0 + s_cur, qr, negm);
    finishSM(pA0, pA1, alA, l_reg, pa0, pa1, pa2, pa3); SBAR();
    pv_d0(o, vb0 + s_prev, pa0, pa1, pa2, pa3); if (FIXM) { alB = 1.f; exp_half(pB0); } else partialSM2<false>(pB0, pB1, m_reg, negm, alB);
    if (!FIXM) RESC2(alB);
    finishSM(pB0, pB1, alB, l_reg, pa0, pa1, pa2, pa3); SBAR();
    pv_d0(o, vb0 + s_cur, pa0, pa1, pa2, pa3);
    if (FIXM) { const bool okl = (l_reg > 0.f) && (l_reg < 1e30f); const bool okw = __all(okl); if (lane == 0) ((LAS unsigned*)(lds + LDS2_BYTES))[wid] = okw ? 1u : 0u; }
    if (hi == 0) li_l[r32] = l_reg; asm volatile("s_waitcnt lgkmcnt(0)" ::: "memory");
    float rli[16];
#pragma unroll
    for (int r = 0; r < 16; ++r) rli[r] = __builtin_amdgcn_rcpf(li_l[crow(r, hi)]);
    asm volatile("s_waitcnt lgkmcnt(0)\n\ts_barrier" ::: "memory");
    { constexpr int OP = 272; LAS unsigned char* st = lds + wid * (32 * OP);
#pragma unroll
      for (int r = 0; r < 16; ++r) { const int orow = crow(r, hi);
#pragma unroll
        for (int d0 = 0; d0 < 4; ++d0) *(LAS bf16_t*)(st + orow * OP + (d0 * 32 + r32) * 2) = (bf16_t)(cvt_pk_bf16(o[d0][r] * rli[r], 0.f) & 0xffffu); }
      asm volatile("s_waitcnt lgkmcnt(0)" ::: "memory");
      bf16_t* Ow = U.Ob + (size_t)(wid * QBLK) * D;
#pragma unroll
      for (int i = 0; i < 8; ++i) { const int row = (lane >> 4) + 4 * i, ch = lane & 15;
        const u32x4 w = *(const LAS u32x4*)(st + row * OP + ch * 16); *(u32x4*)(Ow + (size_t)row * D + ch * 8) = w; } }
    TILE_BAR();
#undef KROW
#undef DMA
#undef TILE_BAR
#undef RESC2
}


typedef float f32x4_t __attribute__((ext_vector_type(4)));
__device__ __forceinline__ void attn_unit7(const Unit& U, const bf16_t* __restrict__ KR, const float* __restrict__ ropetab, LAS unsigned char* lds) {
    int tid = threadIdx.x; asm volatile("" : "+v"(tid));
    const int wid = __builtin_amdgcn_readfirstlane(tid >> 6), lane = tid & 63, c16 = lane & 15, g = lane >> 4;
    f32x4_t o[8][2]; bf16x8 qr[2][6]; f32x4_t negm[2]; float l_reg[2] = {0.f, 0.f};
#pragma unroll
    for (int t = 0; t < 8; ++t)
#pragma unroll
        for (int u = 0; u < 2; ++u) o[t][u] = (f32x4_t){0.f, 0.f, 0.f, 0.f};
    const int xg = g < 2 ? g : g + 2;
#pragma unroll
    for (int u = 0; u < 2; ++u) { const bf16_t* Qw = U.Qb + (size_t)(wid * QBLK + 16 * u + c16) * NQ;
#pragma unroll
        for (int s = 0; s < 4; ++s) qr[u][s] = *reinterpret_cast<const bf16x8*>(Qw + 32 * s + 8 * g);
        qr[u][4] = *reinterpret_cast<const bf16x8*>(Qw + NOPE + 8 * xg); qr[u][5] = *reinterpret_cast<const bf16x8*>(Qw + NOPE + 8 * (xg + 2));
        if (U.qpos0 >= 0) { const int t = U.qpos0 + wid * QBLK + 16 * u + c16, pos = g < 2 ? (t >> 6) : (t & 63); rope8(qr[u][4], qr[u][5], ropetab + (pos * 16 + (g & 1) * 8) * 2); } }
    unsigned von[2], vov[2], vor;
#pragma unroll
    for (int i = 0; i < 2; ++i) { const int p = (wid * 2 + i) * 64 + lane;
        { const int row = p >> 4, c = (p & 15) ^ (row & 15); von[i] = (unsigned)(row * (NKV * 2) + c * 16); }
        { const int sub = p >> 5, within = p & 31, k = (sub >> 2) * 8 + (within >> 2), c = (sub & 3) * 32 + (((within & 3) * 8) ^ (((within >> 4) & 1) << 4)); vov[i] = (unsigned)(k * (NKV * 2) + NOPE * 2 + c * 2); } }
    { const int p = wid * 64 + lane, row = p >> 3, c = (p & 7) ^ ((row >> 1) & 7); vor = (unsigned)(row * (ROPED * 2) + c * 16); }
    const int kn0 = c16 * 256 + ((g ^ c16) << 4), kr0 = KR_OFF + c16 * 128 + ((xg ^ ((c16 >> 1) & 7)) << 4);
    const int vbe = (int)(uintptr_t)lds + V_OFF + (g >> 1) * 2048 + (4 * (g & 1) + (c16 >> 2)) * 64 + 32 * (g & 1) + 8 * (c16 & 3), vbo = vbe ^ 32;
    const int nt_lat = U.nt_lat, kb_lat = U.kb_lat, kb_ctx = U.kb_ctx - 64 * nt_lat, NT = U.NT;
    const bf16_t* KVh = U.KVh;
    const unsigned ldsw2 = (unsigned)wid * 2048u, ldsw1 = (unsigned)wid * 1024u;
#define KROW(j) (((j) < nt_lat ? kb_lat : kb_ctx) + 64 * (j))
#define DMA(j, so) do { const size_t _k = (size_t)KROW(j); const char* _kv = (const char*)KVh + _k * (NKV * 2); const char* _kr = (const char*)KR + _k * (ROPED * 2); \
    __builtin_amdgcn_global_load_lds((const unsigned*)(_kv + von[0]), (LAS unsigned*)(lds + (so) + ldsw2), 16, 0, 0); \
    __builtin_amdgcn_global_load_lds((const unsigned*)(_kv + von[1]), (LAS unsigned*)(lds + (so) + ldsw2 + 1024), 16, 0, 0); \
    __builtin_amdgcn_global_load_lds((const unsigned*)(_kr + vor), (LAS unsigned*)(lds + (so) + KR_OFF + ldsw1), 16, 0, 0); \
    __builtin_amdgcn_global_load_lds((const unsigned*)(_kv + vov[0]), (LAS unsigned*)(lds + (so) + V_OFF + ldsw2), 16, 0, 0); \
    __builtin_amdgcn_global_load_lds((const unsigned*)(_kv + vov[1]), (LAS unsigned*)(lds + (so) + V_OFF + ldsw2 + 1024), 16, 0, 0); } while (0)
#define TILE_BAR() asm volatile("s_waitcnt vmcnt(0) lgkmcnt(0)\n\ts_barrier" ::: "memory")
#define XSH(x, m) __int_as_float(__builtin_amdgcn_ds_bpermute((lane ^ (m)) << 2, __float_as_int(x)))
#define MFMA16(A, B, C) __builtin_amdgcn_mfma_f32_16x16x32_bf16(A, B, C, 0, 0, 0)
#define KRD(dst, addr, off) asm volatile("ds_read_b128 %0, %1 offset:%2" : "=&v"(dst) : "v"(addr), "i"(off) : "memory")
#define KRD4(K, s, stp) do { const int _a = (s) < 4 ? (_kn ^ ((s) << 6)) : (_kr ^ (((s) - 4) << 5)); KRD(K[0], _a, 0); KRD(K[1], _a, (stp)); KRD(K[2], _a, 2 * (stp)); KRD(K[3], _a, 3 * (stp)); } while (0)
#define QKM(K, s) do { _Pragma("unroll") for (int a = 0; a < 4; ++a) _Pragma("unroll") for (int u = 0; u < 2; ++u) P_[u][a] = MFMA16(K[a], qr[u][s], (s) == 0 ? negm[u] : P_[u][a]); } while (0)
#define QK7(P, so) do { auto& P_ = P; const int _kn = (int)(uintptr_t)lds + kn0 + (so), _kr = (int)(uintptr_t)lds + kr0 + (so); bf16x8 ka[4], kb[4]; \
    KRD4(ka, 0, 4096); \
    KRD4(kb, 1, 4096); asm volatile("s_waitcnt lgkmcnt(4)" ::: "memory"); SBAR(); QKM(ka, 0); SBAR(); \
    KRD4(ka, 2, 4096); asm volatile("s_waitcnt lgkmcnt(4)" ::: "memory"); SBAR(); QKM(kb, 1); SBAR(); \
    KRD4(kb, 3, 4096); asm volatile("s_waitcnt lgkmcnt(4)" ::: "memory"); SBAR(); QKM(ka, 2); SBAR(); \
    KRD4(ka, 4, 2048); asm volatile("s_waitcnt lgkmcnt(4)" ::: "memory"); SBAR(); QKM(kb, 3); SBAR(); \
    KRD4(kb, 5, 2048); asm volatile("s_waitcnt lgkmcnt(4)" ::: "memory"); SBAR(); QKM(ka, 4); SBAR(); \
    asm volatile("s_waitcnt lgkmcnt(0)" ::: "memory"); SBAR(); QKM(kb, 5); } while (0)
#define EXPH7(P, A0) do { _Pragma("unroll") for (int u = 0; u < 2; ++u) _Pragma("unroll") for (int a = (A0); a < (A0) + 2; ++a) _Pragma("unroll") for (int r = 0; r < 4; ++r) P[u][a][r] = __builtin_amdgcn_exp2f(P[u][a][r]); } while (0)
#define FIN7(P) do { EXPH7(P, 2); \
    _Pragma("unroll") for (int u = 0; u < 2; ++u) { float ps = 0.f; _Pragma("unroll") for (int a = 0; a < 4; ++a) ps += (P[u][a][0] + P[u][a][1]) + (P[u][a][2] + P[u][a][3]); l_reg[u] += ps; \
        _Pragma("unroll") for (int ks = 0; ks < 2; ++ks) { u32x4 w = {cvt_pk_bf16(P[u][2 * ks][0], P[u][2 * ks][1]), cvt_pk_bf16(P[u][2 * ks][2], P[u][2 * ks][3]), \
            cvt_pk_bf16(P[u][2 * ks + 1][0], P[u][2 * ks + 1][1]), cvt_pk_bf16(P[u][2 * ks + 1][2], P[u][2 * ks + 1][3])}; pk[ks][u] = *reinterpret_cast<bf16x8*>(&w); } } } while (0)
#define TR7(dst, vb, a, t) asm volatile("ds_read_b64_tr_b16 %0, %1 offset:%2" : "=&v"(dst) : "v"(vb), "i"((a) * 4096 + ((t) >> 1) * 512) : "memory")
#define RD4(E, t) do { if ((t) & 1) { TR7(E[0], vb1_, 0, t); TR7(E[1], vb1_, 1, t); TR7(E[2], vb1_, 2, t); TR7(E[3], vb1_, 3, t); } else { TR7(E[0], vb0_, 0, t); TR7(E[1], vb0_, 1, t); TR7(E[2], vb0_, 2, t); TR7(E[3], vb0_, 3, t); } } while (0)
#define MM4(E, t) do { \
        const bf16x8 v0 = (bf16x8){E[0][0], E[0][1], E[0][2], E[0][3], E[1][0], E[1][1], E[1][2], E[1][3]}, v1 = (bf16x8){E[2][0], E[2][1], E[2][2], E[2][3], E[3][0], E[3][1], E[3][2], E[3][3]}; \
        o[t][0] = MFMA16(v0, pk[0][0], o[t][0]); o[t][1] = MFMA16(v0, pk[0][1], o[t][1]); o[t][0] = MFMA16(v1, pk[1][0], o[t][0]); o[t][1] = MFMA16(v1, pk[1][1], o[t][1]); } while (0)
#define PV7(so) do { const int vb0_ = vbe + (so), vb1_ = vbo + (so); s16x4 ea[4], eb[4]; \
        RD4(ea, 0); \
        RD4(eb, 1); asm volatile("s_waitcnt lgkmcnt(4)" ::: "memory"); SBAR(); MM4(ea, 0); SBAR(); \
        RD4(ea, 2); asm volatile("s_waitcnt lgkmcnt(4)" ::: "memory"); SBAR(); MM4(eb, 1); SBAR(); \
        RD4(eb, 3); asm volatile("s_waitcnt lgkmcnt(4)" ::: "memory"); SBAR(); MM4(ea, 2); SBAR(); \
        RD4(ea, 4); asm volatile("s_waitcnt lgkmcnt(4)" ::: "memory"); SBAR(); MM4(eb, 3); SBAR(); \
        RD4(eb, 5); asm volatile("s_waitcnt lgkmcnt(4)" ::: "memory"); SBAR(); MM4(ea, 4); SBAR(); \
        RD4(ea, 6); asm volatile("s_waitcnt lgkmcnt(4)" ::: "memory"); SBAR(); MM4(eb, 5); SBAR(); \
        RD4(eb, 7); asm volatile("s_waitcnt lgkmcnt(4)" ::: "memory"); SBAR(); MM4(ea, 6); SBAR(); \
        asm volatile("s_waitcnt lgkmcnt(0)" ::: "memory"); SBAR(); MM4(eb, 7); } while (0)
    f32x4_t pA[2][4]; bf16x8 pk[2][2];
    negm[0] = negm[1] = (f32x4_t){0.f, 0.f, 0.f, 0.f};
    int s_prev = 0, s_cur = SLOT, s_next = 2 * SLOT;
    DMA(0, 0); DMA(1, SLOT); TILE_BAR();
    QK7(pA, 0);
#pragma unroll
    for (int u = 0; u < 2; ++u) { float pmax = pA[u][0][0];
#pragma unroll
        for (int a = 0; a < 4; ++a)
#pragma unroll
            for (int r = 0; r < 4; ++r) pmax = fmaxf(pmax, pA[u][a][r]);
        pmax = fmaxf(pmax, XSH(pmax, 16)); pmax = fmaxf(pmax, XSH(pmax, 32));
        const float delta = pmax + ATT_MARGIN; negm[u] = (f32x4_t){-delta, -delta, -delta, -delta};
#pragma unroll
        for (int a = 0; a < 4; ++a)
#pragma unroll
            for (int r = 0; r < 4; ++r) pA[u][a][r] -= delta; }
    EXPH7(pA, 0);
    asm volatile(".p2align 6");
    for (int j = 1; j < NT; ++j) {
        if (j + 1 < NT) DMA(j + 1, s_next); SBAR();
        FIN7(pA); SBAR();
        QK7(pA, s_cur); SBAR();
        PV7(s_prev); EXPH7(pA, 0); TILE_BAR();
        { const int t = s_prev; s_prev = s_cur; s_cur = s_next; s_next = t; }
    }
    FIN7(pA); SBAR();
    PV7(s_prev);
    float rl[2]; bool okl = true;
#pragma unroll
    for (int u = 0; u < 2; ++u) { float l = l_reg[u]; l += XSH(l, 16); l += XSH(l, 32); okl = okl && (l > 0.f) && (l < 1e30f); rl[u] = __builtin_amdgcn_rcpf(l); }
    { const bool okw = __all(okl); if (lane == 0) ((LAS unsigned*)(lds + LDS2_BYTES))[wid] = okw ? 1u : 0u; }
    asm volatile("s_waitcnt vmcnt(0) lgkmcnt(0)\n\ts_barrier" ::: "memory");
    { constexpr int OP = 272; LAS unsigned char* st = lds + wid * (32 * OP);
      int tid2 = threadIdx.x; asm volatile("" : "+v"(tid2)); const int lane = tid2 & 63, c16 = lane & 15, g = lane >> 4;
#pragma unroll
      for (int u = 0; u < 2; ++u)
#pragma unroll
        for (int t = 0; t < 8; ++t) { u32x2 w; w.x = cvt_pk_bf16(o[t][u][0] * rl[u], o[t][u][1] * rl[u]); w.y = cvt_pk_bf16(o[t][u][2] * rl[u], o[t][u][3] * rl[u]);
            *(LAS u32x2*)(st + (16 * u + c16) * OP + (16 * t + 4 * g) * 2) = w; }
      asm volatile("s_waitcnt lgkmcnt(0)" ::: "memory");
      bf16_t* Ow = U.Ob + (size_t)(wid * QBLK) * D;
#pragma unroll
      for (int i = 0; i < 8; ++i) { const int row = (lane >> 4) + 4 * i, ch = lane & 15;
        const u32x4 w = *(const LAS u32x4*)(st + row * OP + ch * 16); *(u32x4*)(Ow + (size_t)row * D + ch * 8) = w; } }
    TILE_BAR();
#undef KROW
#undef DMA
#undef TILE_BAR
#undef XSH
#undef MFMA16
#undef QK7
#undef KRD
#undef KRD4
#undef QKM
#undef EXPH7
#undef FIN7
#undef PV7
#undef TR7
#undef RD4
#undef MM4
}

#ifndef ATT_FAST_FIRST
#define ATT_FAST_FIRST 1
#endif
#ifndef ATT_FORCE_SAFE
#define ATT_FORCE_SAFE 0
#endif
__device__ __forceinline__ void attn_unit_auto(const Unit& U, const bf16_t* __restrict__ KR, const float* __restrict__ ropetab, LAS unsigned char* lds) {
#if ATT_FAST_FIRST
    attn_unit7(U, KR, ropetab, lds);
    const LAS unsigned* fl = (const LAS unsigned*)(lds + LDS2_BYTES);
    unsigned okc = 0; for (int w = 0; w < NWAVES; ++w) okc += fl[w];
    if (ATT_FORCE_SAFE || __builtin_amdgcn_readfirstlane(okc) != (unsigned)NWAVES) attn_unit6<false>(U, KR, ropetab, lds);
#else
    attn_unit6<false>(U, KR, ropetab, lds);
#endif
}
}
constexpr size_t MiB = 1u << 20;
constexpr int CW_TMO = 0, CW_BAR = 4096;
constexpr int KSPL = 16;
constexpr size_t WS_CTL = 0;
constexpr size_t WS_MOD = 64 * 1024;
constexpr size_t WS_SSQ = 1 * MiB;
constexpr size_t CTL_ZERO_BYTES = 64 * 1024;
constexpr size_t WS_ROPE = 3 * MiB;
constexpr size_t WS_W13 = 4 * MiB;
constexpr size_t WS_W2 = 180 * MiB;
constexpr size_t WS_WPOOL = 268 * MiB;
constexpr size_t WS_WDQKV = 272 * MiB;
constexpr size_t WS_WUP = 282 * MiB;
constexpr size_t WS_WO = 296 * MiB;
constexpr size_t WS_H = 312 * MiB;
constexpr size_t WS_U = 444 * MiB;
constexpr size_t WS_Y = 510 * MiB;
constexpr size_t WS_P = 576 * MiB;
constexpr size_t WS_G = 642 * MiB;
constexpr size_t WS_CQKV = 824 * MiB;
constexpr size_t WS_Q = 866 * MiB;
constexpr size_t WS_KV = 965 * MiB;
constexpr size_t WS_KR = 1097 * MiB;
constexpr size_t WS_YP = 1100 * MiB;
constexpr size_t WS_MODP2 = 1148 * MiB;
constexpr size_t WS_END = 1176 * MiB;
static_assert(WS_W13 + (size_t)4 * 11264 * 2048 * 2 <= WS_W2 && WS_W2 + (size_t)4 * 2048 * 5632 * 2 <= WS_WPOOL && WS_H + (size_t)T * D * 4 <= WS_U && WS_U + (size_t)T * D * 2 <= WS_Y, "ws map");
static_assert(WS_G + (size_t)T * DFF * 2 <= WS_CQKV && WS_CQKV + (size_t)T * NDQKV * 2 <= WS_Q && WS_Q + (size_t)T * NQ * 2 <= WS_KV && WS_KV + (size_t)T * NKV * 2 <= WS_KR && WS_KR + (size_t)T * ROPED * 2 <= WS_YP && WS_YP + (size_t)11 * TC * D * 4 <= WS_MODP2 && WS_MODP2 + (size_t)3 * 64 * 3 * NMOD * 4 <= WS_END, "ws map");
static_assert(WS_MOD + (size_t)4 * 3 * NMOD * 4 <= WS_SSQ && WS_SSQ + (size_t)16 * T * 4 <= WS_ROPE && (CW_BAR + 3456) * 4 <= (int)CTL_ZERO_BYTES, "ctl map");

constexpr int RING_BYTES = 131072, MISC_OFF = RING_BYTES, LDS_BYTES = 147456;
static_assert(att::LDS_BYTES <= RING_BYTES && att::LDS2_BYTES + 64 <= RING_BYTES, "attention LDS");

#define XB_TMO      128
#define XB_XCNT(j)  (256  + 64 * (j))
#define XB_XSUB(j)  (1280 + 64 * (j))
#define XB_XGEN(j)  (2304 + 64 * (j))
#define XB_TOP      3328
#define XB_TOPGEN   3392
#define XCD_BAR_WORDS 3456
#define XB_SPIN_CAP (1u << 22)
__device__ __forceinline__ unsigned xb_ld(unsigned* p)              { return __hip_atomic_load(p, __ATOMIC_RELAXED, __HIP_MEMORY_SCOPE_AGENT); }
__device__ __forceinline__ unsigned xb_add(unsigned* p, unsigned v) { return __hip_atomic_fetch_add(p, v, __ATOMIC_RELAXED, __HIP_MEMORY_SCOPE_AGENT); }
__device__ __forceinline__ unsigned xb_xcc_id() { return (unsigned)__builtin_amdgcn_s_getreg((3 << 11) | 20) & 0xFu; }
#define XB_SPIN(cond, bar) do { unsigned _sp = 0; while (cond) { __builtin_amdgcn_s_sleep(1); \
    if ((++_sp & 255u) == 0u) { if (xb_ld(&(bar)[XB_TMO])) break; if (_sp > XB_SPIN_CAP) { atomicAdd(&(bar)[XB_TMO], 1u); break; } } } } while (0)
struct XcdBarrier { unsigned* bar; unsigned x; volatile LAS unsigned* st; };
__device__ __forceinline__ XcdBarrier xcd_barrier_post(unsigned* bar, volatile LAS unsigned* st) {
    XcdBarrier b; b.bar = bar; b.x = xb_xcc_id(); b.st = st;
    if (threadIdx.x == 0) (void)xb_add(&bar[XB_XCNT(b.x)], 1u);
    return b;
}
__device__ __forceinline__ void xcd_barrier_complete(unsigned* bar, unsigned x, unsigned& nloc, unsigned& nx) {
    const unsigned G = gridDim.x * gridDim.y * gridDim.z;
    unsigned sum, cnt, mine, sp = 0u;
    for (;;) {
        sum = 0u; cnt = 0u; mine = 0u;
#pragma unroll
        for (unsigned j = 0; j < 16; ++j) { const unsigned c = xb_ld(&bar[XB_XCNT(j)]); sum += c; cnt += (c > 0u) ? 1u : 0u; mine = (j == x) ? c : mine; }
        if (sum == G) break;
        __builtin_amdgcn_s_sleep(1);
        if ((++sp & 255u) == 0u) { if (xb_ld(&bar[XB_TMO])) break; if (sp > XB_SPIN_CAP) { atomicAdd(&bar[XB_TMO], 1u); break; } }
    }
    nloc = mine > 0u ? mine : 1u; nx = cnt > 0u ? cnt : 1u;
}
__device__ __forceinline__ void xcd_barrier(const XcdBarrier& b) {
    asm volatile("s_waitcnt vmcnt(0)" ::: "memory");
    __syncthreads();
    if (threadIdx.x == 0) {
        unsigned* bar = b.bar; asm volatile("" : "+s"(bar));
        __builtin_amdgcn_s_waitcnt(0);
        const unsigned bx = xb_xcc_id();
        unsigned nloc = b.st[0], nx = b.st[1];
        if (nloc == 0u) { xcd_barrier_complete(bar, bx, nloc, nx); b.st[0] = nloc; b.st[1] = nx; }
        const unsigned old = xb_add(&bar[XB_XSUB(bx)], 1u);
        const unsigned gen = old / nloc;
        if (old + 1u == (gen + 1u) * nloc) {
            __builtin_amdgcn_fence(__ATOMIC_RELEASE, "agent");
            asm volatile("s_waitcnt vmcnt(0)" ::: "memory");
            const unsigned og = xb_add(&bar[XB_TOP], 1u);
            const unsigned tg = og / nx;
            if (og + 1u == (tg + 1u) * nx) xb_add(&bar[XB_TOPGEN], 1u);
            else XB_SPIN(xb_ld(&bar[XB_TOPGEN]) == tg, bar);
            __builtin_amdgcn_fence(__ATOMIC_ACQUIRE, "agent");
            xb_add(&bar[XB_XGEN(bx)], 1u);
            asm volatile("s_waitcnt vmcnt(0)" ::: "memory");
        } else {
            XB_SPIN(xb_ld(&bar[XB_XGEN(bx)]) == gen, bar);
            __builtin_amdgcn_fence(__ATOMIC_ACQUIRE, "agent");
            asm volatile("s_waitcnt vmcnt(0)" ::: "memory");
        }
    }
    __syncthreads();
}

#define LDS_WAIT() asm volatile("s_waitcnt lgkmcnt(0)" ::: "memory")
struct TrD { const float* W; int ldw, k0, n0; bf16_t* WT; int ldt, drow0; const float* ksc; const float* nsc; float mul; };
__device__ __forceinline__ void tr_load(const TrD& d, float (&v)[32], int lane) {
    const float* wp = d.W + (size_t)(d.k0 + (lane >> 5)) * d.ldw + d.n0 + (lane & 31);
#pragma unroll
    for (int i = 0; i < 32; ++i) v[i] = __builtin_nontemporal_load(wp + (size_t)(2 * i) * d.ldw);
}
__device__ __forceinline__ void tr_finish(const TrD& d, float (&v)[32], LAS float* scr, int lane) {
    const float ns = (d.nsc ? d.nsc[d.n0 + (lane & 31)] : 1.f) * d.mul;
    if (d.ksc) {
#pragma unroll
        for (int i = 0; i < 32; ++i) v[i] *= d.ksc[d.k0 + 2 * i + (lane >> 5)]; }
#pragma unroll
    for (int i = 0; i < 32; ++i) scr[(2 * i + (lane >> 5)) * 33 + (lane & 31)] = v[i] * ns;
    LDS_WAIT(); asm volatile("" ::: "memory");
    const int c = lane & 7;
#pragma unroll
    for (int j = 0; j < 4; ++j) { const int n = (lane >> 3) + 8 * j; const LAS float* s = scr + (8 * c) * 33 + n;
        u32x4 o; o.x = cvt_pk_bf16(s[0 * 33], s[1 * 33]); o.y = cvt_pk_bf16(s[2 * 33], s[3 * 33]); o.z = cvt_pk_bf16(s[4 * 33], s[5 * 33]); o.w = cvt_pk_bf16(s[6 * 33], s[7 * 33]);
        *(u32x4*)(d.WT + (size_t)(d.drow0 + n) * d.ldt + d.k0 + 8 * c) = o; }
    LDS_WAIT(); asm volatile("" ::: "memory");
}
struct In {
    const float *x, *c, *ctx, *c_ctx, *ada_w, *ada_b, *norm_g, *pool_w, *pool_scale, *w_dqkv, *q_norm, *w_uq, *kv_norm, *w_ukv, *w_o, *w1, *w3, *w2;
};
constexpr int I_F = (D / 64) * (DFF / 32);
constexpr int I_P = (512 / 64) * (512 / 32);
constexpr int I_DQ = (D / 64) * (1088 / 32);
constexpr int I_UQ = (QL / 64) * (NQ / 32), I_UKV = (KVL / 64) * (NKV / 32);
constexpr int I_O = (D / 64) * (D / 32);
constexpr int SEG0 = 0;
constexpr int SEG1 = SEG0 + 3 * I_F + 8 * I_P + 2 * I_DQ;
constexpr int SEG2 = SEG1 + 3 * I_F;
constexpr int SEG3 = SEG2 + I_UQ + I_UKV + I_O;
constexpr int SEG4 = SEG3 + 3 * I_F;
constexpr int SEG5 = SEG4 + 2 * I_F;
constexpr int SEG6 = SEG5 + I_UQ + I_UKV + I_O + I_F;
__device__ __forceinline__ TrD d_ffn(const In& I, unsigned char* ws, int l, int which, int item) {
    if (which < 2) { const int nblk = DFF / 32, kb = item / nblk, nb = item % nblk, n0 = nb * 32;
        return TrD{(which ? I.w3 : I.w1) + (size_t)l * D * DFF, DFF, kb * 64, n0, (bf16_t*)(ws + WS_W13) + (size_t)l * 2 * DFF * D, D, 256 * (n0 >> 7) + 128 * which + (n0 & 127), nullptr, nullptr, 1.f}; }
    const int nblk = D / 32, kb = item / nblk, nb = item % nblk;
    return TrD{I.w2 + (size_t)l * DFF * D, D, kb * 64, nb * 32, (bf16_t*)(ws + WS_W2) + (size_t)l * D * DFF, DFF, nb * 32, nullptr, nullptr, 1.f};
}
__device__ __forceinline__ TrD d_pool(const In& I, unsigned char* ws, int r) { const int jg = r / I_P, item = r % I_P, j = jg >> 2, g = jg & 3, nblk = 512 / 32, kb = item / nblk, nb = item % nblk;
    return TrD{I.pool_w + (size_t)jg * 512 * 512, 512, kb * 64, nb * 32, (bf16_t*)(ws + WS_WPOOL) + (size_t)j * D * 512, 512, g * 512 + nb * 32, nullptr, I.pool_scale + j * D + g * 512, 1.f}; }
__device__ __forceinline__ TrD d_dq(const In& I, unsigned char* ws, int j, int item) { const int nblk = 1088 / 32, kb = item / nblk, nb = item % nblk;
    return TrD{I.w_dqkv + (size_t)j * D * 1088, 1088, kb * 64, nb * 32, (bf16_t*)(ws + WS_WDQKV) + (size_t)j * NDQKV * D, D, nb * 32, nullptr, nullptr, 1.f}; }
__device__ __forceinline__ TrD d_uq(const In& I, unsigned char* ws, int j, int item) { const int nblk = NQ / 32, kb = item / nblk, nb = item % nblk;
    return TrD{I.w_uq + (size_t)j * QL * NQ, NQ, kb * 64, nb * 32, (bf16_t*)(ws + WS_WUP) + (size_t)j * NUP * 512, 512, nb * 32, I.q_norm + j * QL, nullptr, att::SCALE * 1.4426950408889634f}; }
__device__ __forceinline__ TrD d_ukv(const In& I, unsigned char* ws, int j, int item) { const int nblk = NKV / 32, kb = item / nblk, nb = item % nblk;
    return TrD{I.w_ukv + (size_t)j * KVL * NKV, NKV, kb * 64, nb * 32, (bf16_t*)(ws + WS_WUP) + (size_t)j * NUP * 512, 512, NQ + nb * 32, I.kv_norm + j * KVL, nullptr, 1.f}; }
__device__ __forceinline__ TrD d_o(const In& I, unsigned char* ws, int j, int item) { const int nblk = D / 32, kb = item / nblk, nb = item % nblk;
    return TrD{I.w_o + (size_t)j * D * D, D, kb * 64, nb * 32, (bf16_t*)(ws + WS_WO) + (size_t)j * D * D, D, nb * 32, nullptr, nullptr, 1.f}; }
__device__ __forceinline__ TrD tr_desc(const In& I, unsigned char* ws, int r) {
#define PIECE(cnt, expr) if (r < (cnt)) return expr; r -= (cnt);
    PIECE(I_F, d_ffn(I, ws, 0, 0, r)) PIECE(I_F, d_ffn(I, ws, 0, 1, r)) PIECE(I_F, d_ffn(I, ws, 0, 2, r)) PIECE(8 * I_P, d_pool(I, ws, r)) PIECE(I_DQ, d_dq(I, ws, 0, r)) PIECE(I_DQ, d_dq(I, ws, 1, r))
    PIECE(I_F, d_ffn(I, ws, 1, 0, r)) PIECE(I_F, d_ffn(I, ws, 1, 1, r)) PIECE(I_F, d_ffn(I, ws, 1, 2, r))
    PIECE(I_UQ, d_uq(I, ws, 0, r)) PIECE(I_UKV, d_ukv(I, ws, 0, r)) PIECE(I_O, d_o(I, ws, 0, r))
    PIECE(I_F, d_ffn(I, ws, 2, 0, r)) PIECE(I_F, d_ffn(I, ws, 2, 1, r)) PIECE(I_F, d_ffn(I, ws, 2, 2, r))
    PIECE(I_F, d_ffn(I, ws, 3, 0, r)) PIECE(I_F, d_ffn(I, ws, 3, 1, r))
    PIECE(I_UQ, d_uq(I, ws, 1, r)) PIECE(I_UKV, d_ukv(I, ws, 1, r)) PIECE(I_O, d_o(I, ws, 1, r))
    return d_ffn(I, ws, 3, 2, r);
#undef PIECE
}
__device__ __forceinline__ void tr_run(const In& I, unsigned char* ws, int seg_lo, int seg_n, int v, int vs, LAS float* scr, int lane) {
    float vA[32], vB[32]; TrD dA, dB; int it = v;
    if (it < seg_n) { dA = tr_desc(I, ws, seg_lo + it); tr_load(dA, vA, lane); }
    while (it < seg_n) {
        int itn = it + vs;
        if (itn < seg_n) { dB = tr_desc(I, ws, seg_lo + itn); tr_load(dB, vB, lane); }
        tr_finish(dA, vA, scr, lane);
        it = itn; if (it >= seg_n) break;
        itn = it + vs;
        if (itn < seg_n) { dA = tr_desc(I, ws, seg_lo + itn); tr_load(dA, vA, lane); }
        tr_finish(dB, vB, scr, lane);
        it = itn;
    }
}
#ifndef GEMV_DEFER
#define GEMV_DEFER 0
#endif
constexpr int KSPL2 = 64;
template <int KLEN>
__device__ __forceinline__ void gemv_task(const In& I, float* outp, int l, int st, int k0, int lane) {
    constexpr int NHALF = (KLEN + 63) / 64, HL = KLEN < 64 ? KLEN : 64;
    float sv[3][NHALF];
#pragma unroll
    for (int h = 0; h < NHALF; ++h) { const int k = k0 + h * 64 + (lane % HL); const float c0 = I.c[k], c1 = I.c[D + k], c2 = I.c_ctx[k];
        sv[0][h] = c0 / (1.f + __expf(-c0)); sv[1][h] = c1 / (1.f + __expf(-c1)); sv[2][h] = c2 / (1.f + __expf(-c2)); }
    const float* wp = I.ada_w + ((size_t)l * D + k0) * NMOD + st * 256 + lane * 4;
    f32x4 a0 = {0.f, 0.f, 0.f, 0.f}, a1 = a0, a2 = a0;
#pragma unroll
    for (int h = 0; h < NHALF; ++h)
#pragma unroll (KLEN < 64 ? 16 : 8)
        for (int kk = 0; kk < HL; ++kk) { const f32x4 w = __builtin_nontemporal_load((const f32x4*)(wp + (size_t)(h * 64 + kk) * NMOD));
            a0 += w * __int_as_float(__builtin_amdgcn_readlane(__float_as_int(sv[0][h]), kk)); a1 += w * __int_as_float(__builtin_amdgcn_readlane(__float_as_int(sv[1][h]), kk)); a2 += w * __int_as_float(__builtin_amdgcn_readlane(__float_as_int(sv[2][h]), kk)); }
    float* mp = outp + st * 256 + lane * 4;
    *(f32x4*)mp = a0; *(f32x4*)(mp + NMOD) = a1; *(f32x4*)(mp + 2 * NMOD) = a2;
}
__device__ __forceinline__ void filler(const In& I, unsigned char* ws, int gl, int seg_lo, int seg_n, int fi, int fn, LAS float* scr, int lane) {
    int v = fi;
    if (gl > 0) { constexpr int NG2 = (NMOD / 256) * KSPL2; float* mp2 = (float*)(ws + WS_MODP2) + (size_t)(gl - 1) * KSPL2 * 3 * NMOD;
#if GEMV_TWICE
        if (gl == 2) for (int v2 = fi; v2 < NG2; v2 += fn) { const int ks = v2 % KSPL2, st = v2 / KSPL2; gemv_task<D / KSPL2>(I, mp2 + (size_t)ks * 3 * NMOD, gl, st, ks * (D / KSPL2), lane); }
#endif
        for (; v < NG2; v += fn) { const int ks = v % KSPL2, st = v / KSPL2; gemv_task<D / KSPL2>(I, mp2 + (size_t)ks * 3 * NMOD, gl, st, ks * (D / KSPL2), lane); }
        v -= NG2; }
    tr_run(I, ws, seg_lo, seg_n, v, fn, scr, lane);
}

__device__ __forceinline__ void prologue(const In& I, unsigned char* ws, LAS unsigned char* lds, int gw, int ngw, int wave, int lane, int gtid, int ngt) {
    LAS float* scr = (LAS float*)(lds + wave * 16384);
    bf16_t* WDQKV = (bf16_t*)(ws + WS_WDQKV);
    tr_run(I, ws, SEG0, SEG1 - SEG0, gw, ngw, scr, lane);
    { constexpr int PER = (NDQKV - 1088) * D / 8;
        for (int i = gtid; i < 2 * PER; i += ngt) { const int j = i / PER, q = i % PER; *(u32x4*)(WDQKV + (size_t)j * NDQKV * D + (size_t)1088 * D + (size_t)q * 8) = (u32x4){0u, 0u, 0u, 0u}; } }
    if (gtid < 128 * 16) { const int pos = gtid >> 4, f = gtid & 15; const float inv = powf(10000.f, -(float)(2 * f) / 32.f), ang = (float)pos * inv;
        float* tab = (float*)(ws + WS_ROPE); tab[gtid * 2] = cosf(ang); tab[gtid * 2 + 1] = sinf(ang); }
    { float* MODP = (float*)(ws + WS_G); constexpr int NSTRIP = NMOD / 256, KLEN = D / KSPL;
        for (int task = gw; task < (GEMV_DEFER ? 2 : 4) * NSTRIP * KSPL; task += ngw) { const int ks = task % KSPL, st = (task / KSPL) % NSTRIP, l = task / (KSPL * NSTRIP);
            gemv_task<KLEN>(I, MODP + (size_t)ks * 12 * NMOD + (size_t)l * 3 * NMOD, l, st, ks * KLEN, lane); } }
}

struct RN { const float* xin_lat; const float* xin_ctx; const bf16_t* hin; const bf16_t* Y; const float* Yp; int nparts; const float* gate; const float* gY; bf16_t* hout; float* fout;
            const float* gN; const float* shift; const float* scale; bf16_t* U; int nrows; const float* modp; const float* bias; float* mod_out; };
template <bool HAS_Y, bool WRITE_U, bool HIN_F32, bool HOUT_F32, bool MODP_IN = false, bool POOLY = false>
__device__ __forceinline__ void resid_norm(const RN& a, LAS unsigned char* lds, int gw, int ngw, int tid) {
    asm volatile("" : "+v"(tid)); const int lane = tid & 63;
    typedef const GAS char* gcp; typedef GAS char* gp;
    if (MODP_IN) {
        for (int i = (gw * 64 + lane); i < (GEMV_DEFER ? 6 : 12) * NMOD / 4; i += ngw * 64) { f32x4 acc = *(const GAS f32x4*)((gcp)a.bias + 16 * ((size_t)(i / (3 * NMOD / 4)) * (NMOD / 4) + i % (NMOD / 4)));
            for (int p = 0; p < KSPL; ++p) acc += *(const GAS f32x4*)((gcp)a.modp + ((size_t)p * 12 * NMOD + (size_t)i * 4) * 4);
            *(GAS f32x4*)((gp)a.mod_out + (size_t)i * 16) = acc; } }
    for (int i = tid; i < 3 * (D / 4); i += NTHREADS) { const int s = i / (D / 4), c4 = i % (D / 4); LAS f32x4* t = (LAS f32x4*)(lds + s * 24576) + c4;
        if (HAS_Y) t[0] = *(const GAS f32x4*)((gcp)(a.gate + (size_t)s * NMOD) + 16 * c4) * *(const GAS f32x4*)((gcp)a.gY + 16 * c4);
        if (WRITE_U) { f32x4 sc, sh;
            if (MODP_IN) { sh = *(const GAS f32x4*)((gcp)a.bias + 16 * c4); sc = *(const GAS f32x4*)((gcp)a.bias + 16 * (D / 4 + c4));
                for (int p = 0; p < KSPL; ++p) { const float* mp = a.modp + (size_t)p * 12 * NMOD + (size_t)s * NMOD; sh += *(const GAS f32x4*)((gcp)mp + 16 * c4); sc += *(const GAS f32x4*)((gcp)mp + 16 * (D / 4 + c4)); } }
            else { sc = *(const GAS f32x4*)((gcp)(a.scale + (size_t)s * NMOD) + 16 * c4); sh = *(const GAS f32x4*)((gcp)(a.shift + (size_t)s * NMOD) + 16 * c4); }
            t[D / 4] = *(const GAS f32x4*)((gcp)a.gN + 16 * c4) * (sc + 1.f); t[2 * (D / 4)] = sh; } }
    __syncthreads();
    const unsigned l16 = (unsigned)lane * 16u, l8 = (unsigned)lane * 8u;
    const int nrows = a.nrows, nparts = a.nparts;
#define LDF4(base, j) (*(const GAS f32x4*)((gcp)(base) + l16 + 1024u * (j)))
#define LDB4(base, j) (*(const GAS u32x2*)((gcp)(base) + l8 + 512u * (j)))
#define UNPK(w) ((f32x4){bf_lo((w).x), bf_hi((w).x), bf_lo((w).y), bf_hi((w).y)})
#define RN_LOAD(hf, hw, yw, r) do { \
        if (HIN_F32) { const float* hp_ = (r) < TL ? a.xin_lat + (size_t)(r) * D : a.xin_ctx + (size_t)((r) - TL) * D; _Pragma("unroll") for (int j = 0; j < 8; ++j) hf[j] = LDF4(hp_, j); } \
        else { const bf16_t* hp_ = a.hin + (size_t)(r) * D; _Pragma("unroll") for (int j = 0; j < 8; ++j) hw[j] = LDB4(hp_, j); } \
        if (HAS_Y && !POOLY && !((r) >= TL && nparts > 0)) { const bf16_t* yr_ = a.Y + (size_t)(r) * D; _Pragma("unroll") for (int j = 0; j < 8; ++j) yw[j] = LDB4(yr_, j); } } while (0)
#define RN_PROC(hf, hw, yw, r) do { const int s_ = (r) < SEQ ? 0 : ((r) < TL ? 1 : 2); const LAS f32x4* tb_ = (const LAS f32x4*)(lds + s_ * 24576) + lane; f32x4 h[8]; \
        _Pragma("unroll") for (int j = 0; j < 8; ++j) h[j] = HIN_F32 ? hf[j] : UNPK(hw[j]); \
        if (HAS_Y) { f32x4 y[8]; float sy = 0.f; \
            if (POOLY) {   \
                int sb_, L_; if ((r) < TL) { sb_ = ((r) / SEQ) * SEQ; L_ = SEQ; } else { sb_ = TL + (((r) - TL) / CTXL) * CTXL; L_ = CTXL; } const int t_ = (r) - sb_; const bf16_t* zs_ = a.Y + (size_t)sb_ * D; \
                _Pragma("unroll") for (int g = 0; g < 4; ++g) { const int w2_ = 1 << g, lo_ = max(t_ - w2_, 0), hi_ = min(t_ + w2_, L_); const float inv_ = 1.f / (float)(hi_ - lo_); \
                    f32x4 s0_ = {0.f, 0.f, 0.f, 0.f}, s1_ = s0_; \
                    _Pragma("unroll") for (int i = 0; i < 2 * w2_; ++i) { const int q_ = t_ - w2_ + i; const bool ok_ = q_ >= 0 && q_ < L_; const bf16_t* zr_ = zs_ + (size_t)(ok_ ? q_ : t_) * D; \
                        const u32x2 wa_ = LDB4(zr_, 2 * g), wb_ = LDB4(zr_, 2 * g + 1); const float m_ = ok_ ? 1.f : 0.f; s0_ += UNPK(wa_) * m_; s1_ += UNPK(wb_) * m_; } \
                    const bf16_t* zc_ = zs_ + (size_t)t_ * D; const u32x2 ca_ = LDB4(zc_, 2 * g), cb_ = LDB4(zc_, 2 * g + 1); y[2 * g] = s0_ * inv_ - UNPK(ca_); y[2 * g + 1] = s1_ * inv_ - UNPK(cb_); } } \
            else if ((r) >= TL && nparts > 0) { _Pragma("unroll") for (int j = 0; j < 8; ++j) y[j] = (f32x4){0.f, 0.f, 0.f, 0.f}; \
                for (int p = 0; p < nparts; ++p) { const float* yp_ = a.Yp + ((size_t)p * TC + ((r) - TL)) * D; _Pragma("unroll") for (int j = 0; j < 8; ++j) y[j] += LDF4(yp_, j); } } \
            else { _Pragma("unroll") for (int j = 0; j < 8; ++j) y[j] = UNPK(yw[j]); } \
            _Pragma("unroll") for (int j = 0; j < 8; ++j) sy += (y[j][0] * y[j][0] + y[j][1] * y[j][1]) + (y[j][2] * y[j][2] + y[j][3] * y[j][3]); \
            const float rs_ = __builtin_amdgcn_rsqf(wave_sum(sy) * (1.f / D) + RMS_EPS); \
            _Pragma("unroll") for (int j = 0; j < 8; ++j) h[j] += tb_[64 * j] * (y[j] * rs_); } \
        if (HOUT_F32) { float* op_ = a.fout + (size_t)(r) * D; _Pragma("unroll") for (int j = 0; j < 8; ++j) __builtin_nontemporal_store(h[j], (GAS f32x4*)((gp)op_ + l16 + 1024u * j)); } \
        else if (a.hout) { bf16_t* op_ = a.hout + (size_t)(r) * D; _Pragma("unroll") for (int j = 0; j < 8; ++j) { u32x2 w; w.x = cvt_pk_bf16(h[j][0], h[j][1]); w.y = cvt_pk_bf16(h[j][2], h[j][3]); *(GAS u32x2*)((gp)op_ + l8 + 512u * j) = w; } } \
        if (WRITE_U) { float ss = 0.f; \
            _Pragma("unroll") for (int j = 0; j < 8; ++j) ss += (h[j][0] * h[j][0] + h[j][1] * h[j][1]) + (h[j][2] * h[j][2] + h[j][3] * h[j][3]); \
            const float rstd_ = __builtin_amdgcn_rsqf(wave_sum(ss) * (1.f / D) + RMS_EPS); bf16_t* ur_ = a.U + (size_t)(r) * D; \
            _Pragma("unroll") for (int j = 0; j < 8; ++j) { const f32x4 u = (h[j] * rstd_) * tb_[D / 4 + 64 * j] + tb_[2 * (D / 4) + 64 * j]; u32x2 w; w.x = cvt_pk_bf16(u[0], u[1]); w.y = cvt_pk_bf16(u[2], u[3]); \
                *(GAS u32x2*)((gp)ur_ + l8 + 512u * j) = w; } } } while (0)
    f32x4 hfA[8], hfB[8], hfC[8]; u32x2 hwA[8], hwB[8], hwC[8], ywA[8], ywB[8], ywC[8];
    int r = POOLY ? gw : (gw % NWAVES) * (ngw / NWAVES) + gw / NWAVES;
    if (r < nrows) RN_LOAD(hfA, hwA, ywA, r);
    if (r + ngw < nrows) RN_LOAD(hfB, hwB, ywB, r + ngw);
    while (r < nrows) {
        if (r + 2 * ngw < nrows) RN_LOAD(hfC, hwC, ywC, r + 2 * ngw);
        RN_PROC(hfA, hwA, ywA, r);
        r += ngw; if (r >= nrows) break;
        if (r + 2 * ngw < nrows) RN_LOAD(hfA, hwA, ywA, r + 2 * ngw);
        RN_PROC(hfB, hwB, ywB, r);
        r += ngw; if (r >= nrows) break;
        if (r + 2 * ngw < nrows) RN_LOAD(hfB, hwB, ywB, r + 2 * ngw);
        RN_PROC(hfC, hwC, ywC, r);
        r += ngw;
    }
#undef LDF4
#undef LDB4
#undef UNPK
#undef RN_LOAD
#undef RN_PROC
    __syncthreads();
}

__device__ __forceinline__ void krope_phase(const bf16_t* __restrict__ CQKV, bf16_t* __restrict__ KR, const float* __restrict__ tab, int gtid, int ngt) {
    asm volatile("" : "+v"(gtid));
    for (int i = gtid; i < T * 32; i += ngt) { const int r = i >> 5, ax = (i >> 4) & 1, f = i & 15;
        const bf16_t* src = CQKV + (size_t)r * NDQKV + 1024 + ax * 32 + f; const float x1 = bf_lo((unsigned)src[0]), x2 = bf_lo((unsigned)src[16]); float o1 = x1, o2 = x2;
        if (r < TL) { const int t = r & (SEQ - 1), pos = ax ? (t & 63) : (t >> 6); const float c = tab[(pos * 16 + f) * 2], s = tab[(pos * 16 + f) * 2 + 1]; o1 = x1 * c - x2 * s; o2 = x2 * c + x1 * s; }
        bf16_t* dst = KR + (size_t)r * ROPED + ax * 32 + f; dst[0] = (bf16_t)(cvt_pk_bf16(o1, 0.f) & 0xffffu); dst[16] = (bf16_t)(cvt_pk_bf16(o2, 0.f) & 0xffffu); }
}

#ifndef EN_P0
#define EN_P0 1
#endif
#ifndef EN_P1
#define EN_P1 1
#endif
#ifndef EN_S0
#define EN_S0 1
#endif
#ifndef EN_S1
#define EN_S1 1
#endif
#ifndef EN_S2
#define EN_S2 1
#endif
#ifndef EN_S3
#define EN_S3 1
#endif
#ifndef EN_S4
#define EN_S4 1
#endif
#ifndef EN_S5
#define EN_S5 1
#endif
#ifndef EN_S6
#define EN_S6 1
#endif
#ifndef EN_S7
#define EN_S7 1
#endif
struct Args { const float* in[18]; float* out; unsigned char* ws; int ph_lo, ph_hi; };
constexpr int N_PHASES = 34;
constexpr int SPLIT_POOL = 2, SPLIT_WO = 8, SPLIT_FFN2 = 11;

__global__ void __launch_bounds__(NTHREADS, 2) mk_fwd(Args args) {
    extern __shared__ __attribute__((aligned(16))) unsigned char lds_raw[];
    LAS unsigned char* lds = (LAS unsigned char*)lds_raw;
    volatile LAS unsigned* MISC = (volatile LAS unsigned*)(lds + MISC_OFF);
    const int G0 = gridDim.x, bid0 = blockIdx.x;
    unsigned char* ws = args.ws;
    for (int u = threadIdx.x; u < (LDS_BYTES - MISC_OFF) / 4; u += NTHREADS) ((LAS unsigned*)(lds + MISC_OFF))[u] = 0u;
    __syncthreads();
#if MK_PER_PHASE
    const int lo = args.ph_lo, hi = args.ph_hi;
#else
    constexpr int lo = 0, hi = N_PHASES;
#endif
    const bool use_bar = (hi - lo) > 1;
    XcdBarrier bar; bar.bar = (unsigned*)(ws + WS_CTL) + CW_BAR; bar.x = 0; bar.st = MISC + 8;
    if (use_bar) bar = xcd_barrier_post((unsigned*)(ws + WS_CTL) + CW_BAR, MISC + 8);
#define IN(k) (lo <= (k) && (k) < hi)
#define PHASE_END(k) do { if (hi > (k) + 1) xcd_barrier(bar); } while (0)
#define SITE() int tid = threadIdx.x, G = G0, bid = bid0; asm volatile("" : "+v"(tid), "+s"(G), "+s"(bid)); const int lane = tid & 63, wave = __builtin_amdgcn_readfirstlane(tid >> 6), gw = bid * NWAVES + wave, gtid = bid * NTHREADS + tid, ngw = G * NWAVES, ngt = G * NTHREADS; \
               (void)lane; (void)gw; (void)gtid; (void)ngw; (void)ngt; const __attribute__((address_space(4))) char* kp_ = (const __attribute__((address_space(4))) char*)__builtin_amdgcn_kernarg_segment_ptr(); asm volatile("" : "+s"(kp_)); \
               unsigned char* wsl = *(unsigned char* const __attribute__((address_space(4)))*)(kp_ + 19 * 8); asm volatile("" : "+s"(wsl))
#define KIN(k) (*(const float* const __attribute__((address_space(4)))*)(kp_ + (k) * 8))
#define KOUT() (*(float* const __attribute__((address_space(4)))*)(kp_ + 18 * 8))
#define WP(type, off) ((type*)(wsl + (off)))
#define MKIN() In I; I.x = KIN(0); I.c = KIN(1); I.ctx = KIN(2); I.c_ctx = KIN(3); I.ada_w = KIN(4); I.ada_b = KIN(5); I.norm_g = KIN(6); I.pool_w = KIN(7); \
               I.pool_scale = KIN(8); I.w_dqkv = KIN(9); I.q_norm = KIN(10); I.w_uq = KIN(11); I.kv_norm = KIN(12); I.w_ukv = KIN(13); I.w_o = KIN(14); I.w1 = KIN(15); I.w3 = KIN(16); I.w2 = KIN(17)
#define FILL_TAIL(gl, seg_lo, seg_hi) do { const int nshort_ = S.nwg % G; if (bid >= nshort_) { __syncthreads(); MKIN();   \
               filler(I, wsl, (gl), (seg_lo), (seg_hi) - (seg_lo), (bid - nshort_) * NWAVES + wave, (G - nshort_) * NWAVES, (LAS float*)(lds + wave * 16384), lane); } } while (0)

    if (EN_P0 && IN(0)) { SITE();
        MKIN();
        prologue(I, wsl, lds, gw, ngw, wave, lane, gtid, ngt); PHASE_END(0); }
    if (EN_P1 && IN(1)) { SITE();
        RN a; a.xin_lat = KIN(0); a.xin_ctx = KIN(2); a.hin = nullptr; a.Y = nullptr; a.Yp = nullptr; a.nparts = 0; a.gate = nullptr; a.gY = nullptr; a.hout = nullptr; a.fout = nullptr;
        a.gN = KIN(6); a.shift = nullptr; a.scale = nullptr; a.U = WP(bf16_t, WS_U); a.nrows = T; a.modp = WP(const float, WS_G); a.bias = KIN(5); a.mod_out = WP(float, WS_MOD);
        resid_norm<false, true, true, false, true>(a, lds, gw, ngw, tid); PHASE_END(1); }

    for (int L = 0; L < 4; ++L) {
        const int base = 2 + 8 * L, j = L >> 1; const bool pool = (L & 1) == 0;
        const int Mrows = (L == 3) ? TL : T;
        if (EN_S0 && !pool && IN(base + 0)) { SITE(); float* SSQ = WP(float, WS_SSQ);
            pg8::Gemm g{WP(const bf16_t, WS_U), WP(const bf16_t, WS_WDQKV) + (size_t)j * NDQKV * D, T, NDQKV, D, D, D}; pg8::StaticOrder S; S.init(T, NDQKV, D, G, bid);
            pg8::EpiStore E{WP(bf16_t, WS_CQKV), NDQKV, SSQ, SSQ + (size_t)8 * T, 2, 4, 0, 0};
            pg8::gemm_phase<pg8::EpiStore, pg8::StaticOrder>(lds, g, S, E);
            { const int lo_ = L == 1 ? SEG2 : SEG5, hi_ = L == 1 ? SEG3 : SEG6; FILL_TAIL(GEMV_DEFER && L == 1 ? 2 : 0, lo_, hi_); }
            PHASE_END(base + 0); }
        if (EN_S1 && !pool && IN(base + 1)) { SITE(); float* SSQ = WP(float, WS_SSQ);
            krope_phase(WP(const bf16_t, WS_CQKV), WP(bf16_t, WS_KR), WP(const float, WS_ROPE), gtid, ngt);
            pg8::Gemm g{WP(const bf16_t, WS_CQKV), WP(const bf16_t, WS_WUP) + (size_t)j * NUP * 512, T, NUP, 512, NDQKV, 512}; pg8::StaticOrder S; S.init(T, NUP, 512, G, bid);
            pg8::EpiUp E{WP(bf16_t, WS_Q), WP(bf16_t, WS_KV), SSQ, SSQ + (size_t)8 * T};
            pg8::gemm_phase<pg8::EpiUp, pg8::StaticOrder>(lds, g, S, E);
            PHASE_END(base + 1); }
        if (EN_S2 && !pool && IN(base + 2)) { SITE();
            const bf16_t* Qb = WP(const bf16_t, WS_Q); const bf16_t* KV = WP(const bf16_t, WS_KV); bf16_t* P = WP(bf16_t, WS_P);
            const int nlat = NB * NH * (SEQ / 256), nunits = nlat + (L == 1 ? NB * NH : 0);
            for (int u = bid; u < nunits; u += G) {
                att::Unit A;
                if (u < nlat) { const int pair = (u >> 8) * 8 + (u & 7), qb = (u & 255) >> 3, b = pair >> 4, h = pair & 15; const int row0 = b * SEQ + qb * 256;
                    A.Qb = Qb + (size_t)row0 * NQ + h * QKD; A.KVh = KV + h * 256; A.Ob = P + (size_t)row0 * D + h * VD; A.kb_lat = b * SEQ; A.nt_lat = SEQ / 64; A.kb_ctx = TL + b * CTXL; A.NT = SEQ / 64 + CTXL / 64; A.qpos0 = qb * 256; }
                else { const int v = u - nlat, b = v >> 4, h = v & 15; const int row0 = TL + b * CTXL;
                    A.Qb = Qb + (size_t)row0 * NQ + h * QKD; A.KVh = KV + h * 256; A.Ob = P + (size_t)row0 * D + h * VD; A.kb_lat = 0; A.nt_lat = 0; A.kb_ctx = row0; A.NT = CTXL / 64; A.qpos0 = -1; }
                att::attn_unit_auto(A, WP(const bf16_t, WS_KR), WP(const float, WS_ROPE), lds);
            }
            PHASE_END(base + 2); }
        if (EN_S3 && IN(base + 3)) { SITE();
            pg8::Gemm g; pg8::EpiY E{WP(bf16_t, WS_Y), WP(float, WS_YP), D, TL, TC, 0, 0}; pg8::HybridOrder S;
            if (pool) { g = pg8::Gemm{WP(const bf16_t, WS_U), WP(const bf16_t, WS_WPOOL) + (size_t)j * D * 512, Mrows, D, 512, D, 512}; E.a_grp_tiles = 2; E.a_grp_off = 512; S.init(Mrows, Mrows, D, 512, G, bid, 1); }
            else { g = pg8::Gemm{WP(const bf16_t, WS_P), WP(const bf16_t, WS_WO) + (size_t)j * D * D, Mrows, D, D, D, D}; S.init(TL, Mrows, D, D, G, bid, SPLIT_WO); }
            pg8::gemm_phase<pg8::EpiY, pg8::HybridOrder>(lds, g, S, E);
            PHASE_END(base + 3); }
        if (EN_S4 && IN(base + 4)) { SITE(); const float* modL = WP(const float, WS_MOD) + (size_t)L * 3 * NMOD; const float* gL = KIN(6) + (size_t)L * 4 * D;
            RN a; a.xin_lat = KIN(0); a.xin_ctx = KIN(2); a.hin = WP(const bf16_t, WS_H); a.Y = WP(const bf16_t, WS_Y); a.Yp = WP(const float, WS_YP); a.nparts = (!pool && Mrows > TL) ? SPLIT_WO : 0; a.gate = modL + 2 * D; a.gY = gL + D;
            a.hout = WP(bf16_t, WS_H); a.fout = nullptr; a.gN = gL + 2 * D; a.shift = modL + 3 * D; a.scale = modL + 4 * D; a.U = WP(bf16_t, WS_U); a.nrows = Mrows; a.modp = nullptr; a.bias = nullptr; a.mod_out = nullptr;
            if (L == 0) resid_norm<true, true, true, false, false, true>(a, lds, gw, ngw, tid); else if (pool) resid_norm<true, true, false, false, false, true>(a, lds, gw, ngw, tid); else resid_norm<true, true, false, false>(a, lds, gw, ngw, tid);
            PHASE_END(base + 4); }
        if (EN_S5 && IN(base + 5)) { SITE(); pg8::Gemm g{WP(const bf16_t, WS_U), WP(const bf16_t, WS_W13) + (size_t)L * 2 * DFF * D, Mrows, 2 * DFF, D, D, D}; pg8::StaticOrder S; S.init(Mrows, 2 * DFF, D, G, bid);
            pg8::EpiSwiGLU E{WP(bf16_t, WS_G), DFF};
            pg8::gemm_phase<pg8::EpiSwiGLU, pg8::StaticOrder>(lds, g, S, E);
            if (L < 3) { const int lo_ = L == 0 ? SEG1 : L == 1 ? SEG3 : SEG4, hi_ = L == 0 ? SEG2 : L == 1 ? SEG4 : SEG5; FILL_TAIL(GEMV_DEFER && L == 2 ? 3 : 0, lo_, hi_); }
            PHASE_END(base + 5); }
        if (EN_S6 && IN(base + 6)) { SITE();
            pg8::Gemm g{WP(const bf16_t, WS_G), WP(const bf16_t, WS_W2) + (size_t)L * D * DFF, Mrows, D, DFF, DFF, DFF}; pg8::HybridOrder S; S.init(TL, Mrows, D, DFF, G, bid, SPLIT_FFN2);
            pg8::EpiY E{WP(bf16_t, WS_Y), WP(float, WS_YP), D, TL, TC, 0, 0};
            pg8::gemm_phase<pg8::EpiY, pg8::HybridOrder>(lds, g, S, E);
            if (GEMV_DEFER && (L == 1 || L == 2)) { const float* mp2 = WP(const float, WS_MODP2) + (size_t)L * KSPL2 * 3 * NMOD; const float* bias = KIN(5) + (size_t)(L + 1) * NMOD; float* mo = WP(float, WS_MOD) + (size_t)(L + 1) * 3 * NMOD;
                for (int o = gtid; o < 3 * NMOD; o += ngt) { float acc = bias[o % NMOD];
#pragma unroll 16
                    for (int p = 0; p < KSPL2; ++p) acc += mp2[(size_t)p * 3 * NMOD + o];
                    mo[o] = acc; } }
            PHASE_END(base + 6); }
        if (EN_S7 && IN(base + 7)) { SITE(); const float* modL = WP(const float, WS_MOD) + (size_t)L * 3 * NMOD; const float* gL = KIN(6) + (size_t)L * 4 * D;
            RN a; a.xin_lat = nullptr; a.xin_ctx = nullptr; a.hin = WP(const bf16_t, WS_H); a.Y = WP(const bf16_t, WS_Y); a.Yp = WP(const float, WS_YP); a.nparts = L < 3 ? SPLIT_FFN2 : 0; a.gate = modL + 5 * D; a.gY = gL + 3 * D; a.modp = nullptr; a.bias = nullptr; a.mod_out = nullptr;
            if (L < 3) { a.hout = WP(bf16_t, WS_H); a.fout = nullptr; a.gN = gL + 4 * D; a.shift = modL + 3 * NMOD; a.scale = modL + 3 * NMOD + D; a.U = WP(bf16_t, WS_U); a.nrows = T;
                resid_norm<true, true, false, false>(a, lds, gw, ngw, tid); }
            else { a.hout = nullptr; a.fout = KOUT(); a.gN = nullptr; a.shift = nullptr; a.scale = nullptr; a.U = nullptr; a.nrows = TL;
                resid_norm<true, false, false, true>(a, lds, gw, ngw, tid); }
            PHASE_END(base + 7); }
    }
#undef IN
#undef PHASE_END
}

extern "C" void kernel_launch(void* const* d_in, const int* in_sizes, int n_in, void* d_out, int out_size, void* d_ws, size_t ws_size, hipStream_t stream) {
    static int grid = 0;
    if (grid == 0) {
        if (n_in != 18 || in_sizes[0] != TL * D || out_size != TL * D || ws_size < WS_END) { fprintf(stderr, "kernel_launch: unexpected shapes (n_in %d, in0 %d, out %d, ws %zu); nothing launched\n", n_in, n_in > 0 ? in_sizes[0] : -1, out_size, ws_size); grid = -1; return; }
        int dev = 0, cus = 0, per_cu = 0;
        if (hipGetDevice(&dev) != hipSuccess || hipDeviceGetAttribute(&cus, hipDeviceAttributeMultiprocessorCount, dev) != hipSuccess) { grid = -1; return; }
        if (hipFuncSetAttribute((const void*)mk_fwd, hipFuncAttributeMaxDynamicSharedMemorySize, LDS_BYTES) != hipSuccess) { fprintf(stderr, "kernel_launch: hipFuncSetAttribute failed\n"); grid = -1; return; }
        if (hipOccupancyMaxActiveBlocksPerMultiprocessor(&per_cu, (const void*)mk_fwd, NTHREADS, LDS_BYTES) != hipSuccess || per_cu < 1) { fprintf(stderr, "kernel_launch: occupancy query says %d blocks per CU\n", per_cu); }
        (void)hipGetLastError();
        grid = cus;
    }
    if (grid < 0) return;
    if (hipMemsetAsync((char*)d_ws + WS_CTL, 0, CTL_ZERO_BYTES, stream) != hipSuccess) return;
    Args a{};
    for (int i = 0; i < 18; ++i) a.in[i] = (const float*)d_in[i];
    a.out = (float*)d_out; a.ws = (unsigned char*)d_ws;
#if MK_PER_PHASE
    for (int p = 0; p < N_PHASES; ++p) { const int k = p - 2, L = k >> 3, s = k & 7; if (p >= 2 && (L & 1) == 0 && s <= 2) continue;
        a.ph_lo = p; a.ph_hi = p + 1; hipLaunchKernelGGL(mk_fwd, dim3(grid), dim3(NTHREADS), LDS_BYTES, stream, a); }
#else
    a.ph_lo = 0; a.ph_hi = N_PHASES; hipLaunchKernelGGL(mk_fwd, dim3(grid), dim3(NTHREADS), LDS_BYTES, stream, a);
#endif
    const hipError_t le = hipPeekAtLastError();
    if (le != hipSuccess) fprintf(stderr, "kernel_launch: launch failed: %s\n", hipGetErrorName(le));
}
```

```cpp
#include <hip/hip_runtime.h>
#include <cstdio>
#include <cstdint>

#ifndef MK_PER_PHASE
#define MK_PER_PHASE 0
#endif

#define LAS __attribute__((address_space(3)))
#define GAS __attribute__((address_space(1)))
typedef unsigned short bf16_t;
typedef short bf16x8 __attribute__((ext_vector_type(8)));
typedef short s16x4 __attribute__((ext_vector_type(4)));
typedef float f32x4 __attribute__((ext_vector_type(4)));
typedef float f32x2 __attribute__((ext_vector_type(2)));
typedef float f32x16 __attribute__((ext_vector_type(16)));
typedef unsigned u32x4 __attribute__((ext_vector_type(4)));
typedef unsigned u32x2 __attribute__((ext_vector_type(2)));

constexpr int D = 2048, SEQ = 8192, NB = 2, CTXL = 256, TL = NB * SEQ, TC = NB * CTXL, T = TL + TC;
constexpr int DFF = 5632, NH = 16, QKD = 192, NOPE = 128, ROPED = 64, VD = 128, QL = 512, KVL = 512;
constexpr int NDQKV = 1280;
constexpr int NQ = NH * QKD, NKV = NH * (NOPE + VD), NUP = NQ + NKV;
constexpr int NMOD = 6 * D;
constexpr float RMS_EPS = 1e-6f;
constexpr int NWAVES = 8, NTHREADS = 512;

__device__ __forceinline__ unsigned cvt_pk_bf16(float lo, float hi) { unsigned r; asm volatile("v_cvt_pk_bf16_f32 %0, %1, %2" : "=v"(r) : "v"(lo), "v"(hi)); return r; }
__device__ __forceinline__ float bf_lo(unsigned w) { return __uint_as_float(w << 16); }
__device__ __forceinline__ float bf_hi(unsigned w) { return __uint_as_float(w & 0xffff0000u); }
__device__ __forceinline__ float wave_sum(float v) {
    int ln_ = threadIdx.x & 63; asm volatile("" : "+v"(ln_));
#pragma unroll
    for (int o = 1; o < 64; o <<= 1) v += __int_as_float(__builtin_amdgcn_ds_bpermute((ln_ ^ o) << 2, __float_as_int(v)));
    return v;
}

namespace pg8 {
constexpr int BM = 256, BK = 64, HALF = 128, HTB = HALF * BK * 2, STAGE_BYTES = 8 * HTB, NXCD = 8, WGM = 4;
__host__ __device__ __forceinline__ int lds_byte(int r, int c) { const int st = (r >> 4) * 2 + (c >> 5), rr = r & 15, cc = c & 31, ob = rr * 64 + cc * 2; return st * 1024 + (ob ^ (((ob >> 9) & 1) << 5)); }
__host__ __device__ __forceinline__ void stage_rc(int b, int& R, int& C) { const int st = b / 1024, sb = b % 1024, swz = sb ^ (((sb >> 9) & 1) << 5); R = (st >> 1) * 16 + swz / 64; C = (st & 1) * 32 + (swz % 64) / 2; }
__host__ __device__ __forceinline__ int perm32(int rho) { const int n = rho >> 4, i = rho & 15; return 8 * (i >> 2) + 4 * n + (i & 3); }

struct Unit { int pm, pn, kt0, nkt, part; };
struct Gemm { const bf16_t* A; const bf16_t* Bt; int M, N, K, lda, ldb; };

struct StaticOrder {
    int nM, nN, nwg, G, c, nkt;
    __host__ __device__ void init(int M, int N, int K, int G_, int c_) { nM = M / BM; nN = N / BM; nwg = nM * nN; G = G_; c = c_; nkt = K / BK; }
    __host__ __device__ bool next(int i, Unit& u) const {
        const long L = (long)i * G + c; if (L >= nwg) return false;
        int wgid = (int)L; { const int q = nwg / NXCD, r = nwg % NXCD, xcd = wgid % NXCD, off = wgid / NXCD; wgid = (xcd < r ? xcd * (q + 1) : r * (q + 1) + (xcd - r) * q) + off; }
        const int nig = WGM * nN, gid = wgid / nig, fm = gid * WGM, gsz = (nM - fm) < WGM ? (nM - fm) : WGM;
        u.pm = fm + ((wgid % nig) % gsz); u.pn = (wgid % nig) / gsz; u.kt0 = 0; u.nkt = nkt; u.part = -1; return true;
    }
};
struct HybridOrder {
    StaticOrder full; int nfull, nsplit, S, nktp, nN, pm0, G, c;
    __host__ __device__ void init(int Mfull, int Mtot, int N, int K, int G_, int c_, int S_) { full.init(Mfull, N, K, G_, c_); nfull = full.nwg; nN = N / BM; pm0 = Mfull / BM; S = S_; nktp = (K / BK) / S_;
        nsplit = ((Mtot - Mfull) / BM) * nN * S_; G = G_; c = c_; }
    __host__ __device__ bool next(int i, Unit& u) const {
        const long L = (long)i * G + c; if (L < nfull) return full.next(i, u);
        const int e = (int)(L - nfull); if (e >= nsplit) return false;
        const int part = e % S, tile = e / S; u.pm = pm0 + tile / nN; u.pn = tile % nN; u.kt0 = part * nktp; u.nkt = nktp; u.part = part; return true;
    }
};

template <class Epi, class Sched, bool ALIGN_EPI = true>
__device__ __forceinline__ void gemm_phase(LAS unsigned char* lds, const Gemm g, const Sched& S, const Epi& E) {
    int tid = threadIdx.x; asm volatile("" : "+v"(tid));
    const int wid = __builtin_amdgcn_readfirstlane(tid >> 6), lane = tid & 63, wr = wid >> 2, wc = wid & 3, fr = lane & 15, fq = lane >> 4;
    unsigned voffA[2], voffB[2];
#pragma unroll
    for (int i = 0; i < 2; ++i) { int R, C; stage_rc(tid * 16 + i * 8192, R, C); const int Rb = (R & ~31) + perm32(R & 31);
        voffA[i] = (unsigned)(R * g.lda + C) * 2u; voffB[i] = (unsigned)(Rb * g.ldb + C) * 2u; }
    const size_t kstep = (size_t)(BK * 2);
    const size_t hstepA = (size_t)HALF * g.lda * 2, hstepB = (size_t)HALF * g.ldb * 2;
    const size_t tstepA = 2 * hstepA, tstepB = 2 * hstepB;
    const unsigned ldsw = (unsigned)wid * 1024u;
    const int aoff = lds_byte(wr * 64 + fr, fq * 8), boff = lds_byte(wc * 32 + fr, fq * 8);
#define PG8_SA(b, h) (((b) * 2 + (h)) * HTB)
#define PG8_SB(b, h) ((4 + (b) * 2 + (h)) * HTB)
#define PG8_STAGE(bufoff, gbase, voff) do { _Pragma("unroll") for (int _i = 0; _i < 2; ++_i) \
        __builtin_amdgcn_global_load_lds((const unsigned*)((const char*)(gbase) + (voff)[_i]), (LAS unsigned*)(lds + (bufoff) + ldsw + _i * 8192), 16, 0, 0); } while (0)
#define PG8_LDA(dst, b, h) do { _Pragma("unroll") for (int m = 0; m < 4; ++m) _Pragma("unroll") for (int k = 0; k < 2; ++k) dst[m][k] = *(const LAS bf16x8*)(lds + PG8_SA(b, h) + aoff + m * 2048 + k * 1024); } while (0)
#define PG8_LDB(dst, b, h) do { _Pragma("unroll") for (int n = 0; n < 2; ++n) _Pragma("unroll") for (int k = 0; k < 2; ++k) dst[n][k] = *(const LAS bf16x8*)(lds + PG8_SB(b, h) + boff + n * 2048 + k * 1024); } while (0)
#define PG8_MMA(ai, bj, At, Bt) do { __builtin_amdgcn_s_setprio(1); _Pragma("unroll") for (int m = 0; m < 4; ++m) _Pragma("unroll") for (int n = 0; n < 2; ++n) _Pragma("unroll") for (int k = 0; k < 2; ++k) \
        acc[ai][bj][m][n] = __builtin_amdgcn_mfma_f32_16x16x32_bf16(Bt[n][k], At[m][k], acc[ai][bj][m][n], 0, 0, 0); __builtin_amdgcn_s_setprio(0); } while (0)
#define PG8_WAIT_V(n) asm volatile("s_waitcnt vmcnt(" #n ")" ::: "memory")
#define PG8_WAIT_L(n) asm volatile("s_waitcnt lgkmcnt(" #n ")" ::: "memory")
#define PG8_BAR __builtin_amdgcn_s_barrier()
#define PG8_SCHED __builtin_amdgcn_sched_barrier(0)
    Unit cur, nxt; int ui = 0;
    if (!S.next(0, cur)) return;
    f32x4 acc[2][2][4][2];
#pragma unroll
    for (int a = 0; a < 2; ++a)
#pragma unroll
        for (int b = 0; b < 2; ++b)
#pragma unroll
            for (int m = 0; m < 4; ++m)
#pragma unroll
                for (int n = 0; n < 2; ++n) acc[a][b][m][n] = (f32x4){0.f, 0.f, 0.f, 0.f};
    bf16x8 At[4][2], B0[2][2], B1[2][2];
    const char* cA = (const char*)g.A + (size_t)cur.pm * tstepA + (size_t)E.a_off(cur.pn) * 2 + (size_t)cur.kt0 * kstep; const char* cB = (const char*)g.Bt + (size_t)cur.pn * tstepB + (size_t)cur.kt0 * kstep;
    PG8_STAGE(PG8_SB(0, 0), cB, voffB); PG8_STAGE(PG8_SB(0, 1), cB + hstepB, voffB); PG8_STAGE(PG8_SA(0, 0), cA, voffA); PG8_STAGE(PG8_SA(0, 1), cA + hstepA, voffA);
    if (wr == 1) PG8_BAR;
    PG8_WAIT_V(2); PG8_BAR;
    PG8_STAGE(PG8_SB(1, 0), cB + kstep, voffB); PG8_STAGE(PG8_SA(1, 0), cA + kstep, voffA); PG8_STAGE(PG8_SB(1, 1), cB + hstepB + kstep, voffB);
    PG8_WAIT_V(6); PG8_BAR;
    for (;;) {
        const bool has_next = S.next(ui + 1, nxt);
        const char* nA = has_next ? (const char*)g.A + (size_t)nxt.pm * tstepA + (size_t)E.a_off(nxt.pn) * 2 + (size_t)nxt.kt0 * kstep : cA; const char* nB = has_next ? (const char*)g.Bt + (size_t)nxt.pn * tstepB + (size_t)nxt.kt0 * kstep : cB;
        const int nt = cur.nkt;
        asm volatile(".p2align 6");
        for (int t = 0; t < nt; t += 2) {
            const bool last = (t == nt - 2);
            const char* a1 = cA + (size_t)(t + 1) * kstep;
            const char* a2 = last ? nA : cA + (size_t)(t + 2) * kstep; const char* b2 = last ? nB : cB + (size_t)(t + 2) * kstep;
            const char* a3 = a2 + kstep; const char* b3 = b2 + kstep;
            PG8_LDB(B0, 0, 0); PG8_LDB(B1, 0, 1); PG8_SCHED; PG8_LDA(At, 0, 0); PG8_STAGE(PG8_SA(1, 1), a1 + hstepA, voffA);
            PG8_WAIT_V(8); PG8_WAIT_L(0); PG8_BAR; PG8_MMA(0, 0, At, B0); PG8_MMA(0, 1, At, B1); PG8_BAR; PG8_SCHED;
            PG8_LDA(At, 0, 1); PG8_STAGE(PG8_SB(0, 0), b2, voffB); PG8_STAGE(PG8_SB(0, 1), b2 + hstepB, voffB); PG8_STAGE(PG8_SA(0, 0), a2, voffA);
            PG8_WAIT_V(8); PG8_WAIT_L(0); PG8_BAR; PG8_MMA(1, 0, At, B0); PG8_MMA(1, 1, At, B1); PG8_BAR; PG8_SCHED;
            PG8_LDB(B0, 1, 0); PG8_LDB(B1, 1, 1); PG8_SCHED; PG8_LDA(At, 1, 0); PG8_STAGE(PG8_SA(0, 1), a2 + hstepA, voffA);
            PG8_WAIT_V(8); PG8_WAIT_L(0); PG8_BAR; PG8_MMA(0, 0, At, B0); PG8_MMA(0, 1, At, B1); PG8_BAR; PG8_SCHED;
            PG8_LDA(At, 1, 1); PG8_STAGE(PG8_SB(1, 0), b3, voffB); PG8_STAGE(PG8_SB(1, 1), b3 + hstepB, voffB); PG8_STAGE(PG8_SA(1, 0), a3, voffA);
            PG8_WAIT_V(8); PG8_WAIT_L(0); PG8_BAR; PG8_MMA(1, 0, At, B0); PG8_MMA(1, 1, At, B1); PG8_BAR; PG8_SCHED;
        }
        if constexpr (ALIGN_EPI) { if (wr == 0) PG8_BAR; }
        E(acc, cur, wr, wc, fr, fq);
        if (!has_next) break;
#pragma unroll
        for (int a = 0; a < 2; ++a)
#pragma unroll
            for (int b = 0; b < 2; ++b)
#pragma unroll
                for (int m = 0; m < 4; ++m)
#pragma unroll
                    for (int n = 0; n < 2; ++n) acc[a][b][m][n] = (f32x4){0.f, 0.f, 0.f, 0.f};
        cur = nxt; cA = nA; cB = nB; ++ui;
        if constexpr (ALIGN_EPI) { if (wr == 1) PG8_BAR; }
    }
    PG8_WAIT_V(0);
    if constexpr (!ALIGN_EPI) { if (wr == 0) PG8_BAR; }
    PG8_BAR;
#undef PG8_SA
#undef PG8_SB
#undef PG8_STAGE
#undef PG8_LDA
#undef PG8_LDB
#undef PG8_MMA
#undef PG8_WAIT_V
#undef PG8_WAIT_L
#undef PG8_BAR
#undef PG8_SCHED
}

#ifndef EPI_SC1
#define EPI_SC1 0
#endif
__device__ __forceinline__ void st16(void* p, u32x4 w) {
#if EPI_SC1
    asm volatile("global_store_dwordx4 %0, %1, off sc1\n\ts_nop 1" :: "v"(p), "v"(w) : "memory");
#else
    *(u32x4*)p = w;
#endif
}
struct EpiStore {
    bf16_t* O; int ldc; float* ssq0; float* ssq1; int split0, split1; int a_grp_tiles, a_grp_off;
    __device__ __forceinline__ int a_off(int pn) const { return a_grp_tiles ? (pn / a_grp_tiles) * a_grp_off : 0; }
    __device__ __forceinline__ void operator()(const f32x4 (&acc)[2][2][4][2], const Unit& u, int wr, int wc, int fr, int fq) const {
        const int row0 = u.pm * BM + wr * 64 + fr, col0 = u.pn * BM + wc * 32 + 8 * fq;
        float* ssq = u.pn < split0 ? ssq0 : (u.pn < split1 ? ssq1 : nullptr);
#pragma unroll
        for (int ai = 0; ai < 2; ++ai)
#pragma unroll
            for (int m = 0; m < 4; ++m) { const int row = row0 + ai * HALF + m * 16; bf16_t* rowp = O + (size_t)row * ldc + col0; float s = 0.f;
#pragma unroll
                for (int bj = 0; bj < 2; ++bj) { const f32x4 v0 = acc[ai][bj][m][0], v1 = acc[ai][bj][m][1];
                    s += (v0[0] * v0[0] + v0[1] * v0[1]) + (v0[2] * v0[2] + v0[3] * v0[3]) + (v1[0] * v1[0] + v1[1] * v1[1]) + (v1[2] * v1[2] + v1[3] * v1[3]);
                    u32x4 w; w.x = cvt_pk_bf16(v0[0], v0[1]); w.y = cvt_pk_bf16(v0[2], v0[3]); w.z = cvt_pk_bf16(v1[0], v1[1]); w.w = cvt_pk_bf16(v1[2], v1[3]);
                    st16(rowp + bj * HALF, w); }
                if (ssq) { const int ln_ = (fq << 4) | fr; s += __int_as_float(__builtin_amdgcn_ds_bpermute((ln_ ^ 16) << 2, __float_as_int(s))); s += __int_as_float(__builtin_amdgcn_ds_bpermute((ln_ ^ 32) << 2, __float_as_int(s))); if (fq == 0) ssq[(size_t)row * 8 + (u.pn & 1) * 4 + wc] = s; } }
    }
};
struct EpiY {
    bf16_t* O; float* Yp; int ldc, row_split, nsplit_rows; int a_grp_tiles, a_grp_off;
    __device__ __forceinline__ int a_off(int pn) const { return a_grp_tiles ? (pn / a_grp_tiles) * a_grp_off : 0; }
    __device__ __forceinline__ void operator()(const f32x4 (&acc)[2][2][4][2], const Unit& u, int wr, int wc, int fr, int fq) const {
        const int row0 = u.pm * BM + wr * 64 + fr, col0 = u.pn * BM + wc * 32 + 8 * fq;
        if (u.part < 0) {
#pragma unroll
            for (int ai = 0; ai < 2; ++ai)
#pragma unroll
                for (int m = 0; m < 4; ++m) { bf16_t* rowp = O + (size_t)(row0 + ai * HALF + m * 16) * ldc + col0;
#pragma unroll
                    for (int bj = 0; bj < 2; ++bj) { const f32x4 v0 = acc[ai][bj][m][0], v1 = acc[ai][bj][m][1];
                        u32x4 w; w.x = cvt_pk_bf16(v0[0], v0[1]); w.y = cvt_pk_bf16(v0[2], v0[3]); w.z = cvt_pk_bf16(v1[0], v1[1]); w.w = cvt_pk_bf16(v1[2], v1[3]);
                        st16(rowp + bj * HALF, w); } }
        } else { float* slab = Yp + (size_t)u.part * nsplit_rows * ldc;
#pragma unroll
            for (int ai = 0; ai < 2; ++ai)
#pragma unroll
                for (int m = 0; m < 4; ++m) { float* rowp = slab + (size_t)(row0 + ai * HALF + m * 16 - row_split) * ldc + col0;
#pragma unroll
                    for (int bj = 0; bj < 2; ++bj) { *(f32x4*)(rowp + bj * HALF) = acc[ai][bj][m][0]; *(f32x4*)(rowp + bj * HALF + 4) = acc[ai][bj][m][1]; } }
        }
    }
};
struct EpiSwiGLU {
    bf16_t* O; int ldc;
    __device__ __forceinline__ int a_off(int) const { return 0; }
    __device__ __forceinline__ void operator()(const f32x4 (&acc)[2][2][4][2], const Unit& u, int wr, int wc, int fr, int fq) const {
        const int row0 = u.pm * BM + wr * 64 + fr, col0 = u.pn * HALF + wc * 32 + 8 * fq;
#pragma unroll
        for (int ai = 0; ai < 2; ++ai)
#pragma unroll
            for (int m = 0; m < 4; ++m) { const int row = row0 + ai * HALF + m * 16; float gv[8];
#pragma unroll
                for (int n = 0; n < 2; ++n)
#pragma unroll
                    for (int j = 0; j < 4; ++j) { const float a = acc[ai][0][m][n][j], b = acc[ai][1][m][n][j]; gv[n * 4 + j] = a * __builtin_amdgcn_rcpf(1.f + __expf(-a)) * b; }
                u32x4 w; w.x = cvt_pk_bf16(gv[0], gv[1]); w.y = cvt_pk_bf16(gv[2], gv[3]); w.z = cvt_pk_bf16(gv[4], gv[5]); w.w = cvt_pk_bf16(gv[6], gv[7]);
                st16(O + (size_t)row * ldc + col0, w); }
    }
};
struct EpiUp {
    bf16_t* Q; bf16_t* KV; const float* ssq_q; const float* ssq_kv;
    __device__ __forceinline__ int a_off(int pn) const { return pn < NQ / BM ? 0 : QL; }
    __device__ __forceinline__ void operator()(const f32x4 (&acc)[2][2][4][2], const Unit& u, int wr, int wc, int fr, int fq) const {
        const bool isq = u.pn < NQ / BM; const int ldc = isq ? NQ : NKV; bf16_t* O = isq ? Q : KV; const float* ssq = isq ? ssq_q : ssq_kv;
        const int row0 = u.pm * BM + wr * 64 + fr, col0 = (isq ? u.pn : u.pn - NQ / BM) * BM + wc * 32 + 8 * fq;
        float rs[2][4];
#pragma unroll
        for (int ai = 0; ai < 2; ++ai)
#pragma unroll
            for (int m = 0; m < 4; ++m) { const int row = row0 + ai * HALF + m * 16;
                const f32x4 sa = *(const f32x4*)(ssq + (size_t)row * 8), sb = *(const f32x4*)(ssq + (size_t)row * 8 + 4);
                rs[ai][m] = __builtin_amdgcn_rsqf((((sa[0] + sa[1]) + (sa[2] + sa[3])) + ((sb[0] + sb[1]) + (sb[2] + sb[3]))) * (1.f / 512.f) + RMS_EPS); }
#pragma unroll
        for (int ai = 0; ai < 2; ++ai)
#pragma unroll
            for (int m = 0; m < 4; ++m) { const int row = row0 + ai * HALF + m * 16; bf16_t* rowp = O + (size_t)row * ldc + col0;
#pragma unroll
                for (int bj = 0; bj < 2; ++bj) { const f32x4 v0 = acc[ai][bj][m][0] * rs[ai][m], v1 = acc[ai][bj][m][1] * rs[ai][m];
                    u32x4 w; w.x = cvt_pk_bf16(v0[0], v0[1]); w.y = cvt_pk_bf16(v0[2], v0[3]); w.z = cvt_pk_bf16(v1[0], v1[1]); w.w = cvt_pk_bf16(v1[2], v1[3]);
                    st16(rowp + bj * HALF, w); } }
    }
};
}
namespace att {
constexpr int QBLK = 32, KVBLK = 64;
constexpr float SCALE = 0.07216878364870322f;
constexpr float THR = 8.f;
#ifndef ATT_SDEPTH
#define ATT_SDEPTH 1
#endif
constexpr int SDEPTH = ATT_SDEPTH;
constexpr int SHM_V = KVBLK * VD * 2, SHM_K = KVBLK * QKD * 2;
constexpr int LDS_BYTES = 2 * SHM_V + 2 * SHM_K + NWAVES * 64 * 4;
#define KOFF(row, ch) ((row) * 384 + ((((ch) ^ (((row) >> 1) & 7))) << 4))
#define SBAR() __builtin_amdgcn_sched_barrier(0)
__device__ __forceinline__ int crow(int r, int hi) { return (r & 3) + 8 * (r >> 2) + 4 * hi; }

__device__ __forceinline__ void finishSM(f32x16& p0, f32x16& p1, float alpha, float& l_reg, bf16x8& pa0, bf16x8& pa1, bf16x8& pa2, bf16x8& pa3) {
#pragma unroll
    for (int r = 0; r < 16; ++r) p1[r] = __builtin_amdgcn_exp2f(p1[r]);
    float ps = 0;
#pragma unroll
    for (int r = 0; r < 16; ++r) ps += p0[r];
#pragma unroll
    for (int r = 0; r < 16; ++r) ps += p1[r];
    { auto rr = __builtin_amdgcn_permlane32_swap(__float_as_uint(ps), __float_as_uint(ps), false, false);
      ps = __uint_as_float(rr[0]) + __uint_as_float(rr[1]); }
    l_reg = l_reg * alpha + ps;
#define PK8(P, BASE, OUT) do { u32x4 w = {cvt_pk_bf16(P[BASE + 0], P[BASE + 1]), cvt_pk_bf16(P[BASE + 2], P[BASE + 3]), cvt_pk_bf16(P[BASE + 4], P[BASE + 5]), cvt_pk_bf16(P[BASE + 6], P[BASE + 7])}; \
    OUT = *reinterpret_cast<bf16x8*>(&w); } while (0)
    PK8(p0, 0, pa0); PK8(p0, 8, pa1); PK8(p1, 0, pa2); PK8(p1, 8, pa3);
#undef PK8
}
__device__ __forceinline__ int v_st(int k, int c) { const int kk = (k & ~0xC) | ((k & 4) << 1) | ((k & 8) >> 1); return ((kk >> 3) * 4 + (c >> 5)) * 512 + ((kk & 7) * 32 + (c & 31)) * 2; }
__device__ __forceinline__ int v_rd_base(int lane) { return ((lane & 3) << 3) | (((lane >> 2) & 3) << 6) | (((lane >> 4) & 1) << 5) | (((lane >> 5) & 1) << 8); }
constexpr int v_rd_off(int d0, int ks, int half) { return d0 * 512 + ks * 4096 + half * 2048; }
template <int OFF> __device__ __forceinline__ s16x4 tr_read(int vb) {
    s16x4 r; asm volatile("ds_read_b64_tr_b16 %0, %1 offset:%2" : "=&v"(r) : "v"(vb), "i"(OFF) : "memory"); return r;
}
template <int D0> __device__ __forceinline__ void pv_one(f32x16& od, int vb, bf16x8 pa0, bf16x8 pa1, bf16x8 pa2, bf16x8 pa3) {
    const s16x4 l0 = tr_read<v_rd_off(D0, 0, 0)>(vb), h0 = tr_read<v_rd_off(D0, 0, 1)>(vb), l1 = tr_read<v_rd_off(D0, 1, 0)>(vb), h1 = tr_read<v_rd_off(D0, 1, 1)>(vb);
    const s16x4 l2 = tr_read<v_rd_off(D0, 2, 0)>(vb), h2 = tr_read<v_rd_off(D0, 2, 1)>(vb), l3 = tr_read<v_rd_off(D0, 3, 0)>(vb), h3 = tr_read<v_rd_off(D0, 3, 1)>(vb);
    asm volatile("s_waitcnt lgkmcnt(0)" ::: "memory"); SBAR();
#define PK(L, H) (bf16x8){L[0], L[1], L[2], L[3], H[0], H[1], H[2], H[3]}
    od = __builtin_amdgcn_mfma_f32_32x32x16_bf16(pa0, PK(l0, h0), od, 0, 0, 0);
    od = __builtin_amdgcn_mfma_f32_32x32x16_bf16(pa1, PK(l1, h1), od, 0, 0, 0);
    od = __builtin_amdgcn_mfma_f32_32x32x16_bf16(pa2, PK(l2, h2), od, 0, 0, 0);
    od = __builtin_amdgcn_mfma_f32_32x32x16_bf16(pa3, PK(l3, h3), od, 0, 0, 0);
#undef PK
}
__device__ __forceinline__ void pv_d0(f32x16* o, int vb, bf16x8 pa0, bf16x8 pa1, bf16x8 pa2, bf16x8 pa3) {
    pv_one<0>(o[0], vb, pa0, pa1, pa2, pa3); pv_one<1>(o[1], vb, pa0, pa1, pa2, pa3); pv_one<2>(o[2], vb, pa0, pa1, pa2, pa3); pv_one<3>(o[3], vb, pa0, pa1, pa2, pa3);
}
__device__ __forceinline__ void rope8(bf16x8& x1, bf16x8& x2, const float* tab) {
    u32x4 a = *reinterpret_cast<u32x4*>(&x1), b = *reinterpret_cast<u32x4*>(&x2), oa, ob;
#pragma unroll
    for (int w = 0; w < 4; ++w) {
        const f32x4 cs = *reinterpret_cast<const f32x4*>(tab + 4 * w);
        const float a0 = bf_lo(a[w]), a1 = bf_hi(a[w]), b0 = bf_lo(b[w]), b1 = bf_hi(b[w]);
        oa[w] = cvt_pk_bf16(a0 * cs[0] - b0 * cs[1], a1 * cs[2] - b1 * cs[3]);
        ob[w] = cvt_pk_bf16(b0 * cs[0] + a0 * cs[1], b1 * cs[2] + a1 * cs[3]);
    }
    x1 = *reinterpret_cast<bf16x8*>(&oa); x2 = *reinterpret_cast<bf16x8*>(&ob);
}

struct Unit { const bf16_t* Qb; const bf16_t* KVh; bf16_t* Ob; int kb_lat, nt_lat, kb_ctx, NT, qpos0; };

constexpr int SLOT = 40960, KR_OFF = 16384, V_OFF = 24576, LDS2_BYTES = 3 * SLOT + NWAVES * 64 * 4;
constexpr float THRL = THR * 1.4426950408889634f;
#ifndef ATT_MARGIN
#define ATT_MARGIN 100.f
#endif
__device__ __forceinline__ void qkt2n(f32x16& p0, f32x16& p1, LAS const char* lds, int kn, int kr, const bf16x8* qr, const f32x16& negm) {
#pragma unroll
    for (int d0 = 0; d0 < 8; ++d0) { const int a = kn ^ (d0 << 5);
        const bf16x8 b0 = *reinterpret_cast<LAS const bf16x8*>(lds + a), b1 = *reinterpret_cast<LAS const bf16x8*>(lds + a + 32 * 256);
        if (d0 == 0) { p0 = __builtin_amdgcn_mfma_f32_32x32x16_bf16(b0, qr[0], negm, 0, 0, 0); p1 = __builtin_amdgcn_mfma_f32_32x32x16_bf16(b1, qr[0], negm, 0, 0, 0); }
        else { p0 = __builtin_amdgcn_mfma_f32_32x32x16_bf16(b0, qr[d0], p0, 0, 0, 0); p1 = __builtin_amdgcn_mfma_f32_32x32x16_bf16(b1, qr[d0], p1, 0, 0, 0); } }
#pragma unroll
    for (int d0 = 0; d0 < 4; ++d0) { const int a = kr ^ (d0 << 5);
        const bf16x8 b0 = *reinterpret_cast<LAS const bf16x8*>(lds + a), b1 = *reinterpret_cast<LAS const bf16x8*>(lds + a + 32 * 128);
        p0 = __builtin_amdgcn_mfma_f32_32x32x16_bf16(b0, qr[8 + d0], p0, 0, 0, 0); p1 = __builtin_amdgcn_mfma_f32_32x32x16_bf16(b1, qr[8 + d0], p1, 0, 0, 0); }
}
template <bool FIRST>
__device__ __forceinline__ void partialSM2(f32x16& p0, f32x16& p1, float& m_reg, f32x16& negm, float& alpha, float margin = 0.f) {
    float pmax = p0[0];
#pragma unroll
    for (int r = 1; r < 16; ++r) pmax = fmaxf(pmax, p0[r]);
#pragma unroll
    for (int r = 0; r < 16; ++r) pmax = fmaxf(pmax, p1[r]);
    { auto rr = __builtin_amdgcn_permlane32_swap(__float_as_uint(pmax), __float_as_uint(pmax), false, false);
      pmax = fmaxf(__uint_as_float(rr[0]), __uint_as_float(rr[1])); }
    alpha = 1.f;
    if (FIRST || !__builtin_expect(__all(pmax <= THRL), 1)) {
        const float delta = FIRST ? pmax + margin : fmaxf(pmax, 0.f);
        if (!FIRST) alpha = __builtin_amdgcn_exp2f(-delta);
        m_reg += delta;
#pragma unroll
        for (int r = 0; r < 16; ++r) { p0[r] -= delta; p1[r] -= delta; negm[r] = -m_reg; }
    }
#pragma unroll
    for (int r = 0; r < 16; ++r) p0[r] = __builtin_amdgcn_exp2f(p0[r]);
}
__device__ __forceinline__ void exp_half(f32x16& p0) {
#pragma unroll
    for (int r = 0; r < 16; ++r) p0[r] = __builtin_amdgcn_exp2f(p0[r]);
}
template <bool FIXM>
__device__ __forceinline__ void attn_unit6(const Unit& U, const bf16_t* __restrict__ KR, const float* __restrict__ ropetab, LAS unsigned char* lds) {
    int tid = threadIdx.x; asm volatile("" : "+v"(tid));
    const int wid = __builtin_amdgcn_readfirstlane(tid >> 6), lane = tid & 63, r32 = lane & 31, hi = lane >> 5;
    LAS float* wsf = (LAS float*)(lds + 3 * SLOT) + wid * 64; LAS float* li_l = wsf; LAS float* al_l = wsf + 32;
    float m_reg = 0.f, l_reg = 0; f32x16 o[4] = {}; bf16x8 qr[12]; f32x16 negm = {};
    const bf16_t* Qw = U.Qb + (size_t)(wid * QBLK + r32) * NQ + hi * 8;
#pragma unroll
    for (int d0 = 0; d0 < 12; ++d0) qr[d0] = *reinterpret_cast<const bf16x8*>(Qw + d0 * 16);
    if (U.qpos0 >= 0) { const int t = U.qpos0 + wid * QBLK + r32, pr = t >> 6, pc = t & 63;
        rope8(qr[8], qr[9], ropetab + (pr * 16 + hi * 8) * 2); rope8(qr[10], qr[11], ropetab + (pc * 16 + hi * 8) * 2); }
    unsigned von[2], vov[2], vor;
#pragma unroll
    for (int i = 0; i < 2; ++i) { const int p = (wid * 2 + i) * 64 + lane;
        { const int row = p >> 4, c = (p & 15) ^ (row & 15); von[i] = (unsigned)(row * (NKV * 2) + c * 16); }
        { const int sub = p >> 5, within = p & 31, k = (sub >> 2) * 8 + (within >> 2), c = (sub & 3) * 32 + (within & 3) * 8;     vov[i] = (unsigned)(k * (NKV * 2) + NOPE * 2 + c * 2); } }
    { const int p = wid * 64 + lane, row = p >> 3, c = (p & 7) ^ ((row >> 1) & 7); vor = (unsigned)(row * (ROPED * 2) + c * 16); }
    const int kn0 = r32 * 256 + ((hi ^ (r32 & 15)) << 4), kr0 = KR_OFF + r32 * 128 + ((hi ^ ((r32 >> 1) & 7)) << 4), vb0 = (int)(uintptr_t)lds + V_OFF + v_rd_base(lane);
    const int nt_lat = U.nt_lat, kb_lat = U.kb_lat, kb_ctx = U.kb_ctx - 64 * nt_lat, NT = U.NT;
    const bf16_t* KVh = U.KVh;
    const unsigned ldsw2 = (unsigned)wid * 2048u, ldsw1 = (unsigned)wid * 1024u;
#define KROW(j) (((j) < nt_lat ? kb_lat : kb_ctx) + 64 * (j))
#define DMA(j, so) do { const size_t _k = (size_t)KROW(j); const char* _kv = (const char*)KVh + _k * (NKV * 2); const char* _kr = (const char*)KR + _k * (ROPED * 2); \
    __builtin_amdgcn_global_load_lds((const unsigned*)(_kv + von[0]), (LAS unsigned*)(lds + (so) + ldsw2), 16, 0, 0); \
    __builtin_amdgcn_global_load_lds((const unsigned*)(_kv + von[1]), (LAS unsigned*)(lds + (so) + ldsw2 + 1024), 16, 0, 0); \
    __builtin_amdgcn_global_load_lds((const unsigned*)(_kr + vor), (LAS unsigned*)(lds + (so) + KR_OFF + ldsw1), 16, 0, 0); \
    __builtin_amdgcn_global_load_lds((const unsigned*)(_kv + vov[0]), (LAS unsigned*)(lds + (so) + V_OFF + ldsw2), 16, 0, 0); \
    __builtin_amdgcn_global_load_lds((const unsigned*)(_kv + vov[1]), (LAS unsigned*)(lds + (so) + V_OFF + ldsw2 + 1024), 16, 0, 0); } while (0)
#define TILE_BAR() asm volatile("s_waitcnt vmcnt(0) lgkmcnt(0)\n\ts_barrier" ::: "memory")
#define RESC2(a) do { if (__any((a) < 1.f)) { if (hi == 0) al_l[r32] = (a); asm volatile("s_waitcnt lgkmcnt(0)" ::: "memory"); \
    _Pragma("unroll") for (int d = 0; d < 4; ++d) _Pragma("unroll") for (int r = 0; r < 16; ++r) o[d][r] *= al_l[crow(r, hi)]; } } while (0)
    f32x16 pA0, pA1, pB0, pB1; float alA, alB; bf16x8 pa0, pa1, pa2, pa3;
    int s_prev = 0, s_cur = SLOT, s_next = 2 * SLOT;
    DMA(0, 0); DMA(1, SLOT); TILE_BAR();
    qkt2n(pA0, pA1, (LAS const char*)lds, kn0, kr0, qr, negm); partialSM2<true>(pA0, pA1, m_reg, negm, alA, FIXM ? ATT_MARGIN : 0.f);
    asm volatile(".p2align 6");
    for (int j = 1; j + 1 < NT; j += 2) {
        DMA(j + 1, s_next); SBAR();
        qkt2n(pB0, pB1, (LAS const char*)lds, kn0 + s_cur, kr0 + s_cur, qr, negm);
        finishSM(pA0, pA1, alA, l_reg, pa0, pa1, pa2, pa3); SBAR();
        pv_d0(o, vb0 + s_prev, pa0, pa1, pa2, pa3); if (FIXM) { alB = 1.f; exp_half(pB0); } else partialSM2<false>(pB0, pB1, m_reg, negm, alB);
        if (!FIXM) RESC2(alB); TILE_BAR();
        { const int t = s_prev; s_prev = s_cur; s_cur = s_next; s_next = t; }
        if (j + 2 < NT) DMA(j + 2, s_next); SBAR();
        qkt2n(pA0, pA1, (LAS const char*)lds, kn0 + s_cur, kr0 + s_cur, qr, negm);
        finishSM(pB0, pB1, alB, l_reg, pa0, pa1, pa2, pa3); SBAR();
        pv_d0(o, vb0 + s_prev, pa0, pa1, pa2, pa3); if (FIXM) { alA = 1.f; exp_half(pA0); } else partialSM2<false>(pA0, pA1, m_reg, negm, alA);
        if (!FIXM) RESC2(alA); TILE_BAR();
        { const int t = s_prev; s_prev = s_cur; s_cur = s_next; s_next = t; }
    }
    SBAR(); qkt2n(pB0, pB1, (LAS const char*)lds, kn0 + s_cur, kr0 + s_cur, qr, negm);
    finishSM(pA0, pA1, alA, l_reg, pa0, pa1, pa2, pa3); SBAR();
    pv_d0(o, vb0 + s_prev, pa0, pa1, pa2, pa3); if (FIXM) { alB = 1.f; exp_half(pB0); } else partialSM2<false>(pB0, pB1, m_reg, negm, alB);
    if (!FIXM) RESC2(alB);
    finishSM(pB0, pB1, alB, l_reg, pa0, pa1, pa2, pa3); SBAR();
    pv_d0(o, vb0 + s_cur, pa0, pa1, pa2, pa3);
    if (FIXM) { const bool okl = (l_reg > 0.f) && (l_reg < 1e30f); const bool okw = __all(okl); if (lane == 0) ((LAS unsigned*)(lds + LDS2_BYTES))[wid] = okw ? 1u : 0u; }
    if (hi == 0) li_l[r32] = l_reg; asm volatile("s_waitcnt lgkmcnt(0)" ::: "memory");
    float rli[16];
#pragma unroll
    for (int r = 0; r < 16; ++r) rli[r] = __builtin_amdgcn_rcpf(li_l[crow(r, hi)]);
    asm volatile("s_waitcnt lgkmcnt(0)\n\ts_barrier" ::: "memory");
    { constexpr int OP = 272; LAS unsigned char* st = lds + wid * (32 * OP);
#pragma unroll
      for (int r = 0; r < 16; ++r) { const int orow = crow(r, hi);
#pragma unroll
        for (int d0 = 0; d0 < 4; ++d0) *(LAS bf16_t*)(st + orow * OP + (d0 * 32 + r32) * 2) = (bf16_t)(cvt_pk_bf16(o[d0][r] * rli[r], 0.f) & 0xffffu); }
      asm volatile("s_waitcnt lgkmcnt(0)" ::: "memory");
      bf16_t* Ow = U.Ob + (size_t)(wid * QBLK) * D;
#pragma unroll
      for (int i = 0; i < 8; ++i) { const int row = (lane >> 4) + 4 * i, ch = lane & 15;
        const u32x4 w = *(const LAS u32x4*)(st + row * OP + ch * 16); *(u32x4*)(Ow + (size_t)row * D + ch * 8) = w; } }
    TILE_BAR();
#undef KROW
#undef DMA
#undef TILE_BAR
#undef RESC2
}


typedef float f32x4_t __attribute__((ext_vector_type(4)));
__device__ __forceinline__ void attn_unit7(const Unit& U, const bf16_t* __restrict__ KR, const float* __restrict__ ropetab, LAS unsigned char* lds) {
    int tid = threadIdx.x; asm volatile("" : "+v"(tid));
    const int wid = __builtin_amdgcn_readfirstlane(tid >> 6), lane = tid & 63, c16 = lane & 15, g = lane >> 4;
    f32x4_t o[8][2]; bf16x8 qr[2][6]; f32x4_t negm[2]; float l_reg[2] = {0.f, 0.f};
#pragma unroll
    for (int t = 0; t < 8; ++t)
#pragma unroll
        for (int u = 0; u < 2; ++u) o[t][u] = (f32x4_t){0.f, 0.f, 0.f, 0.f};
    const int xg = g < 2 ? g : g + 2;
#pragma unroll
    for (int u = 0; u < 2; ++u) { const bf16_t* Qw = U.Qb + (size_t)(wid * QBLK + 16 * u + c16) * NQ;
#pragma unroll
        for (int s = 0; s < 4; ++s) qr[u][s] = *reinterpret_cast<const bf16x8*>(Qw + 32 * s + 8 * g);
        qr[u][4] = *reinterpret_cast<const bf16x8*>(Qw + NOPE + 8 * xg); qr[u][5] = *reinterpret_cast<const bf16x8*>(Qw + NOPE + 8 * (xg + 2));
        if (U.qpos0 >= 0) { const int t = U.qpos0 + wid * QBLK + 16 * u + c16, pos = g < 2 ? (t >> 6) : (t & 63); rope8(qr[u][4], qr[u][5], ropetab + (pos * 16 + (g & 1) * 8) * 2); } }
    unsigned von[2], vov[2], vor;
#pragma unroll
    for (int i = 0; i < 2; ++i) { const int p = (wid * 2 + i) * 64 + lane;
        { const int row = p >> 4, c = (p & 15) ^ (row & 15); von[i] = (unsigned)(row * (NKV * 2) + c * 16); }
        { const int sub = p >> 5, within = p & 31, k = (sub >> 2) * 8 + (within >> 2), c = (sub & 3) * 32 + (((within & 3) * 8) ^ (((within >> 4) & 1) << 4)); vov[i] = (unsigned)(k * (NKV * 2) + NOPE * 2 + c * 2); } }
    { const int p = wid * 64 + lane, row = p >> 3, c = (p & 7) ^ ((row >> 1) & 7); vor = (unsigned)(row * (ROPED * 2) + c * 16); }
    const int kn0 = c16 * 256 + ((g ^ c16) << 4), kr0 = KR_OFF + c16 * 128 + ((xg ^ ((c16 >> 1) & 7)) << 4);
    const int vbe = (int)(uintptr_t)lds + V_OFF + (g >> 1) * 2048 + (4 * (g & 1) + (c16 >> 2)) * 64 + 32 * (g & 1) + 8 * (c16 & 3), vbo = vbe ^ 32;
    const int nt_lat = U.nt_lat, kb_lat = U.kb_lat, kb_ctx = U.kb_ctx - 64 * nt_lat, NT = U.NT;
    const bf16_t* KVh = U.KVh;
    const unsigned ldsw2 = (unsigned)wid * 2048u, ldsw1 = (unsigned)wid * 1024u;
#define KROW(j) (((j) < nt_lat ? kb_lat : kb_ctx) + 64 * (j))
#define DMA(j, so) do { const size_t _k = (size_t)KROW(j); const char* _kv = (const char*)KVh + _k * (NKV * 2); const char* _kr = (const char*)KR + _k * (ROPED * 2); \
    __builtin_amdgcn_global_load_lds((const unsigned*)(_kv + von[0]), (LAS unsigned*)(lds + (so) + ldsw2), 16, 0, 0); \
    __builtin_amdgcn_global_load_lds((const unsigned*)(_kv + von[1]), (LAS unsigned*)(lds + (so) + ldsw2 + 1024), 16, 0, 0); \
    __builtin_amdgcn_global_load_lds((const unsigned*)(_kr + vor), (LAS unsigned*)(lds + (so) + KR_OFF + ldsw1), 16, 0, 0); \
    __builtin_amdgcn_global_load_lds((const unsigned*)(_kv + vov[0]), (LAS unsigned*)(lds + (so) + V_OFF + ldsw2), 16, 0, 0); \
    __builtin_amdgcn_global_load_lds((const unsigned*)(_kv + vov[1]), (LAS unsigned*)(lds + (so) + V_OFF + ldsw2 + 1024), 16, 0, 0); } while (0)
#define TILE_BAR() asm volatile("s_waitcnt vmcnt(0) lgkmcnt(0)\n\ts_barrier" ::: "memory")
#define XSH(x, m) __int_as_float(__builtin_amdgcn_ds_bpermute((lane ^ (m)) << 2, __float_as_int(x)))
#define MFMA16(A, B, C) __builtin_amdgcn_mfma_f32_16x16x32_bf16(A, B, C, 0, 0, 0)
#define KRD(dst, addr, off) asm volatile("ds_read_b128 %0, %1 offset:%2" : "=&v"(dst) : "v"(addr), "i"(off) : "memory")
#define KRD4(K, s, stp) do { const int _a = (s) < 4 ? (_kn ^ ((s) << 6)) : (_kr ^ (((s) - 4) << 5)); KRD(K[0], _a, 0); KRD(K[1], _a, (stp)); KRD(K[2], _a, 2 * (stp)); KRD(K[3], _a, 3 * (stp)); } while (0)
#define QKM(K, s) do { _Pragma("unroll") for (int a = 0; a < 4; ++a) _Pragma("unroll") for (int u = 0; u < 2; ++u) P_[u][a] = MFMA16(K[a], qr[u][s], (s) == 0 ? negm[u] : P_[u][a]); } while (0)
#define QK7(P, so) do { auto& P_ = P; const int _kn = (int)(uintptr_t)lds + kn0 + (so), _kr = (int)(uintptr_t)lds + kr0 + (so); bf16x8 ka[4], kb[4]; \
    KRD4(ka, 0, 4096); \
    KRD4(kb, 1, 4096); asm volatile("s_waitcnt lgkmcnt(4)" ::: "memory"); SBAR(); QKM(ka, 0); SBAR(); \
    KRD4(ka, 2, 4096); asm volatile("s_waitcnt lgkmcnt(4)" ::: "memory"); SBAR(); QKM(kb, 1); SBAR(); \
    KRD4(kb, 3, 4096); asm volatile("s_waitcnt lgkmcnt(4)" ::: "memory"); SBAR(); QKM(ka, 2); SBAR(); \
    KRD4(ka, 4, 2048); asm volatile("s_waitcnt lgkmcnt(4)" ::: "memory"); SBAR(); QKM(kb, 3); SBAR(); \
    KRD4(kb, 5, 2048); asm volatile("s_waitcnt lgkmcnt(4)" ::: "memory"); SBAR(); QKM(ka, 4); SBAR(); \
    asm volatile("s_waitcnt lgkmcnt(0)" ::: "memory"); SBAR(); QKM(kb, 5); } while (0)
#define EXPH7(P, A0) do { _Pragma("unroll") for (int u = 0; u < 2; ++u) _Pragma("unroll") for (int a = (A0); a < (A0) + 2; ++a) _Pragma("unroll") for (int r = 0; r < 4; ++r) P[u][a][r] = __builtin_amdgcn_exp2f(P[u][a][r]); } while (0)
#define FIN7(P) do { EXPH7(P, 2); \
    _Pragma("unroll") for (int u = 0; u < 2; ++u) { float ps = 0.f; _Pragma("unroll") for (int a = 0; a < 4; ++a) ps += (P[u][a][0] + P[u][a][1]) + (P[u][a][2] + P[u][a][3]); l_reg[u] += ps; \
        _Pragma("unroll") for (int ks = 0; ks < 2; ++ks) { u32x4 w = {cvt_pk_bf16(P[u][2 * ks][0], P[u][2 * ks][1]), cvt_pk_bf16(P[u][2 * ks][2], P[u][2 * ks][3]), \
            cvt_pk_bf16(P[u][2 * ks + 1][0], P[u][2 * ks + 1][1]), cvt_pk_bf16(P[u][2 * ks + 1][2], P[u][2 * ks + 1][3])}; pk[ks][u] = *reinterpret_cast<bf16x8*>(&w); } } } while (0)
#define TR7(dst, vb, a, t) asm volatile("ds_read_b64_tr_b16 %0, %1 offset:%2" : "=&v"(dst) : "v"(vb), "i"((a) * 4096 + ((t) >> 1) * 512) : "memory")
#define RD4(E, t) do { if ((t) & 1) { TR7(E[0], vb1_, 0, t); TR7(E[1], vb1_, 1, t); TR7(E[2], vb1_, 2, t); TR7(E[3], vb1_, 3, t); } else { TR7(E[0], vb0_, 0, t); TR7(E[1], vb0_, 1, t); TR7(E[2], vb0_, 2, t); TR7(E[3], vb0_, 3, t); } } while (0)
#define MM4(E, t) do { \
        const bf16x8 v0 = (bf16x8){E[0][0], E[0][1], E[0][2], E[0][3], E[1][0], E[1][1], E[1][2], E[1][3]}, v1 = (bf16x8){E[2][0], E[2][1], E[2][2], E[2][3], E[3][0], E[3][1], E[3][2], E[3][3]}; \
        o[t][0] = MFMA16(v0, pk[0][0], o[t][0]); o[t][1] = MFMA16(v0, pk[0][1], o[t][1]); o[t][0] = MFMA16(v1, pk[1][0], o[t][0]); o[t][1] = MFMA16(v1, pk[1][1], o[t][1]); } while (0)
#define PV7(so) do { const int vb0_ = vbe + (so), vb1_ = vbo + (so); s16x4 ea[4], eb[4]; \
        RD4(ea, 0); \
        RD4(eb, 1); asm volatile("s_waitcnt lgkmcnt(4)" ::: "memory"); SBAR(); MM4(ea, 0); SBAR(); \
        RD4(ea, 2); asm volatile("s_waitcnt lgkmcnt(4)" ::: "memory"); SBAR(); MM4(eb, 1); SBAR(); \
        RD4(eb, 3); asm volatile("s_waitcnt lgkmcnt(4)" ::: "memory"); SBAR(); MM4(ea, 2); SBAR(); \
        RD4(ea, 4); asm volatile("s_waitcnt lgkmcnt(4)" ::: "memory"); SBAR(); MM4(eb, 3); SBAR(); \
        RD4(eb, 5); asm volatile("s_waitcnt lgkmcnt(4)" ::: "memory"); SBAR(); MM4(ea, 4); SBAR(); \
        RD4(ea, 6); asm volatile("s_waitcnt lgkmcnt(4)" ::: "memory"); SBAR(); MM4(eb, 5); SBAR(); \
        RD4(eb, 7); asm volatile("s_waitcnt lgkmcnt(4)" ::: "memory"); SBAR(); MM4(ea, 6); SBAR(); \
        asm volatile("s_waitcnt lgkmcnt(0)" ::: "memory"); SBAR(); MM4(eb, 7); } while (0)
    f32x4_t pA[2][4]; bf16x8 pk[2][2];
    negm[0] = negm[1] = (f32x4_t){0.f, 0.f, 0.f, 0.f};
    int s_prev = 0, s_cur = SLOT, s_next = 2 * SLOT;
    DMA(0, 0); DMA(1, SLOT); TILE_BAR();
    QK7(pA, 0);
#pragma unroll
    for (int u = 0; u < 2; ++u) { float pmax = pA[u][0][0];
#pragma unroll
        for (int a = 0; a < 4; ++a)
#pragma unroll
            for (int r = 0; r < 4; ++r) pmax = fmaxf(pmax, pA[u][a][r]);
        pmax = fmaxf(pmax, XSH(pmax, 16)); pmax = fmaxf(pmax, XSH(pmax, 32));
        const float delta = pmax + ATT_MARGIN; negm[u] = (f32x4_t){-delta, -delta, -delta, -delta};
#pragma unroll
        for (int a = 0; a < 4; ++a)
#pragma unroll
            for (int r = 0; r < 4; ++r) pA[u][a][r] -= delta; }
    EXPH7(pA, 0);
    asm volatile(".p2align 6");
    for (int j = 1; j < NT; ++j) {
        if (j + 1 < NT) DMA(j + 1, s_next); SBAR();
        bf16x8 ka[4], kb[4]; s16x4 ea[4], eb[4];
        const int _kn = (int)(uintptr_t)lds + kn0 + s_cur, _kr = (int)(uintptr_t)lds + kr0 + s_cur, vb0_ = vbe + s_prev, vb1_ = vbo + s_prev; auto& P_ = pA;
        KRD4(ka, 0, 4096); KRD4(kb, 1, 4096); SBAR();
        FIN7(pA); SBAR();
        asm volatile("s_waitcnt lgkmcnt(4)" ::: "memory"); SBAR(); QKM(ka, 0); SBAR();
        KRD4(ka, 2, 4096); asm volatile("s_waitcnt lgkmcnt(4)" ::: "memory"); SBAR(); QKM(kb, 1); SBAR();
        KRD4(kb, 3, 4096); asm volatile("s_waitcnt lgkmcnt(4)" ::: "memory"); SBAR(); QKM(ka, 2); SBAR();
        KRD4(ka, 4, 2048); asm volatile("s_waitcnt lgkmcnt(4)" ::: "memory"); SBAR(); QKM(kb, 3); SBAR();
        KRD4(kb, 5, 2048); asm volatile("s_waitcnt lgkmcnt(4)" ::: "memory"); SBAR(); QKM(ka, 4); SBAR();
        RD4(ea, 0); RD4(eb, 1); asm volatile("s_waitcnt lgkmcnt(8)" ::: "memory"); SBAR(); QKM(kb, 5); SBAR();
        asm volatile("s_waitcnt lgkmcnt(4)" ::: "memory"); SBAR(); MM4(ea, 0); SBAR();
        RD4(ea, 2); asm volatile("s_waitcnt lgkmcnt(4)" ::: "memory"); SBAR(); MM4(eb, 1); SBAR();
        RD4(eb, 3); asm volatile("s_waitcnt lgkmcnt(4)" ::: "memory"); SBAR(); MM4(ea, 2); SBAR();
        RD4(ea, 4); asm volatile("s_waitcnt lgkmcnt(4)" ::: "memory"); SBAR(); MM4(eb, 3); SBAR();
        RD4(eb, 5); asm volatile("s_waitcnt lgkmcnt(4)" ::: "memory"); SBAR(); MM4(ea, 4); SBAR();
        RD4(ea, 6); asm volatile("s_waitcnt lgkmcnt(4)" ::: "memory"); SBAR(); MM4(eb, 5); SBAR();
        RD4(eb, 7); asm volatile("s_waitcnt lgkmcnt(4)" ::: "memory"); SBAR(); MM4(ea, 6); SBAR();
        asm volatile("s_waitcnt lgkmcnt(0)" ::: "memory"); SBAR(); MM4(eb, 7);
        EXPH7(pA, 0); TILE_BAR();
        { const int t = s_prev; s_prev = s_cur; s_cur = s_next; s_next = t; }
    }
    FIN7(pA); SBAR();
    PV7(s_prev);
    float rl[2]; bool okl = true;
#pragma unroll
    for (int u = 0; u < 2; ++u) { float l = l_reg[u]; l += XSH(l, 16); l += XSH(l, 32); okl = okl && (l > 0.f) && (l < 1e30f); rl[u] = __builtin_amdgcn_rcpf(l); }
    { const bool okw = __all(okl); if (lane == 0) ((LAS unsigned*)(lds + LDS2_BYTES))[wid] = okw ? 1u : 0u; }
    asm volatile("s_waitcnt vmcnt(0) lgkmcnt(0)\n\ts_barrier" ::: "memory");
    { constexpr int OP = 272; LAS unsigned char* st = lds + wid * (32 * OP);
      int tid2 = threadIdx.x; asm volatile("" : "+v"(tid2)); const int lane = tid2 & 63, c16 = lane & 15, g = lane >> 4;
#pragma unroll
      for (int u = 0; u < 2; ++u)
#pragma unroll
        for (int t = 0; t < 8; ++t) { u32x2 w; w.x = cvt_pk_bf16(o[t][u][0] * rl[u], o[t][u][1] * rl[u]); w.y = cvt_pk_bf16(o[t][u][2] * rl[u], o[t][u][3] * rl[u]);
            *(LAS u32x2*)(st + (16 * u + c16) * OP + (16 * t + 4 * g) * 2) = w; }
      asm volatile("s_waitcnt lgkmcnt(0)" ::: "memory");
      bf16_t* Ow = U.Ob + (size_t)(wid * QBLK) * D;
#pragma unroll
      for (int i = 0; i < 8; ++i) { const int row = (lane >> 4) + 4 * i, ch = lane & 15;
        const u32x4 w = *(const LAS u32x4*)(st + row * OP + ch * 16); *(u32x4*)(Ow + (size_t)row * D + ch * 8) = w; } }
    TILE_BAR();
#undef KROW
#undef DMA
#undef TILE_BAR
#undef XSH
#undef MFMA16
#undef QK7
#undef KRD
#undef KRD4
#undef QKM
#undef EXPH7
#undef FIN7
#undef PV7
#undef TR7
#undef RD4
#undef MM4
}

#ifndef ATT_FAST_FIRST
#define ATT_FAST_FIRST 1
#endif
#ifndef ATT_FORCE_SAFE
#define ATT_FORCE_SAFE 0
#endif
__device__ __forceinline__ void attn_unit_auto(const Unit& U, const bf16_t* __restrict__ KR, const float* __restrict__ ropetab, LAS unsigned char* lds) {
#if ATT_FAST_FIRST
    attn_unit7(U, KR, ropetab, lds);
    const LAS unsigned* fl = (const LAS unsigned*)(lds + LDS2_BYTES);
    unsigned okc = 0; for (int w = 0; w < NWAVES; ++w) okc += fl[w];
    if (ATT_FORCE_SAFE || __builtin_amdgcn_readfirstlane(okc) != (unsigned)NWAVES) attn_unit6<false>(U, KR, ropetab, lds);
#else
    attn_unit6<false>(U, KR, ropetab, lds);
#endif
}
}
constexpr size_t MiB = 1u << 20;
constexpr int CW_TMO = 0, CW_BAR = 4096;
constexpr int KSPL = 16;
constexpr size_t WS_CTL = 0;
constexpr size_t WS_MOD = 64 * 1024;
constexpr size_t WS_SSQ = 1 * MiB;
constexpr size_t CTL_ZERO_BYTES = 64 * 1024;
constexpr size_t WS_ROPE = 3 * MiB;
constexpr size_t WS_W13 = 4 * MiB;
constexpr size_t WS_W2 = 180 * MiB;
constexpr size_t WS_WPOOL = 268 * MiB;
constexpr size_t WS_WDQKV = 272 * MiB;
constexpr size_t WS_WUP = 282 * MiB;
constexpr size_t WS_WO = 296 * MiB;
constexpr size_t WS_H = 312 * MiB;
constexpr size_t WS_U = 444 * MiB;
constexpr size_t WS_Y = 510 * MiB;
constexpr size_t WS_P = 576 * MiB;
constexpr size_t WS_G = 642 * MiB;
constexpr size_t WS_CQKV = 824 * MiB;
constexpr size_t WS_Q = 866 * MiB;
constexpr size_t WS_KV = 965 * MiB;
constexpr size_t WS_KR = 1097 * MiB;
constexpr size_t WS_YP = 1100 * MiB;
constexpr size_t WS_MODP2 = 1148 * MiB;
constexpr size_t WS_END = 1176 * MiB;
static_assert(WS_W13 + (size_t)4 * 11264 * 2048 * 2 <= WS_W2 && WS_W2 + (size_t)4 * 2048 * 5632 * 2 <= WS_WPOOL && WS_H + (size_t)T * D * 4 <= WS_U && WS_U + (size_t)T * D * 2 <= WS_Y, "ws map");
static_assert(WS_G + (size_t)T * DFF * 2 <= WS_CQKV && WS_CQKV + (size_t)T * NDQKV * 2 <= WS_Q && WS_Q + (size_t)T * NQ * 2 <= WS_KV && WS_KV + (size_t)T * NKV * 2 <= WS_KR && WS_KR + (size_t)T * ROPED * 2 <= WS_YP && WS_YP + (size_t)11 * TC * D * 4 <= WS_MODP2 && WS_MODP2 + (size_t)3 * 64 * 3 * NMOD * 4 <= WS_END, "ws map");
static_assert(WS_MOD + (size_t)4 * 3 * NMOD * 4 <= WS_SSQ && WS_SSQ + (size_t)16 * T * 4 <= WS_ROPE && (CW_BAR + 3456) * 4 <= (int)CTL_ZERO_BYTES, "ctl map");

constexpr int RING_BYTES = 131072, MISC_OFF = RING_BYTES, LDS_BYTES = 147456;
static_assert(att::LDS_BYTES <= RING_BYTES && att::LDS2_BYTES + 64 <= RING_BYTES, "attention LDS");

#define XB_TMO      128
#define XB_XCNT(j)  (256  + 64 * (j))
#define XB_XSUB(j)  (1280 + 64 * (j))
#define XB_XGEN(j)  (2304 + 64 * (j))
#define XB_TOP      3328
#define XB_TOPGEN   3392
#define XCD_BAR_WORDS 3456
#define XB_SPIN_CAP (1u << 22)
__device__ __forceinline__ unsigned xb_ld(unsigned* p)              { return __hip_atomic_load(p, __ATOMIC_RELAXED, __HIP_MEMORY_SCOPE_AGENT); }
__device__ __forceinline__ unsigned xb_add(unsigned* p, unsigned v) { return __hip_atomic_fetch_add(p, v, __ATOMIC_RELAXED, __HIP_MEMORY_SCOPE_AGENT); }
__device__ __forceinline__ unsigned xb_xcc_id() { return (unsigned)__builtin_amdgcn_s_getreg((3 << 11) | 20) & 0xFu; }
#define XB_SPIN(cond, bar) do { unsigned _sp = 0; while (cond) { __builtin_amdgcn_s_sleep(1); \
    if ((++_sp & 255u) == 0u) { if (xb_ld(&(bar)[XB_TMO])) break; if (_sp > XB_SPIN_CAP) { atomicAdd(&(bar)[XB_TMO], 1u); break; } } } } while (0)
struct XcdBarrier { unsigned* bar; unsigned x; volatile LAS unsigned* st; };
__device__ __forceinline__ XcdBarrier xcd_barrier_post(unsigned* bar, volatile LAS unsigned* st) {
    XcdBarrier b; b.bar = bar; b.x = xb_xcc_id(); b.st = st;
    if (threadIdx.x == 0) (void)xb_add(&bar[XB_XCNT(b.x)], 1u);
    return b;
}
__device__ __forceinline__ void xcd_barrier_complete(unsigned* bar, unsigned x, unsigned& nloc, unsigned& nx) {
    const unsigned G = gridDim.x * gridDim.y * gridDim.z;
    unsigned sum, cnt, mine, sp = 0u;
    for (;;) {
        sum = 0u; cnt = 0u; mine = 0u;
#pragma unroll
        for (unsigned j = 0; j < 16; ++j) { const unsigned c = xb_ld(&bar[XB_XCNT(j)]); sum += c; cnt += (c > 0u) ? 1u : 0u; mine = (j == x) ? c : mine; }
        if (sum == G) break;
        __builtin_amdgcn_s_sleep(1);
        if ((++sp & 255u) == 0u) { if (xb_ld(&bar[XB_TMO])) break; if (sp > XB_SPIN_CAP) { atomicAdd(&bar[XB_TMO], 1u); break; } }
    }
    nloc = mine > 0u ? mine : 1u; nx = cnt > 0u ? cnt : 1u;
}
__device__ __forceinline__ void xcd_barrier(const XcdBarrier& b) {
    asm volatile("s_waitcnt vmcnt(0)" ::: "memory");
    __syncthreads();
    if (threadIdx.x == 0) {
        unsigned* bar = b.bar; asm volatile("" : "+s"(bar));
        __builtin_amdgcn_s_waitcnt(0);
        const unsigned bx = xb_xcc_id();
        unsigned nloc = b.st[0], nx = b.st[1];
        if (nloc == 0u) { xcd_barrier_complete(bar, bx, nloc, nx); b.st[0] = nloc; b.st[1] = nx; }
        const unsigned old = xb_add(&bar[XB_XSUB(bx)], 1u);
        const unsigned gen = old / nloc;
        if (old + 1u == (gen + 1u) * nloc) {
            __builtin_amdgcn_fence(__ATOMIC_RELEASE, "agent");
            asm volatile("s_waitcnt vmcnt(0)" ::: "memory");
            const unsigned og = xb_add(&bar[XB_TOP], 1u);
            const unsigned tg = og / nx;
            if (og + 1u == (tg + 1u) * nx) xb_add(&bar[XB_TOPGEN], 1u);
            else XB_SPIN(xb_ld(&bar[XB_TOPGEN]) == tg, bar);
            __builtin_amdgcn_fence(__ATOMIC_ACQUIRE, "agent");
            xb_add(&bar[XB_XGEN(bx)], 1u);
            asm volatile("s_waitcnt vmcnt(0)" ::: "memory");
        } else {
            XB_SPIN(xb_ld(&bar[XB_XGEN(bx)]) == gen, bar);
            __builtin_amdgcn_fence(__ATOMIC_ACQUIRE, "agent");
            asm volatile("s_waitcnt vmcnt(0)" ::: "memory");
        }
    }
    __syncthreads();
}

#define LDS_WAIT() asm volatile("s_waitcnt lgkmcnt(0)" ::: "memory")
struct TrD { const float* W; int ldw, k0, n0; bf16_t* WT; int ldt, drow0; const float* ksc; const float* nsc; float mul; };
__device__ __forceinline__ void tr_load(const TrD& d, float (&v)[32], int lane) {
    const float* wp = d.W + (size_t)(d.k0 + (lane >> 5)) * d.ldw + d.n0 + (lane & 31);
#pragma unroll
    for (int i = 0; i < 32; ++i) v[i] = __builtin_nontemporal_load(wp + (size_t)(2 * i) * d.ldw);
}
__device__ __forceinline__ void tr_finish(const TrD& d, float (&v)[32], LAS float* scr, int lane) {
    const float ns = (d.nsc ? d.nsc[d.n0 + (lane & 31)] : 1.f) * d.mul;
    if (d.ksc) {
#pragma unroll
        for (int i = 0; i < 32; ++i) v[i] *= d.ksc[d.k0 + 2 * i + (lane >> 5)]; }
#pragma unroll
    for (int i = 0; i < 32; ++i) scr[(2 * i + (lane >> 5)) * 33 + (lane & 31)] = v[i] * ns;
    LDS_WAIT(); asm volatile("" ::: "memory");
    const int c = lane & 7;
#pragma unroll
    for (int j = 0; j < 4; ++j) { const int n = (lane >> 3) + 8 * j; const LAS float* s = scr + (8 * c) * 33 + n;
        u32x4 o; o.x = cvt_pk_bf16(s[0 * 33], s[1 * 33]); o.y = cvt_pk_bf16(s[2 * 33], s[3 * 33]); o.z = cvt_pk_bf16(s[4 * 33], s[5 * 33]); o.w = cvt_pk_bf16(s[6 * 33], s[7 * 33]);
        *(u32x4*)(d.WT + (size_t)(d.drow0 + n) * d.ldt + d.k0 + 8 * c) = o; }
    LDS_WAIT(); asm volatile("" ::: "memory");
}
struct In {
    const float *x, *c, *ctx, *c_ctx, *ada_w, *ada_b, *norm_g, *pool_w, *pool_scale, *w_dqkv, *q_norm, *w_uq, *kv_norm, *w_ukv, *w_o, *w1, *w3, *w2;
};
constexpr int I_F = (D / 64) * (DFF / 32);
constexpr int I_P = (512 / 64) * (512 / 32);
constexpr int I_DQ = (D / 64) * (1088 / 32);
constexpr int I_UQ = (QL / 64) * (NQ / 32), I_UKV = (KVL / 64) * (NKV / 32);
constexpr int I_O = (D / 64) * (D / 32);
constexpr int SEG0 = 0;
constexpr int SEG1 = SEG0 + 3 * I_F + 8 * I_P + 2 * I_DQ;
constexpr int SEG2 = SEG1 + 3 * I_F;
constexpr int SEG3 = SEG2 + I_UQ + I_UKV + I_O;
constexpr int SEG4 = SEG3 + 3 * I_F;
constexpr int SEG5 = SEG4 + 2 * I_F;
constexpr int SEG6 = SEG5 + I_UQ + I_UKV + I_O + I_F;
__device__ __forceinline__ TrD d_ffn(const In& I, unsigned char* ws, int l, int which, int item) {
    if (which < 2) { const int nblk = DFF / 32, kb = item / nblk, nb = item % nblk, n0 = nb * 32;
        return TrD{(which ? I.w3 : I.w1) + (size_t)l * D * DFF, DFF, kb * 64, n0, (bf16_t*)(ws + WS_W13) + (size_t)l * 2 * DFF * D, D, 256 * (n0 >> 7) + 128 * which + (n0 & 127), nullptr, nullptr, 1.f}; }
    const int nblk = D / 32, kb = item / nblk, nb = item % nblk;
    return TrD{I.w2 + (size_t)l * DFF * D, D, kb * 64, nb * 32, (bf16_t*)(ws + WS_W2) + (size_t)l * D * DFF, DFF, nb * 32, nullptr, nullptr, 1.f};
}
__device__ __forceinline__ TrD d_pool(const In& I, unsigned char* ws, int r) { const int jg = r / I_P, item = r % I_P, j = jg >> 2, g = jg & 3, nblk = 512 / 32, kb = item / nblk, nb = item % nblk;
    return TrD{I.pool_w + (size_t)jg * 512 * 512, 512, kb * 64, nb * 32, (bf16_t*)(ws + WS_WPOOL) + (size_t)j * D * 512, 512, g * 512 + nb * 32, nullptr, I.pool_scale + j * D + g * 512, 1.f}; }
__device__ __forceinline__ TrD d_dq(const In& I, unsigned char* ws, int j, int item) { const int nblk = 1088 / 32, kb = item / nblk, nb = item % nblk;
    return TrD{I.w_dqkv + (size_t)j * D * 1088, 1088, kb * 64, nb * 32, (bf16_t*)(ws + WS_WDQKV) + (size_t)j * NDQKV * D, D, nb * 32, nullptr, nullptr, 1.f}; }
__device__ __forceinline__ TrD d_uq(const In& I, unsigned char* ws, int j, int item) { const int nblk = NQ / 32, kb = item / nblk, nb = item % nblk;
    return TrD{I.w_uq + (size_t)j * QL * NQ, NQ, kb * 64, nb * 32, (bf16_t*)(ws + WS_WUP) + (size_t)j * NUP * 512, 512, nb * 32, I.q_norm + j * QL, nullptr, att::SCALE * 1.4426950408889634f}; }
__device__ __forceinline__ TrD d_ukv(const In& I, unsigned char* ws, int j, int item) { const int nblk = NKV / 32, kb = item / nblk, nb = item % nblk;
    return TrD{I.w_ukv + (size_t)j * KVL * NKV, NKV, kb * 64, nb * 32, (bf16_t*)(ws + WS_WUP) + (size_t)j * NUP * 512, 512, NQ + nb * 32, I.kv_norm + j * KVL, nullptr, 1.f}; }
__device__ __forceinline__ TrD d_o(const In& I, unsigned char* ws, int j, int item) { const int nblk = D / 32, kb = item / nblk, nb = item % nblk;
    return TrD{I.w_o + (size_t)j * D * D, D, kb * 64, nb * 32, (bf16_t*)(ws + WS_WO) + (size_t)j * D * D, D, nb * 32, nullptr, nullptr, 1.f}; }
__device__ __forceinline__ TrD tr_desc(const In& I, unsigned char* ws, int r) {
#define PIECE(cnt, expr) if (r < (cnt)) return expr; r -= (cnt);
    PIECE(I_F, d_ffn(I, ws, 0, 0, r)) PIECE(I_F, d_ffn(I, ws, 0, 1, r)) PIECE(I_F, d_ffn(I, ws, 0, 2, r)) PIECE(8 * I_P, d_pool(I, ws, r)) PIECE(I_DQ, d_dq(I, ws, 0, r)) PIECE(I_DQ, d_dq(I, ws, 1, r))
    PIECE(I_F, d_ffn(I, ws, 1, 0, r)) PIECE(I_F, d_ffn(I, ws, 1, 1, r)) PIECE(I_F, d_ffn(I, ws, 1, 2, r))
    PIECE(I_UQ, d_uq(I, ws, 0, r)) PIECE(I_UKV, d_ukv(I, ws, 0, r)) PIECE(I_O, d_o(I, ws, 0, r))
    PIECE(I_F, d_ffn(I, ws, 2, 0, r)) PIECE(I_F, d_ffn(I, ws, 2, 1, r)) PIECE(I_F, d_ffn(I, ws, 2, 2, r))
    PIECE(I_F, d_ffn(I, ws, 3, 0, r)) PIECE(I_F, d_ffn(I, ws, 3, 1, r))
    PIECE(I_UQ, d_uq(I, ws, 1, r)) PIECE(I_UKV, d_ukv(I, ws, 1, r)) PIECE(I_O, d_o(I, ws, 1, r))
    return d_ffn(I, ws, 3, 2, r);
#undef PIECE
}
__device__ __forceinline__ void tr_run(const In& I, unsigned char* ws, int seg_lo, int seg_n, int v, int vs, LAS float* scr, int lane) {
    float vA[32], vB[32]; TrD dA, dB; int it = v;
    if (it < seg_n) { dA = tr_desc(I, ws, seg_lo + it); tr_load(dA, vA, lane); }
    while (it < seg_n) {
        int itn = it + vs;
        if (itn < seg_n) { dB = tr_desc(I, ws, seg_lo + itn); tr_load(dB, vB, lane); }
        tr_finish(dA, vA, scr, lane);
        it = itn; if (it >= seg_n) break;
        itn = it + vs;
        if (itn < seg_n) { dA = tr_desc(I, ws, seg_lo + itn); tr_load(dA, vA, lane); }
        tr_finish(dB, vB, scr, lane);
        it = itn;
    }
}
#ifndef GEMV_DEFER
#define GEMV_DEFER 0
#endif
constexpr int KSPL2 = 64;
template <int KLEN>
__device__ __forceinline__ void gemv_task(const In& I, float* outp, int l, int st, int k0, int lane) {
    constexpr int NHALF = (KLEN + 63) / 64, HL = KLEN < 64 ? KLEN : 64;
    float sv[3][NHALF];
#pragma unroll
    for (int h = 0; h < NHALF; ++h) { const int k = k0 + h * 64 + (lane % HL); const float c0 = I.c[k], c1 = I.c[D + k], c2 = I.c_ctx[k];
        sv[0][h] = c0 / (1.f + __expf(-c0)); sv[1][h] = c1 / (1.f + __expf(-c1)); sv[2][h] = c2 / (1.f + __expf(-c2)); }
    const float* wp = I.ada_w + ((size_t)l * D + k0) * NMOD + st * 256 + lane * 4;
    f32x4 a0 = {0.f, 0.f, 0.f, 0.f}, a1 = a0, a2 = a0;
#pragma unroll
    for (int h = 0; h < NHALF; ++h)
#pragma unroll (KLEN < 64 ? 16 : 8)
        for (int kk = 0; kk < HL; ++kk) { const f32x4 w = __builtin_nontemporal_load((const f32x4*)(wp + (size_t)(h * 64 + kk) * NMOD));
            a0 += w * __int_as_float(__builtin_amdgcn_readlane(__float_as_int(sv[0][h]), kk)); a1 += w * __int_as_float(__builtin_amdgcn_readlane(__float_as_int(sv[1][h]), kk)); a2 += w * __int_as_float(__builtin_amdgcn_readlane(__float_as_int(sv[2][h]), kk)); }
    float* mp = outp + st * 256 + lane * 4;
    *(f32x4*)mp = a0; *(f32x4*)(mp + NMOD) = a1; *(f32x4*)(mp + 2 * NMOD) = a2;
}
__device__ __forceinline__ void filler(const In& I, unsigned char* ws, int gl, int seg_lo, int seg_n, int fi, int fn, LAS float* scr, int lane) {
    int v = fi;
    if (gl > 0) { constexpr int NG2 = (NMOD / 256) * KSPL2; float* mp2 = (float*)(ws + WS_MODP2) + (size_t)(gl - 1) * KSPL2 * 3 * NMOD;
#if GEMV_TWICE
        if (gl == 2) for (int v2 = fi; v2 < NG2; v2 += fn) { const int ks = v2 % KSPL2, st = v2 / KSPL2; gemv_task<D / KSPL2>(I, mp2 + (size_t)ks * 3 * NMOD, gl, st, ks * (D / KSPL2), lane); }
#endif
        for (; v < NG2; v += fn) { const int ks = v % KSPL2, st = v / KSPL2; gemv_task<D / KSPL2>(I, mp2 + (size_t)ks * 3 * NMOD, gl, st, ks * (D / KSPL2), lane); }
        v -= NG2; }
    tr_run(I, ws, seg_lo, seg_n, v, fn, scr, lane);
}

__device__ __forceinline__ void prologue(const In& I, unsigned char* ws, LAS unsigned char* lds, int gw, int ngw, int wave, int lane, int gtid, int ngt) {
    LAS float* scr = (LAS float*)(lds + wave * 16384);
    bf16_t* WDQKV = (bf16_t*)(ws + WS_WDQKV);
    tr_run(I, ws, SEG0, SEG1 - SEG0, gw, ngw, scr, lane);
    { constexpr int PER = (NDQKV - 1088) * D / 8;
        for (int i = gtid; i < 2 * PER; i += ngt) { const int j = i / PER, q = i % PER; *(u32x4*)(WDQKV + (size_t)j * NDQKV * D + (size_t)1088 * D + (size_t)q * 8) = (u32x4){0u, 0u, 0u, 0u}; } }
    if (gtid < 128 * 16) { const int pos = gtid >> 4, f = gtid & 15; const float inv = powf(10000.f, -(float)(2 * f) / 32.f), ang = (float)pos * inv;
        float* tab = (float*)(ws + WS_ROPE); tab[gtid * 2] = cosf(ang); tab[gtid * 2 + 1] = sinf(ang); }
    { float* MODP = (float*)(ws + WS_G); constexpr int NSTRIP = NMOD / 256, KLEN = D / KSPL;
        for (int task = gw; task < (GEMV_DEFER ? 2 : 4) * NSTRIP * KSPL; task += ngw) { const int ks = task % KSPL, st = (task / KSPL) % NSTRIP, l = task / (KSPL * NSTRIP);
            gemv_task<KLEN>(I, MODP + (size_t)ks * 12 * NMOD + (size_t)l * 3 * NMOD, l, st, ks * KLEN, lane); } }
}

struct RN { const float* xin_lat; const float* xin_ctx; const bf16_t* hin; const bf16_t* Y; const float* Yp; int nparts; const float* gate; const float* gY; bf16_t* hout; float* fout;
            const float* gN; const float* shift; const float* scale; bf16_t* U; int nrows; const float* modp; const float* bias; float* mod_out; };
template <bool HAS_Y, bool WRITE_U, bool HIN_F32, bool HOUT_F32, bool MODP_IN = false, bool POOLY = false>
__device__ __forceinline__ void resid_norm(const RN& a, LAS unsigned char* lds, int gw, int ngw, int tid) {
    asm volatile("" : "+v"(tid)); const int lane = tid & 63;
    typedef const GAS char* gcp; typedef GAS char* gp;
    if (MODP_IN) {
        for (int i = (gw * 64 + lane); i < (GEMV_DEFER ? 6 : 12) * NMOD / 4; i += ngw * 64) { f32x4 acc = *(const GAS f32x4*)((gcp)a.bias + 16 * ((size_t)(i / (3 * NMOD / 4)) * (NMOD / 4) + i % (NMOD / 4)));
            for (int p = 0; p < KSPL; ++p) acc += *(const GAS f32x4*)((gcp)a.modp + ((size_t)p * 12 * NMOD + (size_t)i * 4) * 4);
            *(GAS f32x4*)((gp)a.mod_out + (size_t)i * 16) = acc; } }
    for (int i = tid; i < 3 * (D / 4); i += NTHREADS) { const int s = i / (D / 4), c4 = i % (D / 4); LAS f32x4* t = (LAS f32x4*)(lds + s * 24576) + c4;
        if (HAS_Y) t[0] = *(const GAS f32x4*)((gcp)(a.gate + (size_t)s * NMOD) + 16 * c4) * *(const GAS f32x4*)((gcp)a.gY + 16 * c4);
        if (WRITE_U) { f32x4 sc, sh;
            if (MODP_IN) { sh = *(const GAS f32x4*)((gcp)a.bias + 16 * c4); sc = *(const GAS f32x4*)((gcp)a.bias + 16 * (D / 4 + c4));
                for (int p = 0; p < KSPL; ++p) { const float* mp = a.modp + (size_t)p * 12 * NMOD + (size_t)s * NMOD; sh += *(const GAS f32x4*)((gcp)mp + 16 * c4); sc += *(const GAS f32x4*)((gcp)mp + 16 * (D / 4 + c4)); } }
            else { sc = *(const GAS f32x4*)((gcp)(a.scale + (size_t)s * NMOD) + 16 * c4); sh = *(const GAS f32x4*)((gcp)(a.shift + (size_t)s * NMOD) + 16 * c4); }
            t[D / 4] = *(const GAS f32x4*)((gcp)a.gN + 16 * c4) * (sc + 1.f); t[2 * (D / 4)] = sh; } }
    __syncthreads();
    const unsigned l16 = (unsigned)lane * 16u, l8 = (unsigned)lane * 8u;
    const int nrows = a.nrows, nparts = a.nparts;
#define LDF4(base, j) (*(const GAS f32x4*)((gcp)(base) + l16 + 1024u * (j)))
#define LDB4(base, j) (*(const GAS u32x2*)((gcp)(base) + l8 + 512u * (j)))
#define UNPK(w) ((f32x4){bf_lo((w).x), bf_hi((w).x), bf_lo((w).y), bf_hi((w).y)})
#define RN_LOAD(hf, hw, yw, r) do { \
        if (HIN_F32) { const float* hp_ = (r) < TL ? a.xin_lat + (size_t)(r) * D : a.xin_ctx + (size_t)((r) - TL) * D; _Pragma("unroll") for (int j = 0; j < 8; ++j) hf[j] = LDF4(hp_, j); } \
        else { const bf16_t* hp_ = a.hin + (size_t)(r) * D; _Pragma("unroll") for (int j = 0; j < 8; ++j) hw[j] = LDB4(hp_, j); } \
        if (HAS_Y && !POOLY && !((r) >= TL && nparts > 0)) { const bf16_t* yr_ = a.Y + (size_t)(r) * D; _Pragma("unroll") for (int j = 0; j < 8; ++j) yw[j] = LDB4(yr_, j); } } while (0)
#define RN_PROC(hf, hw, yw, r) do { const int s_ = (r) < SEQ ? 0 : ((r) < TL ? 1 : 2); const LAS f32x4* tb_ = (const LAS f32x4*)(lds + s_ * 24576) + lane; f32x4 h[8]; \
        _Pragma("unroll") for (int j = 0; j < 8; ++j) h[j] = HIN_F32 ? hf[j] : UNPK(hw[j]); \
        if (HAS_Y) { f32x4 y[8]; float sy = 0.f; \
            if (POOLY) {   \
                int sb_, L_; if ((r) < TL) { sb_ = ((r) / SEQ) * SEQ; L_ = SEQ; } else { sb_ = TL + (((r) - TL) / CTXL) * CTXL; L_ = CTXL; } const int t_ = (r) - sb_; const bf16_t* zs_ = a.Y + (size_t)sb_ * D; \
                _Pragma("unroll") for (int g = 0; g < 4; ++g) { const int w2_ = 1 << g, lo_ = max(t_ - w2_, 0), hi_ = min(t_ + w2_, L_); const float inv_ = 1.f / (float)(hi_ - lo_); \
                    f32x4 s0_ = {0.f, 0.f, 0.f, 0.f}, s1_ = s0_; \
                    _Pragma("unroll") for (int i = 0; i < 2 * w2_; ++i) { const int q_ = t_ - w2_ + i; const bool ok_ = q_ >= 0 && q_ < L_; const bf16_t* zr_ = zs_ + (size_t)(ok_ ? q_ : t_) * D; \
                        const u32x2 wa_ = LDB4(zr_, 2 * g), wb_ = LDB4(zr_, 2 * g + 1); const float m_ = ok_ ? 1.f : 0.f; s0_ += UNPK(wa_) * m_; s1_ += UNPK(wb_) * m_; } \
                    const bf16_t* zc_ = zs_ + (size_t)t_ * D; const u32x2 ca_ = LDB4(zc_, 2 * g), cb_ = LDB4(zc_, 2 * g + 1); y[2 * g] = s0_ * inv_ - UNPK(ca_); y[2 * g + 1] = s1_ * inv_ - UNPK(cb_); } } \
            else if ((r) >= TL && nparts > 0) { _Pragma("unroll") for (int j = 0; j < 8; ++j) y[j] = (f32x4){0.f, 0.f, 0.f, 0.f}; \
                for (int p = 0; p < nparts; ++p) { const float* yp_ = a.Yp + ((size_t)p * TC + ((r) - TL)) * D; _Pragma("unroll") for (int j = 0; j < 8; ++j) y[j] += LDF4(yp_, j); } } \
            else { _Pragma("unroll") for (int j = 0; j < 8; ++j) y[j] = UNPK(yw[j]); } \
            _Pragma("unroll") for (int j = 0; j < 8; ++j) sy += (y[j][0] * y[j][0] + y[j][1] * y[j][1]) + (y[j][2] * y[j][2] + y[j][3] * y[j][3]); \
            const float rs_ = __builtin_amdgcn_rsqf(wave_sum(sy) * (1.f / D) + RMS_EPS); \
            _Pragma("unroll") for (int j = 0; j < 8; ++j) h[j] += tb_[64 * j] * (y[j] * rs_); } \
        if (HOUT_F32) { float* op_ = a.fout + (size_t)(r) * D; _Pragma("unroll") for (int j = 0; j < 8; ++j) __builtin_nontemporal_store(h[j], (GAS f32x4*)((gp)op_ + l16 + 1024u * j)); } \
        else if (a.hout) { bf16_t* op_ = a.hout + (size_t)(r) * D; _Pragma("unroll") for (int j = 0; j < 8; ++j) { u32x2 w; w.x = cvt_pk_bf16(h[j][0], h[j][1]); w.y = cvt_pk_bf16(h[j][2], h[j][3]); *(GAS u32x2*)((gp)op_ + l8 + 512u * j) = w; } } \
        if (WRITE_U) { float ss = 0.f; \
            _Pragma("unroll") for (int j = 0; j < 8; ++j) ss += (h[j][0] * h[j][0] + h[j][1] * h[j][1]) + (h[j][2] * h[j][2] + h[j][3] * h[j][3]); \
            const float rstd_ = __builtin_amdgcn_rsqf(wave_sum(ss) * (1.f / D) + RMS_EPS); bf16_t* ur_ = a.U + (size_t)(r) * D; \
            _Pragma("unroll") for (int j = 0; j < 8; ++j) { const f32x4 u = (h[j] * rstd_) * tb_[D / 4 + 64 * j] + tb_[2 * (D / 4) + 64 * j]; u32x2 w; w.x = cvt_pk_bf16(u[0], u[1]); w.y = cvt_pk_bf16(u[2], u[3]); \
                *(GAS u32x2*)((gp)ur_ + l8 + 512u * j) = w; } } } while (0)
    f32x4 hfA[8], hfB[8], hfC[8]; u32x2 hwA[8], hwB[8], hwC[8], ywA[8], ywB[8], ywC[8];
    int r = POOLY ? gw : (gw % NWAVES) * (ngw / NWAVES) + gw / NWAVES;
    if (r < nrows) RN_LOAD(hfA, hwA, ywA, r);
    if (r + ngw < nrows) RN_LOAD(hfB, hwB, ywB, r + ngw);
    while (r < nrows) {
        if (r + 2 * ngw < nrows) RN_LOAD(hfC, hwC, ywC, r + 2 * ngw);
        RN_PROC(hfA, hwA, ywA, r);
        r += ngw; if (r >= nrows) break;
        if (r + 2 * ngw < nrows) RN_LOAD(hfA, hwA, ywA, r + 2 * ngw);
        RN_PROC(hfB, hwB, ywB, r);
        r += ngw; if (r >= nrows) break;
        if (r + 2 * ngw < nrows) RN_LOAD(hfB, hwB, ywB, r + 2 * ngw);
        RN_PROC(hfC, hwC, ywC, r);
        r += ngw;
    }
#undef LDF4
#undef LDB4
#undef UNPK
#undef RN_LOAD
#undef RN_PROC
    __syncthreads();
}

__device__ __forceinline__ void krope_phase(const bf16_t* __restrict__ CQKV, bf16_t* __restrict__ KR, const float* __restrict__ tab, int gtid, int ngt) {
    asm volatile("" : "+v"(gtid));
    for (int i = gtid; i < T * 32; i += ngt) { const int r = i >> 5, ax = (i >> 4) & 1, f = i & 15;
        const bf16_t* src = CQKV + (size_t)r * NDQKV + 1024 + ax * 32 + f; const float x1 = bf_lo((unsigned)src[0]), x2 = bf_lo((unsigned)src[16]); float o1 = x1, o2 = x2;
        if (r < TL) { const int t = r & (SEQ - 1), pos = ax ? (t & 63) : (t >> 6); const float c = tab[(pos * 16 + f) * 2], s = tab[(pos * 16 + f) * 2 + 1]; o1 = x1 * c - x2 * s; o2 = x2 * c + x1 * s; }
        bf16_t* dst = KR + (size_t)r * ROPED + ax * 32 + f; dst[0] = (bf16_t)(cvt_pk_bf16(o1, 0.f) & 0xffffu); dst[16] = (bf16_t)(cvt_pk_bf16(o2, 0.f) & 0xffffu); }
}

#ifndef EN_P0
#define EN_P0 1
#endif
#ifndef EN_P1
#define EN_P1 1
#endif
#ifndef EN_S0
#define EN_S0 1
#endif
#ifndef EN_S1
#define EN_S1 1
#endif
#ifndef EN_S2
#define EN_S2 1
#endif
#ifndef EN_S3
#define EN_S3 1
#endif
#ifndef EN_S4
#define EN_S4 1
#endif
#ifndef EN_S5
#define EN_S5 1
#endif
#ifndef EN_S6
#define EN_S6 1
#endif
#ifndef EN_S7
#define EN_S7 1
#endif
struct Args { const float* in[18]; float* out; unsigned char* ws; int ph_lo, ph_hi; };
constexpr int N_PHASES = 34;
constexpr int SPLIT_POOL = 2, SPLIT_WO = 8, SPLIT_FFN2 = 11;

__global__ void __launch_bounds__(NTHREADS, 2) mk_fwd(Args args) {
    extern __shared__ __attribute__((aligned(16))) unsigned char lds_raw[];
    LAS unsigned char* lds = (LAS unsigned char*)lds_raw;
    volatile LAS unsigned* MISC = (volatile LAS unsigned*)(lds + MISC_OFF);
    const int G0 = gridDim.x, bid0 = blockIdx.x;
    unsigned char* ws = args.ws;
    for (int u = threadIdx.x; u < (LDS_BYTES - MISC_OFF) / 4; u += NTHREADS) ((LAS unsigned*)(lds + MISC_OFF))[u] = 0u;
    __syncthreads();
#if MK_PER_PHASE
    const int lo = args.ph_lo, hi = args.ph_hi;
#else
    constexpr int lo = 0, hi = N_PHASES;
#endif
    const bool use_bar = (hi - lo) > 1;
    XcdBarrier bar; bar.bar = (unsigned*)(ws + WS_CTL) + CW_BAR; bar.x = 0; bar.st = MISC + 8;
    if (use_bar) bar = xcd_barrier_post((unsigned*)(ws + WS_CTL) + CW_BAR, MISC + 8);
#define IN(k) (lo <= (k) && (k) < hi)
#define PHASE_END(k) do { if (hi > (k) + 1) xcd_barrier(bar); } while (0)
#define SITE() int tid = threadIdx.x, G = G0, bid = bid0; asm volatile("" : "+v"(tid), "+s"(G), "+s"(bid)); const int lane = tid & 63, wave = __builtin_amdgcn_readfirstlane(tid >> 6), gw = bid * NWAVES + wave, gtid = bid * NTHREADS + tid, ngw = G * NWAVES, ngt = G * NTHREADS; \
               (void)lane; (void)gw; (void)gtid; (void)ngw; (void)ngt; const __attribute__((address_space(4))) char* kp_ = (const __attribute__((address_space(4))) char*)__builtin_amdgcn_kernarg_segment_ptr(); asm volatile("" : "+s"(kp_)); \
               unsigned char* wsl = *(unsigned char* const __attribute__((address_space(4)))*)(kp_ + 19 * 8); asm volatile("" : "+s"(wsl))
#define KIN(k) (*(const float* const __attribute__((address_space(4)))*)(kp_ + (k) * 8))
#define KOUT() (*(float* const __attribute__((address_space(4)))*)(kp_ + 18 * 8))
#define WP(type, off) ((type*)(wsl + (off)))
#define MKIN() In I; I.x = KIN(0); I.c = KIN(1); I.ctx = KIN(2); I.c_ctx = KIN(3); I.ada_w = KIN(4); I.ada_b = KIN(5); I.norm_g = KIN(6); I.pool_w = KIN(7); \
               I.pool_scale = KIN(8); I.w_dqkv = KIN(9); I.q_norm = KIN(10); I.w_uq = KIN(11); I.kv_norm = KIN(12); I.w_ukv = KIN(13); I.w_o = KIN(14); I.w1 = KIN(15); I.w3 = KIN(16); I.w2 = KIN(17)
#define FILL_TAIL(gl, seg_lo, seg_hi) do { const int nshort_ = S.nwg % G; if (bid >= nshort_) { __syncthreads(); MKIN();   \
               filler(I, wsl, (gl), (seg_lo), (seg_hi) - (seg_lo), (bid - nshort_) * NWAVES + wave, (G - nshort_) * NWAVES, (LAS float*)(lds + wave * 16384), lane); } } while (0)

    if (EN_P0 && IN(0)) { SITE();
        MKIN();
        prologue(I, wsl, lds, gw, ngw, wave, lane, gtid, ngt); PHASE_END(0); }
    if (EN_P1 && IN(1)) { SITE();
        RN a; a.xin_lat = KIN(0); a.xin_ctx = KIN(2); a.hin = nullptr; a.Y = nullptr; a.Yp = nullptr; a.nparts = 0; a.gate = nullptr; a.gY = nullptr; a.hout = nullptr; a.fout = nullptr;
        a.gN = KIN(6); a.shift = nullptr; a.scale = nullptr; a.U = WP(bf16_t, WS_U); a.nrows = T; a.modp = WP(const float, WS_G); a.bias = KIN(5); a.mod_out = WP(float, WS_MOD);
        resid_norm<false, true, true, false, true>(a, lds, gw, ngw, tid); PHASE_END(1); }

    for (int L = 0; L < 4; ++L) {
        const int base = 2 + 8 * L, j = L >> 1; const bool pool = (L & 1) == 0;
        const int Mrows = (L == 3) ? TL : T;
        if (EN_S0 && !pool && IN(base + 0)) { SITE(); float* SSQ = WP(float, WS_SSQ);
            pg8::Gemm g{WP(const bf16_t, WS_U), WP(const bf16_t, WS_WDQKV) + (size_t)j * NDQKV * D, T, NDQKV, D, D, D}; pg8::StaticOrder S; S.init(T, NDQKV, D, G, bid);
            pg8::EpiStore E{WP(bf16_t, WS_CQKV), NDQKV, SSQ, SSQ + (size_t)8 * T, 2, 4, 0, 0};
            pg8::gemm_phase<pg8::EpiStore, pg8::StaticOrder>(lds, g, S, E);
            { const int lo_ = L == 1 ? SEG2 : SEG5, hi_ = L == 1 ? SEG3 : SEG6; FILL_TAIL(GEMV_DEFER && L == 1 ? 2 : 0, lo_, hi_); }
            PHASE_END(base + 0); }
        if (EN_S1 && !pool && IN(base + 1)) { SITE(); float* SSQ = WP(float, WS_SSQ);
            krope_phase(WP(const bf16_t, WS_CQKV), WP(bf16_t, WS_KR), WP(const float, WS_ROPE), gtid, ngt);
            pg8::Gemm g{WP(const bf16_t, WS_CQKV), WP(const bf16_t, WS_WUP) + (size_t)j * NUP * 512, T, NUP, 512, NDQKV, 512}; pg8::StaticOrder S; S.init(T, NUP, 512, G, bid);
            pg8::EpiUp E{WP(bf16_t, WS_Q), WP(bf16_t, WS_KV), SSQ, SSQ + (size_t)8 * T};
            pg8::gemm_phase<pg8::EpiUp, pg8::StaticOrder>(lds, g, S, E);
            PHASE_END(base + 1); }
        if (EN_S2 && !pool && IN(base + 2)) { SITE();
            const bf16_t* Qb = WP(const bf16_t, WS_Q); const bf16_t* KV = WP(const bf16_t, WS_KV); bf16_t* P = WP(bf16_t, WS_P);
            const int nlat = NB * NH * (SEQ / 256), nunits = nlat + (L == 1 ? NB * NH : 0);
            for (int u = bid; u < nunits; u += G) {
                att::Unit A;
                if (u < nlat) { const int pair = (u >> 8) * 8 + (u & 7), qb = (u & 255) >> 3, b = pair >> 4, h = pair & 15; const int row0 = b * SEQ + qb * 256;
                    A.Qb = Qb + (size_t)row0 * NQ + h * QKD; A.KVh = KV + h * 256; A.Ob = P + (size_t)row0 * D + h * VD; A.kb_lat = b * SEQ; A.nt_lat = SEQ / 64; A.kb_ctx = TL + b * CTXL; A.NT = SEQ / 64 + CTXL / 64; A.qpos0 = qb * 256; }
                else { const int v = u - nlat, b = v >> 4, h = v & 15; const int row0 = TL + b * CTXL;
                    A.Qb = Qb + (size_t)row0 * NQ + h * QKD; A.KVh = KV + h * 256; A.Ob = P + (size_t)row0 * D + h * VD; A.kb_lat = 0; A.nt_lat = 0; A.kb_ctx = row0; A.NT = CTXL / 64; A.qpos0 = -1; }
                att::attn_unit_auto(A, WP(const bf16_t, WS_KR), WP(const float, WS_ROPE), lds);
            }
            PHASE_END(base + 2); }
        if (EN_S3 && IN(base + 3)) { SITE();
            pg8::Gemm g; pg8::EpiY E{WP(bf16_t, WS_Y), WP(float, WS_YP), D, TL, TC, 0, 0}; pg8::HybridOrder S;
            if (pool) { g = pg8::Gemm{WP(const bf16_t, WS_U), WP(const bf16_t, WS_WPOOL) + (size_t)j * D * 512, Mrows, D, 512, D, 512}; E.a_grp_tiles = 2; E.a_grp_off = 512; S.init(Mrows, Mrows, D, 512, G, bid, 1); }
            else { g = pg8::Gemm{WP(const bf16_t, WS_P), WP(const bf16_t, WS_WO) + (size_t)j * D * D, Mrows, D, D, D, D}; S.init(TL, Mrows, D, D, G, bid, SPLIT_WO); }
            pg8::gemm_phase<pg8::EpiY, pg8::HybridOrder>(lds, g, S, E);
            PHASE_END(base + 3); }
        if (EN_S4 && IN(base + 4)) { SITE(); const float* modL = WP(const float, WS_MOD) + (size_t)L * 3 * NMOD; const float* gL = KIN(6) + (size_t)L * 4 * D;
            RN a; a.xin_lat = KIN(0); a.xin_ctx = KIN(2); a.hin = WP(const bf16_t, WS_H); a.Y = WP(const bf16_t, WS_Y); a.Yp = WP(const float, WS_YP); a.nparts = (!pool && Mrows > TL) ? SPLIT_WO : 0; a.gate = modL + 2 * D; a.gY = gL + D;
            a.hout = WP(bf16_t, WS_H); a.fout = nullptr; a.gN = gL + 2 * D; a.shift = modL + 3 * D; a.scale = modL + 4 * D; a.U = WP(bf16_t, WS_U); a.nrows = Mrows; a.modp = nullptr; a.bias = nullptr; a.mod_out = nullptr;
            if (L == 0) resid_norm<true, true, true, false, false, true>(a, lds, gw, ngw, tid); else if (pool) resid_norm<true, true, false, false, false, true>(a, lds, gw, ngw, tid); else resid_norm<true, true, false, false>(a, lds, gw, ngw, tid);
            PHASE_END(base + 4); }
        if (EN_S5 && IN(base + 5)) { SITE(); pg8::Gemm g{WP(const bf16_t, WS_U), WP(const bf16_t, WS_W13) + (size_t)L * 2 * DFF * D, Mrows, 2 * DFF, D, D, D}; pg8::StaticOrder S; S.init(Mrows, 2 * DFF, D, G, bid);
            pg8::EpiSwiGLU E{WP(bf16_t, WS_G), DFF};
            pg8::gemm_phase<pg8::EpiSwiGLU, pg8::StaticOrder>(lds, g, S, E);
            if (L < 3) { const int lo_ = L == 0 ? SEG1 : L == 1 ? SEG3 : SEG4, hi_ = L == 0 ? SEG2 : L == 1 ? SEG4 : SEG5; FILL_TAIL(GEMV_DEFER && L == 2 ? 3 : 0, lo_, hi_); }
            PHASE_END(base + 5); }
        if (EN_S6 && IN(base + 6)) { SITE();
            pg8::Gemm g{WP(const bf16_t, WS_G), WP(const bf16_t, WS_W2) + (size_t)L * D * DFF, Mrows, D, DFF, DFF, DFF}; pg8::HybridOrder S; S.init(TL, Mrows, D, DFF, G, bid, SPLIT_FFN2);
            pg8::EpiY E{WP(bf16_t, WS_Y), WP(float, WS_YP), D, TL, TC, 0, 0};
            pg8::gemm_phase<pg8::EpiY, pg8::HybridOrder>(lds, g, S, E);
            if (GEMV_DEFER && (L == 1 || L == 2)) { const float* mp2 = WP(const float, WS_MODP2) + (size_t)L * KSPL2 * 3 * NMOD; const float* bias = KIN(5) + (size_t)(L + 1) * NMOD; float* mo = WP(float, WS_MOD) + (size_t)(L + 1) * 3 * NMOD;
                for (int o = gtid; o < 3 * NMOD; o += ngt) { float acc = bias[o % NMOD];
#pragma unroll 16
                    for (int p = 0; p < KSPL2; ++p) acc += mp2[(size_t)p * 3 * NMOD + o];
                    mo[o] = acc; } }
            PHASE_END(base + 6); }
        if (EN_S7 && IN(base + 7)) { SITE(); const float* modL = WP(const float, WS_MOD) + (size_t)L * 3 * NMOD; const float* gL = KIN(6) + (size_t)L * 4 * D;
            RN a; a.xin_lat = nullptr; a.xin_ctx = nullptr; a.hin = WP(const bf16_t, WS_H); a.Y = WP(const bf16_t, WS_Y); a.Yp = WP(const float, WS_YP); a.nparts = L < 3 ? SPLIT_FFN2 : 0; a.gate = modL + 5 * D; a.gY = gL + 3 * D; a.modp = nullptr; a.bias = nullptr; a.mod_out = nullptr;
            if (L < 3) { a.hout = WP(bf16_t, WS_H); a.fout = nullptr; a.gN = gL + 4 * D; a.shift = modL + 3 * NMOD; a.scale = modL + 3 * NMOD + D; a.U = WP(bf16_t, WS_U); a.nrows = T;
                resid_norm<true, true, false, false>(a, lds, gw, ngw, tid); }
            else { a.hout = nullptr; a.fout = KOUT(); a.gN = nullptr; a.shift = nullptr; a.scale = nullptr; a.U = nullptr; a.nrows = TL;
                resid_norm<true, false, false, true>(a, lds, gw, ngw, tid); }
            PHASE_END(base + 7); }
    }
#undef IN
#undef PHASE_END
}

extern "C" void kernel_launch(void* const* d_in, const int* in_sizes, int n_in, void* d_out, int out_size, void* d_ws, size_t ws_size, hipStream_t stream) {
    static int grid = 0;
    if (grid == 0) {
        if (n_in != 18 || in_sizes[0] != TL * D || out_size != TL * D || ws_size < WS_END) { fprintf(stderr, "kernel_launch: unexpected shapes (n_in %d, in0 %d, out %d, ws %zu); nothing launched\n", n_in, n_in > 0 ? in_sizes[0] : -1, out_size, ws_size); grid = -1; return; }
        int dev = 0, cus = 0, per_cu = 0;
        if (hipGetDevice(&dev) != hipSuccess || hipDeviceGetAttribute(&cus, hipDeviceAttributeMultiprocessorCount, dev) != hipSuccess) { grid = -1; return; }
        if (hipFuncSetAttribute((const void*)mk_fwd, hipFuncAttributeMaxDynamicSharedMemorySize, LDS_BYTES) != hipSuccess) { fprintf(stderr, "kernel_launch: hipFuncSetAttribute failed\n"); grid = -1; return; }
        if (hipOccupancyMaxActiveBlocksPerMultiprocessor(&per_cu, (const void*)mk_fwd, NTHREADS, LDS_BYTES) != hipSuccess || per_cu < 1) { fprintf(stderr, "kernel_launch: occupancy query says %d blocks per CU\n", per_cu); }
        (void)hipGetLastError();
        grid = cus;
    }
    if (grid < 0) return;
    if (hipMemsetAsync((char*)d_ws + WS_CTL, 0, CTL_ZERO_BYTES, stream) != hipSuccess) return;
    Args a{};
    for (int i = 0; i < 18; ++i) a.in[i] = (const float*)d_in[i];
    a.out = (float*)d_out; a.ws = (unsigned char*)d_ws;
#if MK_PER_PHASE
    for (int p = 0; p < N_PHASES; ++p) { const int k = p - 2, L = k >> 3, s = k & 7; if (p >= 2 && (L & 1) == 0 && s <= 2) continue;
        a.ph_lo = p; a.ph_hi = p + 1; hipLaunchKernelGGL(mk_fwd, dim3(grid), dim3(NTHREADS), LDS_BYTES, stream, a); }
#else
    a.ph_lo = 0; a.ph_hi = N_PHASES; hipLaunchKernelGGL(mk_fwd, dim3(grid), dim3(NTHREADS), LDS_BYTES, stream, a);
#endif
    const hipError_t le = hipPeekAtLastError();
    if (le != hipSuccess) fprintf(stderr, "kernel_launch: launch failed: %s\n", hipGetErrorName(le));
}
```

```cpp
#include <hip/hip_runtime.h>
#include <cstdio>
#include <cstdint>

#ifndef MK_PER_PHASE
#define MK_PER_PHASE 0
#endif

#define LAS __attribute__((address_space(3)))
#define GAS __attribute__((address_space(1)))
typedef unsigned short bf16_t;
typedef short bf16x8 __attribute__((ext_vector_type(8)));
typedef short s16x4 __attribute__((ext_vector_type(4)));
typedef float f32x4 __attribute__((ext_vector_type(4)));
typedef float f32x2 __attribute__((ext_vector_type(2)));
typedef float f32x16 __attribute__((ext_vector_type(16)));
typedef unsigned u32x4 __attribute__((ext_vector_type(4)));
typedef unsigned u32x2 __attribute__((ext_vector_type(2)));

constexpr int D = 2048, SEQ = 8192, NB = 2, CTXL = 256, TL = NB * SEQ, TC = NB * CTXL, T = TL + TC;
constexpr int DFF = 5632, NH = 16, QKD = 192, NOPE = 128, ROPED = 64, VD = 128, QL = 512, KVL = 512;
constexpr int NDQKV = 1280;
constexpr int NQ = NH * QKD, NKV = NH * (NOPE + VD), NUP = NQ + NKV;
constexpr int NMOD = 6 * D;
constexpr float RMS_EPS = 1e-6f;
constexpr int NWAVES = 8, NTHREADS = 512;

__device__ __forceinline__ unsigned cvt_pk_bf16(float lo, float hi) { unsigned r; asm volatile("v_cvt_pk_bf16_f32 %0, %1, %2" : "=v"(r) : "v"(lo), "v"(hi)); return r; }
__device__ __forceinline__ float bf_lo(unsigned w) { return __uint_as_float(w << 16); }
__device__ __forceinline__ float bf_hi(unsigned w) { return __uint_as_float(w & 0xffff0000u); }
__device__ __forceinline__ float wave_sum(float v) {
    int ln_ = threadIdx.x & 63; asm volatile("" : "+v"(ln_));
#pragma unroll
    for (int o = 1; o < 64; o <<= 1) v += __int_as_float(__builtin_amdgcn_ds_bpermute((ln_ ^ o) << 2, __float_as_int(v)));
    return v;
}

namespace pg8 {
constexpr int BM = 256, BK = 64, HALF = 128, HTB = HALF * BK * 2, STAGE_BYTES = 8 * HTB, NXCD = 8, WGM = 4;
__host__ __device__ __forceinline__ int lds_byte(int r, int c) { const int st = (r >> 4) * 2 + (c >> 5), rr = r & 15, cc = c & 31, ob = rr * 64 + cc * 2; return st * 1024 + (ob ^ (((ob >> 9) & 1) << 5)); }
__host__ __device__ __forceinline__ void stage_rc(int b, int& R, int& C) { const int st = b / 1024, sb = b % 1024, swz = sb ^ (((sb >> 9) & 1) << 5); R = (st >> 1) * 16 + swz / 64; C = (st & 1) * 32 + (swz % 64) / 2; }
__host__ __device__ __forceinline__ int perm32(int rho) { const int n = rho >> 4, i = rho & 15; return 8 * (i >> 2) + 4 * n + (i & 3); }

struct Unit { int pm, pn, kt0, nkt, part; };
struct Gemm { const bf16_t* A; const bf16_t* Bt; int M, N, K, lda, ldb; };

struct StaticOrder {
    int nM, nN, nwg, G, c, nkt;
    __host__ __device__ void init(int M, int N, int K, int G_, int c_) { nM = M / BM; nN = N / BM; nwg = nM * nN; G = G_; c = c_; nkt = K / BK; }
    __host__ __device__ bool next(int i, Unit& u) const {
        const long L = (long)i * G + c; if (L >= nwg) return false;
        int wgid = (int)L; { const int q = nwg / NXCD, r = nwg % NXCD, xcd = wgid % NXCD, off = wgid / NXCD; wgid = (xcd < r ? xcd * (q + 1) : r * (q + 1) + (xcd - r) * q) + off; }
        const int nig = WGM * nN, gid = wgid / nig, fm = gid * WGM, gsz = (nM - fm) < WGM ? (nM - fm) : WGM;
        u.pm = fm + ((wgid % nig) % gsz); u.pn = (wgid % nig) / gsz; u.kt0 = 0; u.nkt = nkt; u.part = -1; return true;
    }
};
struct HybridOrder {
    StaticOrder full; int nfull, nsplit, S, nktp, nN, pm0, G, c;
    __host__ __device__ void init(int Mfull, int Mtot, int N, int K, int G_, int c_, int S_) { full.init(Mfull, N, K, G_, c_); nfull = full.nwg; nN = N / BM; pm0 = Mfull / BM; S = S_; nktp = (K / BK) / S_;
        nsplit = ((Mtot - Mfull) / BM) * nN * S_; G = G_; c = c_; }
    __host__ __device__ bool next(int i, Unit& u) const {
        const long L = (long)i * G + c; if (L < nfull) return full.next(i, u);
        const int e = (int)(L - nfull); if (e >= nsplit) return false;
        const int part = e % S, tile = e / S; u.pm = pm0 + tile / nN; u.pn = tile % nN; u.kt0 = part * nktp; u.nkt = nktp; u.part = part; return true;
    }
};

template <class Epi, class Sched, bool ALIGN_EPI = true>
__device__ __forceinline__ void gemm_phase(LAS unsigned char* lds, const Gemm g, const Sched& S, const Epi& E) {
    int tid = threadIdx.x; asm volatile("" : "+v"(tid));
    const int wid = __builtin_amdgcn_readfirstlane(tid >> 6), lane = tid & 63, wr = wid >> 2, wc = wid & 3, fr = lane & 15, fq = lane >> 4;
    unsigned voffA[2], voffB[2];
#pragma unroll
    for (int i = 0; i < 2; ++i) { int R, C; stage_rc(tid * 16 + i * 8192, R, C); const int Rb = (R & ~31) + perm32(R & 31);
        voffA[i] = (unsigned)(R * g.lda + C) * 2u; voffB[i] = (unsigned)(Rb * g.ldb + C) * 2u; }
    const size_t kstep = (size_t)(BK * 2);
    const size_t hstepA = (size_t)HALF * g.lda * 2, hstepB = (size_t)HALF * g.ldb * 2;
    const size_t tstepA = 2 * hstepA, tstepB = 2 * hstepB;
    const unsigned ldsw = (unsigned)wid * 1024u;
    const int aoff = lds_byte(wr * 64 + fr, fq * 8), boff = lds_byte(wc * 32 + fr, fq * 8);
#define PG8_SA(b, h) (((b) * 2 + (h)) * HTB)
#define PG8_SB(b, h) ((4 + (b) * 2 + (h)) * HTB)
#define PG8_STAGE(bufoff, gbase, voff) do { _Pragma("unroll") for (int _i = 0; _i < 2; ++_i) \
        __builtin_amdgcn_global_load_lds((const unsigned*)((const char*)(gbase) + (voff)[_i]), (LAS unsigned*)(lds + (bufoff) + ldsw + _i * 8192), 16, 0, 0); } while (0)
#define PG8_LDA(dst, b, h) do { _Pragma("unroll") for (int m = 0; m < 4; ++m) _Pragma("unroll") for (int k = 0; k < 2; ++k) dst[m][k] = *(const LAS bf16x8*)(lds + PG8_SA(b, h) + aoff + m * 2048 + k * 1024); } while (0)
#define PG8_LDB(dst, b, h) do { _Pragma("unroll") for (int n = 0; n < 2; ++n) _Pragma("unroll") for (int k = 0; k < 2; ++k) dst[n][k] = *(const LAS bf16x8*)(lds + PG8_SB(b, h) + boff + n * 2048 + k * 1024); } while (0)
#define PG8_MMA(ai, bj, At, Bt) do { __builtin_amdgcn_s_setprio(1); _Pragma("unroll") for (int m = 0; m < 4; ++m) _Pragma("unroll") for (int n = 0; n < 2; ++n) _Pragma("unroll") for (int k = 0; k < 2; ++k) \
        acc[ai][bj][m][n] = __builtin_amdgcn_mfma_f32_16x16x32_bf16(Bt[n][k], At[m][k], acc[ai][bj][m][n], 0, 0, 0); __builtin_amdgcn_s_setprio(0); } while (0)
#define PG8_WAIT_V(n) asm volatile("s_waitcnt vmcnt(" #n ")" ::: "memory")
#define PG8_WAIT_L(n) asm volatile("s_waitcnt lgkmcnt(" #n ")" ::: "memory")
#define PG8_BAR __builtin_amdgcn_s_barrier()
#define PG8_SCHED __builtin_amdgcn_sched_barrier(0)
    Unit cur, nxt; int ui = 0;
    if (!S.next(0, cur)) return;
    f32x4 acc[2][2][4][2];
#pragma unroll
    for (int a = 0; a < 2; ++a)
#pragma unroll
        for (int b = 0; b < 2; ++b)
#pragma unroll
            for (int m = 0; m < 4; ++m)
#pragma unroll
                for (int n = 0; n < 2; ++n) acc[a][b][m][n] = (f32x4){0.f, 0.f, 0.f, 0.f};
    bf16x8 At[4][2], B0[2][2], B1[2][2];
    const char* cA = (const char*)g.A + (size_t)cur.pm * tstepA + (size_t)E.a_off(cur.pn) * 2 + (size_t)cur.kt0 * kstep; const char* cB = (const char*)g.Bt + (size_t)cur.pn * tstepB + (size_t)cur.kt0 * kstep;
    PG8_STAGE(PG8_SB(0, 0), cB, voffB); PG8_STAGE(PG8_SB(0, 1), cB + hstepB, voffB); PG8_STAGE(PG8_SA(0, 0), cA, voffA); PG8_STAGE(PG8_SA(0, 1), cA + hstepA, voffA);
    if (wr == 1) PG8_BAR;
    PG8_WAIT_V(2); PG8_BAR;
    PG8_STAGE(PG8_SB(1, 0), cB + kstep, voffB); PG8_STAGE(PG8_SA(1, 0), cA + kstep, voffA); PG8_STAGE(PG8_SB(1, 1), cB + hstepB + kstep, voffB);
    PG8_WAIT_V(6); PG8_BAR;
    for (;;) {
        const bool has_next = S.next(ui + 1, nxt);
        const char* nA = has_next ? (const char*)g.A + (size_t)nxt.pm * tstepA + (size_t)E.a_off(nxt.pn) * 2 + (size_t)nxt.kt0 * kstep : cA; const char* nB = has_next ? (const char*)g.Bt + (size_t)nxt.pn * tstepB + (size_t)nxt.kt0 * kstep : cB;
        const int nt = cur.nkt;
        asm volatile(".p2align 6");
        for (int t = 0; t < nt; t += 2) {
            const bool last = (t == nt - 2);
            const char* a1 = cA + (size_t)(t + 1) * kstep;
            const char* a2 = last ? nA : cA + (size_t)(t + 2) * kstep; const char* b2 = last ? nB : cB + (size_t)(t + 2) * kstep;
            const char* a3 = a2 + kstep; const char* b3 = b2 + kstep;
            PG8_LDB(B0, 0, 0); PG8_LDB(B1, 0, 1); PG8_SCHED; PG8_LDA(At, 0, 0); PG8_STAGE(PG8_SA(1, 1), a1 + hstepA, voffA);
            PG8_WAIT_V(8); PG8_WAIT_L(0); PG8_BAR; PG8_MMA(0, 0, At, B0); PG8_MMA(0, 1, At, B1); PG8_BAR; PG8_SCHED;
            PG8_LDA(At, 0, 1); PG8_STAGE(PG8_SB(0, 0), b2, voffB); PG8_STAGE(PG8_SB(0, 1), b2 + hstepB, voffB); PG8_STAGE(PG8_SA(0, 0), a2, voffA);
            PG8_WAIT_V(8); PG8_WAIT_L(0); PG8_BAR; PG8_MMA(1, 0, At, B0); PG8_MMA(1, 1, At, B1); PG8_BAR; PG8_SCHED;
            PG8_LDB(B0, 1, 0); PG8_LDB(B1, 1, 1); PG8_SCHED; PG8_LDA(At, 1, 0); PG8_STAGE(PG8_SA(0, 1), a2 + hstepA, voffA);
            PG8_WAIT_V(8); PG8_WAIT_L(0); PG8_BAR; PG8_MMA(0, 0, At, B0); PG8_MMA(0, 1, At, B1); PG8_BAR; PG8_SCHED;
            PG8_LDA(At, 1, 1); PG8_STAGE(PG8_SB(1, 0), b3, voffB); PG8_STAGE(PG8_SB(1, 1), b3 + hstepB, voffB); PG8_STAGE(PG8_SA(1, 0), a3, voffA);
            PG8_WAIT_V(8); PG8_WAIT_L(0); PG8_BAR; PG8_MMA(1, 0, At, B0); PG8_MMA(1, 1, At, B1); PG8_BAR; PG8_SCHED;
        }
        if constexpr (ALIGN_EPI) { if (wr == 0) PG8_BAR; }
        E(acc, cur, wr, wc, fr, fq);
        if (!has_next) break;
#pragma unroll
        for (int a = 0; a < 2; ++a)
#pragma unroll
            for (int b = 0; b < 2; ++b)
#pragma unroll
                for (int m = 0; m < 4; ++m)
#pragma unroll
                    for (int n = 0; n < 2; ++n) acc[a][b][m][n] = (f32x4){0.f, 0.f, 0.f, 0.f};
        cur = nxt; cA = nA; cB = nB; ++ui;
        if constexpr (ALIGN_EPI) { if (wr == 1) PG8_BAR; }
    }
    PG8_WAIT_V(0);
    if constexpr (!ALIGN_EPI) { if (wr == 0) PG8_BAR; }
    PG8_BAR;
#undef PG8_SA
#undef PG8_SB
#undef PG8_STAGE
#undef PG8_LDA
#undef PG8_LDB
#undef PG8_MMA
#undef PG8_WAIT_V
#undef PG8_WAIT_L
#undef PG8_BAR
#undef PG8_SCHED
}

#ifndef EPI_SC1
#define EPI_SC1 0
#endif
__device__ __forceinline__ void st16(void* p, u32x4 w) {
#if EPI_SC1
    asm volatile("global_store_dwordx4 %0, %1, off sc1\n\ts_nop 1" :: "v"(p), "v"(w) : "memory");
#else
    *(u32x4*)p = w;
#endif
}
struct EpiStore {
    bf16_t* O; int ldc; float* ssq0; float* ssq1; int split0, split1; int a_grp_tiles, a_grp_off;
    __device__ __forceinline__ int a_off(int pn) const { return a_grp_tiles ? (pn / a_grp_tiles) * a_grp_off : 0; }
    __device__ __forceinline__ void operator()(const f32x4 (&acc)[2][2][4][2], const Unit& u, int wr, int wc, int fr, int fq) const {
        const int row0 = u.pm * BM + wr * 64 + fr, col0 = u.pn * BM + wc * 32 + 8 * fq;
        float* ssq = u.pn < split0 ? ssq0 : (u.pn < split1 ? ssq1 : nullptr);
#pragma unroll
        for (int ai = 0; ai < 2; ++ai)
#pragma unroll
            for (int m = 0; m < 4; ++m) { const int row = row0 + ai * HALF + m * 16; bf16_t* rowp = O + (size_t)row * ldc + col0; float s = 0.f;
#pragma unroll
                for (int bj = 0; bj < 2; ++bj) { const f32x4 v0 = acc[ai][bj][m][0], v1 = acc[ai][bj][m][1];
                    s += (v0[0] * v0[0] + v0[1] * v0[1]) + (v0[2] * v0[2] + v0[3] * v0[3]) + (v1[0] * v1[0] + v1[1] * v1[1]) + (v1[2] * v1[2] + v1[3] * v1[3]);
                    u32x4 w; w.x = cvt_pk_bf16(v0[0], v0[1]); w.y = cvt_pk_bf16(v0[2], v0[3]); w.z = cvt_pk_bf16(v1[0], v1[1]); w.w = cvt_pk_bf16(v1[2], v1[3]);
                    st16(rowp + bj * HALF, w); }
                if (ssq) { const int ln_ = (fq << 4) | fr; s += __int_as_float(__builtin_amdgcn_ds_bpermute((ln_ ^ 16) << 2, __float_as_int(s))); s += __int_as_float(__builtin_amdgcn_ds_bpermute((ln_ ^ 32) << 2, __float_as_int(s))); if (fq == 0) ssq[(size_t)row * 8 + (u.pn & 1) * 4 + wc] = s; } }
    }
};
struct EpiY {
    bf16_t* O; float* Yp; int ldc, row_split, nsplit_rows; int a_grp_tiles, a_grp_off;
    __device__ __forceinline__ int a_off(int pn) const { return a_grp_tiles ? (pn / a_grp_tiles) * a_grp_off : 0; }
    __device__ __forceinline__ void operator()(const f32x4 (&acc)[2][2][4][2], const Unit& u, int wr, int wc, int fr, int fq) const {
        const int row0 = u.pm * BM + wr * 64 + fr, col0 = u.pn * BM + wc * 32 + 8 * fq;
        if (u.part < 0) {
#pragma unroll
            for (int ai = 0; ai < 2; ++ai)
#pragma unroll
                for (int m = 0; m < 4; ++m) { bf16_t* rowp = O + (size_t)(row0 + ai * HALF + m * 16) * ldc + col0;
#pragma unroll
                    for (int bj = 0; bj < 2; ++bj) { const f32x4 v0 = acc[ai][bj][m][0], v1 = acc[ai][bj][m][1];
                        u32x4 w; w.x = cvt_pk_bf16(v0[0], v0[1]); w.y = cvt_pk_bf16(v0[2], v0[3]); w.z = cvt_pk_bf16(v1[0], v1[1]); w.w = cvt_pk_bf16(v1[2], v1[3]);
                        st16(rowp + bj * HALF, w); } }
        } else { float* slab = Yp + (size_t)u.part * nsplit_rows * ldc;
#pragma unroll
            for (int ai = 0; ai < 2; ++ai)
#pragma unroll
                for (int m = 0; m < 4; ++m) { float* rowp = slab + (size_t)(row0 + ai * HALF + m * 16 - row_split) * ldc + col0;
#pragma unroll
                    for (int bj = 0; bj < 2; ++bj) { *(f32x4*)(rowp + bj * HALF) = acc[ai][bj][m][0]; *(f32x4*)(rowp + bj * HALF + 4) = acc[ai][bj][m][1]; } }
        }
    }
};
struct EpiSwiGLU {
    bf16_t* O; int ldc;
    __device__ __forceinline__ int a_off(int) const { return 0; }
    __device__ __forceinline__ void operator()(const f32x4 (&acc)[2][2][4][2], const Unit& u, int wr, int wc, int fr, int fq) const {
        const int row0 = u.pm * BM + wr * 64 + fr, col0 = u.pn * HALF + wc * 32 + 8 * fq;
#pragma unroll
        for (int ai = 0; ai < 2; ++ai)
#pragma unroll
            for (int m = 0; m < 4; ++m) { const int row = row0 + ai * HALF + m * 16; float gv[8];
#pragma unroll
                for (int n = 0; n < 2; ++n)
#pragma unroll
                    for (int j = 0; j < 4; ++j) { const float a = acc[ai][0][m][n][j], b = acc[ai][1][m][n][j]; gv[n * 4 + j] = a * __builtin_amdgcn_rcpf(1.f + __expf(-a)) * b; }
                u32x4 w; w.x = cvt_pk_bf16(gv[0], gv[1]); w.y = cvt_pk_bf16(gv[2], gv[3]); w.z = cvt_pk_bf16(gv[4], gv[5]); w.w = cvt_pk_bf16(gv[6], gv[7]);
                st16(O + (size_t)row * ldc + col0, w); }
    }
};
struct EpiUp {
    bf16_t* Q; bf16_t* KV; const float* ssq_q; const float* ssq_kv;
    __device__ __forceinline__ int a_off(int pn) const { return pn < NQ / BM ? 0 : QL; }
    __device__ __forceinline__ void operator()(const f32x4 (&acc)[2][2][4][2], const Unit& u, int wr, int wc, int fr, int fq) const {
        const bool isq = u.pn < NQ / BM; const int ldc = isq ? NQ : NKV; bf16_t* O = isq ? Q : KV; const float* ssq = isq ? ssq_q : ssq_kv;
        const int row0 = u.pm * BM + wr * 64 + fr, col0 = (isq ? u.pn : u.pn - NQ / BM) * BM + wc * 32 + 8 * fq;
        float rs[2][4];
#pragma unroll
        for (int ai = 0; ai < 2; ++ai)
#pragma unroll
            for (int m = 0; m < 4; ++m) { const int row = row0 + ai * HALF + m * 16;
                const f32x4 sa = *(const f32x4*)(ssq + (size_t)row * 8), sb = *(const f32x4*)(ssq + (size_t)row * 8 + 4);
                rs[ai][m] = __builtin_amdgcn_rsqf((((sa[0] + sa[1]) + (sa[2] + sa[3])) + ((sb[0] + sb[1]) + (sb[2] + sb[3]))) * (1.f / 512.f) + RMS_EPS); }
#pragma unroll
        for (int ai = 0; ai < 2; ++ai)
#pragma unroll
            for (int m = 0; m < 4; ++m) { const int row = row0 + ai * HALF + m * 16; bf16_t* rowp = O + (size_t)row * ldc + col0;
#pragma unroll
                for (int bj = 0; bj < 2; ++bj) { const f32x4 v0 = acc[ai][bj][m][0] * rs[ai][m], v1 = acc[ai][bj][m][1] * rs[ai][m];
                    u32x4 w; w.x = cvt_pk_bf16(v0[0], v0[1]); w.y = cvt_pk_bf16(v0[2], v0[3]); w.z = cvt_pk_bf16(v1[0], v1[1]); w.w = cvt_pk_bf16(v1[2], v1[3]);
                    st16(rowp + bj * HALF, w); } }
    }
};
}
namespace att {
constexpr int QBLK = 32, KVBLK = 64;
constexpr float SCALE = 0.07216878364870322f;
constexpr float THR = 8.f;
#ifndef ATT_SDEPTH
#define ATT_SDEPTH 1
#endif
constexpr int SDEPTH = ATT_SDEPTH;
constexpr int SHM_V = KVBLK * VD * 2, SHM_K = KVBLK * QKD * 2;
constexpr int LDS_BYTES = 2 * SHM_V + 2 * SHM_K + NWAVES * 64 * 4;
#define KOFF(row, ch) ((row) * 384 + ((((ch) ^ (((row) >> 1) & 7))) << 4))
#define SBAR() __builtin_amdgcn_sched_barrier(0)
__device__ __forceinline__ int crow(int r, int hi) { return (r & 3) + 8 * (r >> 2) + 4 * hi; }

__device__ __forceinline__ void finishSM(f32x16& p0, f32x16& p1, float alpha, float& l_reg, bf16x8& pa0, bf16x8& pa1, bf16x8& pa2, bf16x8& pa3) {
#pragma unroll
    for (int r = 0; r < 16; ++r) p1[r] = __builtin_amdgcn_exp2f(p1[r]);
    float ps = 0;
#pragma unroll
    for (int r = 0; r < 16; ++r) ps += p0[r];
#pragma unroll
    for (int r = 0; r < 16; ++r) ps += p1[r];
    { auto rr = __builtin_amdgcn_permlane32_swap(__float_as_uint(ps), __float_as_uint(ps), false, false);
      ps = __uint_as_float(rr[0]) + __uint_as_float(rr[1]); }
    l_reg = l_reg * alpha + ps;
#define PK8(P, BASE, OUT) do { u32x4 w = {cvt_pk_bf16(P[BASE + 0], P[BASE + 1]), cvt_pk_bf16(P[BASE + 2], P[BASE + 3]), cvt_pk_bf16(P[BASE + 4], P[BASE + 5]), cvt_pk_bf16(P[BASE + 6], P[BASE + 7])}; \
    OUT = *reinterpret_cast<bf16x8*>(&w); } while (0)
    PK8(p0, 0, pa0); PK8(p0, 8, pa1); PK8(p1, 0, pa2); PK8(p1, 8, pa3);
#undef PK8
}
__device__ __forceinline__ int v_st(int k, int c) { const int kk = (k & ~0xC) | ((k & 4) << 1) | ((k & 8) >> 1); return ((kk >> 3) * 4 + (c >> 5)) * 512 + ((kk & 7) * 32 + (c & 31)) * 2; }
__device__ __forceinline__ int v_rd_base(int lane) { return ((lane & 3) << 3) | (((lane >> 2) & 3) << 6) | (((lane >> 4) & 1) << 5) | (((lane >> 5) & 1) << 8); }
constexpr int v_rd_off(int d0, int ks, int half) { return d0 * 512 + ks * 4096 + half * 2048; }
template <int OFF> __device__ __forceinline__ s16x4 tr_read(int vb) {
    s16x4 r; asm volatile("ds_read_b64_tr_b16 %0, %1 offset:%2" : "=&v"(r) : "v"(vb), "i"(OFF) : "memory"); return r;
}
template <int D0> __device__ __forceinline__ void pv_one(f32x16& od, int vb, bf16x8 pa0, bf16x8 pa1, bf16x8 pa2, bf16x8 pa3) {
    const s16x4 l0 = tr_read<v_rd_off(D0, 0, 0)>(vb), h0 = tr_read<v_rd_off(D0, 0, 1)>(vb), l1 = tr_read<v_rd_off(D0, 1, 0)>(vb), h1 = tr_read<v_rd_off(D0, 1, 1)>(vb);
    const s16x4 l2 = tr_read<v_rd_off(D0, 2, 0)>(vb), h2 = tr_read<v_rd_off(D0, 2, 1)>(vb), l3 = tr_read<v_rd_off(D0, 3, 0)>(vb), h3 = tr_read<v_rd_off(D0, 3, 1)>(vb);
    asm volatile("s_waitcnt lgkmcnt(0)" ::: "memory"); SBAR();
#define PK(L, H) (bf16x8){L[0], L[1], L[2], L[3], H[0], H[1], H[2], H[3]}
    od = __builtin_amdgcn_mfma_f32_32x32x16_bf16(pa0, PK(l0, h0), od, 0, 0, 0);
    od = __builtin_amdgcn_mfma_f32_32x32x16_bf16(pa1, PK(l1, h1), od, 0, 0, 0);
    od = __builtin_amdgcn_mfma_f32_32x32x16_bf16(pa2, PK(l2, h2), od, 0, 0, 0);
    od = __builtin_amdgcn_mfma_f32_32x32x16_bf16(pa3, PK(l3, h3), od, 0, 0, 0);
#undef PK
}
__device__ __forceinline__ void pv_d0(f32x16* o, int vb, bf16x8 pa0, bf16x8 pa1, bf16x8 pa2, bf16x8 pa3) {
    pv_one<0>(o[0], vb, pa0, pa1, pa2, pa3); pv_one<1>(o[1], vb, pa0, pa1, pa2, pa3); pv_one<2>(o[2], vb, pa0, pa1, pa2, pa3); pv_one<3>(o[3], vb, pa0, pa1, pa2, pa3);
}
__device__ __forceinline__ void rope8(bf16x8& x1, bf16x8& x2, const float* tab) {
    u32x4 a = *reinterpret_cast<u32x4*>(&x1), b = *reinterpret_cast<u32x4*>(&x2), oa, ob;
#pragma unroll
    for (int w = 0; w < 4; ++w) {
        const f32x4 cs = *reinterpret_cast<const f32x4*>(tab + 4 * w);
        const float a0 = bf_lo(a[w]), a1 = bf_hi(a[w]), b0 = bf_lo(b[w]), b1 = bf_hi(b[w]);
        oa[w] = cvt_pk_bf16(a0 * cs[0] - b0 * cs[1], a1 * cs[2] - b1 * cs[3]);
        ob[w] = cvt_pk_bf16(b0 * cs[0] + a0 * cs[1], b1 * cs[2] + a1 * cs[3]);
    }
    x1 = *reinterpret_cast<bf16x8*>(&oa); x2 = *reinterpret_cast<bf16x8*>(&ob);
}

struct Unit { const bf16_t* Qb; const bf16_t* KVh; bf16_t* Ob; int kb_lat, nt_lat, kb_ctx, NT, qpos0; };

constexpr int SLOT = 40960, KR_OFF = 16384, V_OFF = 24576, LDS2_BYTES = 3 * SLOT + NWAVES * 64 * 4;
constexpr float THRL = THR * 1.4426950408889634f;
#ifndef ATT_MARGIN
#define ATT_MARGIN 100.f
#endif
__device__ __forceinline__ void qkt2n(f32x16& p0, f32x16& p1, LAS const char* lds, int kn, int kr, const bf16x8* qr, const f32x16& negm) {
#pragma unroll
    for (int d0 = 0; d0 < 8; ++d0) { const int a = kn ^ (d0 << 5);
        const bf16x8 b0 = *reinterpret_cast<LAS const bf16x8*>(lds + a), b1 = *reinterpret_cast<LAS const bf16x8*>(lds + a + 32 * 256);
        if (d0 == 0) { p0 = __builtin_amdgcn_mfma_f32_32x32x16_bf16(b0, qr[0], negm, 0, 0, 0); p1 = __builtin_amdgcn_mfma_f32_32x32x16_bf16(b1, qr[0], negm, 0, 0, 0); }
        else { p0 = __builtin_amdgcn_mfma_f32_32x32x16_bf16(b0, qr[d0], p0, 0, 0, 0); p1 = __builtin_amdgcn_mfma_f32_32x32x16_bf16(b1, qr[d0], p1, 0, 0, 0); } }
#pragma unroll
    for (int d0 = 0; d0 < 4; ++d0) { const int a = kr ^ (d0 << 5);
        const bf16x8 b0 = *reinterpret_cast<LAS const bf16x8*>(lds + a), b1 = *reinterpret_cast<LAS const bf16x8*>(lds + a + 32 * 128);
        p0 = __builtin_amdgcn_mfma_f32_32x32x16_bf16(b0, qr[8 + d0], p0, 0, 0, 0); p1 = __builtin_amdgcn_mfma_f32_32x32x16_bf16(b1, qr[8 + d0], p1, 0, 0, 0); }
}
template <bool FIRST>
__device__ __forceinline__ void partialSM2(f32x16& p0, f32x16& p1, float& m_reg, f32x16& negm, float& alpha, float margin = 0.f) {
    float pmax = p0[0];
#pragma unroll
    for (int r = 1; r < 16; ++r) pmax = fmaxf(pmax, p0[r]);
#pragma unroll
    for (int r = 0; r < 16; ++r) pmax = fmaxf(pmax, p1[r]);
    { auto rr = __builtin_amdgcn_permlane32_swap(__float_as_uint(pmax), __float_as_uint(pmax), false, false);
      pmax = fmaxf(__uint_as_float(rr[0]), __uint_as_float(rr[1])); }
    alpha = 1.f;
    if (FIRST || !__builtin_expect(__all(pmax <= THRL), 1)) {
        const float delta = FIRST ? pmax + margin : fmaxf(pmax, 0.f);
        if (!FIRST) alpha = __builtin_amdgcn_exp2f(-delta);
        m_reg += delta;
#pragma unroll
        for (int r = 0; r < 16; ++r) { p0[r] -= delta; p1[r] -= delta; negm[r] = -m_reg; }
    }
#pragma unroll
    for (int r = 0; r < 16; ++r) p0[r] = __builtin_amdgcn_exp2f(p0[r]);
}
__device__ __forceinline__ void exp_half(f32x16& p0) {
#pragma unroll
    for (int r = 0; r < 16; ++r) p0[r] = __builtin_amdgcn_exp2f(p0[r]);
}
template <bool FIXM>
__device__ __forceinline__ void attn_unit6(const Unit& U, const bf16_t* __restrict__ KR, const float* __restrict__ ropetab, LAS unsigned char* lds) {
    int tid = threadIdx.x; asm volatile("" : "+v"(tid));
    const int wid = __builtin_amdgcn_readfirstlane(tid >> 6), lane = tid & 63, r32 = lane & 31, hi = lane >> 5;
    LAS float* wsf = (LAS float*)(lds + 3 * SLOT) + wid * 64; LAS float* li_l = wsf; LAS float* al_l = wsf + 32;
    float m_reg = 0.f, l_reg = 0; f32x16 o[4] = {}; bf16x8 qr[12]; f32x16 negm = {};
    const bf16_t* Qw = U.Qb + (size_t)(wid * QBLK + r32) * NQ + hi * 8;
#pragma unroll
    for (int d0 = 0; d0 < 12; ++d0) qr[d0] = *reinterpret_cast<const bf16x8*>(Qw + d0 * 16);
    if (U.qpos0 >= 0) { const int t = U.qpos0 + wid * QBLK + r32, pr = t >> 6, pc = t & 63;
        rope8(qr[8], qr[9], ropetab + (pr * 16 + hi * 8) * 2); rope8(qr[10], qr[11], ropetab + (pc * 16 + hi * 8) * 2); }
    unsigned von[2], vov[2], vor;
#pragma unroll
    for (int i = 0; i < 2; ++i) { const int p = (wid * 2 + i) * 64 + lane;
        { const int row = p >> 4, c = (p & 15) ^ (row & 15); von[i] = (unsigned)(row * (NKV * 2) + c * 16); }
        { const int sub = p >> 5, within = p & 31, k = (sub >> 2) * 8 + (within >> 2), c = (sub & 3) * 32 + (within & 3) * 8;     vov[i] = (unsigned)(k * (NKV * 2) + NOPE * 2 + c * 2); } }
    { const int p = wid * 64 + lane, row = p >> 3, c = (p & 7) ^ ((row >> 1) & 7); vor = (unsigned)(row * (ROPED * 2) + c * 16); }
    const int kn0 = r32 * 256 + ((hi ^ (r32 & 15)) << 4), kr0 = KR_OFF + r32 * 128 + ((hi ^ ((r32 >> 1) & 7)) << 4), vb0 = (int)(uintptr_t)lds + V_OFF + v_rd_base(lane);
    const int nt_lat = U.nt_lat, kb_lat = U.kb_lat, kb_ctx = U.kb_ctx - 64 * nt_lat, NT = U.NT;
    const bf16_t* KVh = U.KVh;
    const unsigned ldsw2 = (unsigned)wid * 2048u, ldsw1 = (unsigned)wid * 1024u;
#define KROW(j) (((j) < nt_lat ? kb_lat : kb_ctx) + 64 * (j))
#define DMA(j, so) do { const size_t _k = (size_t)KROW(j); const char* _kv = (const char*)KVh + _k * (NKV * 2); const char* _kr = (const char*)KR + _k * (ROPED * 2); \
    __builtin_amdgcn_global_load_lds((const unsigned*)(_kv + von[0]), (LAS unsigned*)(lds + (so) + ldsw2), 16, 0, 0); \
    __builtin_amdgcn_global_load_lds((const unsigned*)(_kv + von[1]), (LAS unsigned*)(lds + (so) + ldsw2 + 1024), 16, 0, 0); \
    __builtin_amdgcn_global_load_lds((const unsigned*)(_kr + vor), (LAS unsigned*)(lds + (so) + KR_OFF + ldsw1), 16, 0, 0); \
    __builtin_amdgcn_global_load_lds((const unsigned*)(_kv + vov[0]), (LAS unsigned*)(lds + (so) + V_OFF + ldsw2), 16, 0, 0); \
    __builtin_amdgcn_global_load_lds((const unsigned*)(_kv + vov[1]), (LAS unsigned*)(lds + (so) + V_OFF + ldsw2 + 1024), 16, 0, 0); } while (0)
#define TILE_BAR() asm volatile("s_waitcnt vmcnt(0) lgkmcnt(0)\n\ts_barrier" ::: "memory")
#define RESC2(a) do { if (__any((a) < 1.f)) { if (hi == 0) al_l[r32] = (a); asm volatile("s_waitcnt lgkmcnt(0)" ::: "memory"); \
    _Pragma("unroll") for (int d = 0; d < 4; ++d) _Pragma("unroll") for (int r = 0; r < 16; ++r) o[d][r] *= al_l[crow(r, hi)]; } } while (0)
    f32x16 pA0, pA1, pB0, pB1; float alA, alB; bf16x8 pa0, pa1, pa2, pa3;
    int s_prev = 0, s_cur = SLOT, s_next = 2 * SLOT;
    DMA(0, 0); DMA(1, SLOT); TILE_BAR();
    qkt2n(pA0, pA1, (LAS const char*)lds, kn0, kr0, qr, negm); partialSM2<true>(pA0, pA1, m_reg, negm, alA, FIXM ? ATT_MARGIN : 0.f);
    asm volatile(".p2align 6");
    for (int j = 1; j + 1 < NT; j += 2) {
        DMA(j + 1, s_next); SBAR();
        qkt2n(pB0, pB1, (LAS const char*)lds, kn0 + s_cur, kr0 + s_cur, qr, negm);
        finishSM(pA0, pA1, alA, l_reg, pa0, pa1, pa2, pa3); SBAR();
        pv_d0(o, vb0 + s_prev, pa0, pa1, pa2, pa3); if (FIXM) { alB = 1.f; exp_half(pB0); } else partialSM2<false>(pB0, pB1, m_reg, negm, alB);
        if (!FIXM) RESC2(alB); TILE_BAR();
        { const int t = s_prev; s_prev = s_cur; s_cur = s_next; s_next = t; }
        if (j + 2 < NT) DMA(j + 2, s_next); SBAR();
        qkt2n(pA0, pA1, (LAS const char*)lds, kn0 + s_cur, kr0 + s_cur, qr, negm);
        finishSM(pB0, pB1, alB, l_reg, pa0, pa1, pa2, pa3); SBAR();
        pv_d0(o, vb0 + s_prev, pa0, pa1, pa2, pa3); if (FIXM) { alA = 1.f; exp_half(pA0); } else partialSM2<false>(pA0, pA1, m_reg, negm, alA);
        if (!FIXM) RESC2(alA); TILE_BAR();
        { const int t = s_prev; s_prev = s_cur; s_cur = s_next; s_next = t; }
    }
    SBAR(); qkt2n(pB0, pB1, (LAS const char*)lds, kn0 + s_cur, kr0 + s_cur, qr, negm);
    finishSM(pA0, pA1, alA, l_reg, pa0, pa1, pa2, pa3); SBAR();
    pv_d0(o, vb0 + s_prev, pa0, pa1, pa2, pa3); if (FIXM) { alB = 1.f; exp_half(pB0); } else partialSM2<false>(pB0, pB1, m_reg, negm, alB);
    if (!FIXM) RESC2(alB);
    finishSM(pB0, pB1, alB, l_reg, pa0, pa1, pa2, pa3); SBAR();
    pv_d0(o, vb0 + s_cur, pa0, pa1, pa2, pa3);
    if (FIXM) { const bool okl = (l_reg > 0.f) && (l_reg < 1e30f); const bool okw = __all(okl); if (lane == 0) ((LAS unsigned*)(lds + LDS2_BYTES))[wid] = okw ? 1u : 0u; }
    if (hi == 0) li_l[r32] = l_reg; asm volatile("s_waitcnt lgkmcnt(0)" ::: "memory");
    float rli[16];
#pragma unroll
    for (int r = 0; r < 16; ++r) rli[r] = __builtin_amdgcn_rcpf(li_l[crow(r, hi)]);
    asm volatile("s_waitcnt lgkmcnt(0)\n\ts_barrier" ::: "memory");
    { constexpr int OP = 272; LAS unsigned char* st = lds + wid * (32 * OP);
#pragma unroll
      for (int r = 0; r < 16; ++r) { const int orow = crow(r, hi);
#pragma unroll
        for (int d0 = 0; d0 < 4; ++d0) *(LAS bf16_t*)(st + orow * OP + (d0 * 32 + r32) * 2) = (bf16_t)(cvt_pk_bf16(o[d0][r] * rli[r], 0.f) & 0xffffu); }
      asm volatile("s_waitcnt lgkmcnt(0)" ::: "memory");
      bf16_t* Ow = U.Ob + (size_t)(wid * QBLK) * D;
#pragma unroll
      for (int i = 0; i < 8; ++i) { const int row = (lane >> 4) + 4 * i, ch = lane & 15;
        const u32x4 w = *(const LAS u32x4*)(st + row * OP + ch * 16); *(u32x4*)(Ow + (size_t)row * D + ch * 8) = w; } }
    TILE_BAR();
#undef KROW
#undef DMA
#undef TILE_BAR
#undef RESC2
}


typedef float f32x4_t __attribute__((ext_vector_type(4)));
__device__ __forceinline__ void attn_unit7(const Unit& U, const bf16_t* __restrict__ KR, const float* __restrict__ ropetab, LAS unsigned char* lds) {
    int tid = threadIdx.x; asm volatile("" : "+v"(tid));
    const int wid = __builtin_amdgcn_readfirstlane(tid >> 6), lane = tid & 63, c16 = lane & 15, g = lane >> 4;
    f32x4_t o[8][2]; bf16x8 qr[2][6]; f32x4_t negm[2]; float l_reg[2] = {0.f, 0.f};
#pragma unroll
    for (int t = 0; t < 8; ++t)
#pragma unroll
        for (int u = 0; u < 2; ++u) o[t][u] = (f32x4_t){0.f, 0.f, 0.f, 0.f};
    const int xg = g < 2 ? g : g + 2;
#pragma unroll
    for (int u = 0; u < 2; ++u) { const bf16_t* Qw = U.Qb + (size_t)(wid * QBLK + 16 * u + c16) * NQ;
#pragma unroll
        for (int s = 0; s < 4; ++s) qr[u][s] = *reinterpret_cast<const bf16x8*>(Qw + 32 * s + 8 * g);
        qr[u][4] = *reinterpret_cast<const bf16x8*>(Qw + NOPE + 8 * xg); qr[u][5] = *reinterpret_cast<const bf16x8*>(Qw + NOPE + 8 * (xg + 2));
        if (U.qpos0 >= 0) { const int t = U.qpos0 + wid * QBLK + 16 * u + c16, pos = g < 2 ? (t >> 6) : (t & 63); rope8(qr[u][4], qr[u][5], ropetab + (pos * 16 + (g & 1) * 8) * 2); } }
    unsigned von[2], vov[2], vor;
#pragma unroll
    for (int i = 0; i < 2; ++i) { const int p = (wid * 2 + i) * 64 + lane;
        { const int row = p >> 4, c = (p & 15) ^ (row & 15); von[i] = (unsigned)(row * (NKV * 2) + c * 16); }
        { const int sub = p >> 5, within = p & 31, k = (sub >> 2) * 8 + (within >> 2), c = (sub & 3) * 32 + (((within & 3) * 8) ^ (((within >> 4) & 1) << 4)); vov[i] = (unsigned)(k * (NKV * 2) + NOPE * 2 + c * 2); } }
    { const int p = wid * 64 + lane, row = p >> 3, c = (p & 7) ^ ((row >> 1) & 7); vor = (unsigned)(row * (ROPED * 2) + c * 16); }
    const int kn0 = c16 * 256 + ((g ^ c16) << 4), kr0 = KR_OFF + c16 * 128 + ((xg ^ ((c16 >> 1) & 7)) << 4);
    const int vbe = (int)(uintptr_t)lds + V_OFF + (g >> 1) * 2048 + (4 * (g & 1) + (c16 >> 2)) * 64 + 32 * (g & 1) + 8 * (c16 & 3), vbo = vbe ^ 32;
    const int nt_lat = U.nt_lat, kb_lat = U.kb_lat, kb_ctx = U.kb_ctx - 64 * nt_lat, NT = U.NT;
    const bf16_t* KVh = U.KVh;
    const unsigned ldsw2 = (unsigned)wid * 2048u, ldsw1 = (unsigned)wid * 1024u;
#define KROW(j) (((j) < nt_lat ? kb_lat : kb_ctx) + 64 * (j))
#define DMA(j, so) do { const size_t _k = (size_t)KROW(j); const char* _kv = (const char*)KVh + _k * (NKV * 2); const char* _kr = (const char*)KR + _k * (ROPED * 2); \
    __builtin_amdgcn_global_load_lds((const unsigned*)(_kv + von[0]), (LAS unsigned*)(lds + (so) + ldsw2), 16, 0, 0); \
    __builtin_amdgcn_global_load_lds((const unsigned*)(_kv + von[1]), (LAS unsigned*)(lds + (so) + ldsw2 + 1024), 16, 0, 0); \
    __builtin_amdgcn_global_load_lds((const unsigned*)(_kr + vor), (LAS unsigned*)(lds + (so) + KR_OFF + ldsw1), 16, 0, 0); \
    __builtin_amdgcn_global_load_lds((const unsigned*)(_kv + vov[0]), (LAS unsigned*)(lds + (so) + V_OFF + ldsw2), 16, 0, 0); \
    __builtin_amdgcn_global_load_lds((const unsigned*)(_kv + vov[1]), (LAS unsigned*)(lds + (so) + V_OFF + ldsw2 + 1024), 16, 0, 0); } while (0)
#define TILE_BAR() asm volatile("s_waitcnt vmcnt(0) lgkmcnt(0)\n\ts_barrier" ::: "memory")
#define XSH(x, m) __int_as_float(__builtin_amdgcn_ds_bpermute((lane ^ (m)) << 2, __float_as_int(x)))
#define MFMA16(A, B, C) __builtin_amdgcn_mfma_f32_16x16x32_bf16(A, B, C, 0, 0, 0)
#define KRD(dst, addr, off) asm volatile("ds_read_b128 %0, %1 offset:%2" : "=&v"(dst) : "v"(addr), "i"(off) : "memory")
#define KRD4(K, s, stp) do { const int _a = (s) < 4 ? (_kn ^ ((s) << 6)) : (_kr ^ (((s) - 4) << 5)); KRD(K[0], _a, 0); KRD(K[1], _a, (stp)); KRD(K[2], _a, 2 * (stp)); KRD(K[3], _a, 3 * (stp)); } while (0)
#define QKM(K, s) do { _Pragma("unroll") for (int a = 0; a < 4; ++a) _Pragma("unroll") for (int u = 0; u < 2; ++u) P_[u][a] = MFMA16(K[a], qr[u][s], (s) == 0 ? negm[u] : P_[u][a]); } while (0)
#define QK7(P, so) do { auto& P_ = P; const int _kn = (int)(uintptr_t)lds + kn0 + (so), _kr = (int)(uintptr_t)lds + kr0 + (so); bf16x8 ka[4], kb[4]; \
    KRD4(ka, 0, 4096); \
    KRD4(kb, 1, 4096); asm volatile("s_waitcnt lgkmcnt(4)" ::: "memory"); SBAR(); QKM(ka, 0); SBAR(); \
    KRD4(ka, 2, 4096); asm volatile("s_waitcnt lgkmcnt(4)" ::: "memory"); SBAR(); QKM(kb, 1); SBAR(); \
    KRD4(kb, 3, 4096); asm volatile("s_waitcnt lgkmcnt(4)" ::: "memory"); SBAR(); QKM(ka, 2); SBAR(); \
    KRD4(ka, 4, 2048); asm volatile("s_waitcnt lgkmcnt(4)" ::: "memory"); SBAR(); QKM(kb, 3); SBAR(); \
    KRD4(kb, 5, 2048); asm volatile("s_waitcnt lgkmcnt(4)" ::: "memory"); SBAR(); QKM(ka, 4); SBAR(); \
    asm volatile("s_waitcnt lgkmcnt(0)" ::: "memory"); SBAR(); QKM(kb, 5); } while (0)
#define EXPH7(P, A0) do { _Pragma("unroll") for (int u = 0; u < 2; ++u) _Pragma("unroll") for (int a = (A0); a < (A0) + 2; ++a) _Pragma("unroll") for (int r = 0; r < 4; ++r) P[u][a][r] = __builtin_amdgcn_exp2f(P[u][a][r]); } while (0)
#define FIN7(P) do { EXPH7(P, 2); \
    _Pragma("unroll") for (int u = 0; u < 2; ++u) { float ps = 0.f; _Pragma("unroll") for (int a = 0; a < 4; ++a) ps += (P[u][a][0] + P[u][a][1]) + (P[u][a][2] + P[u][a][3]); l_reg[u] += ps; \
        _Pragma("unroll") for (int ks = 0; ks < 2; ++ks) { u32x4 w = {cvt_pk_bf16(P[u][2 * ks][0], P[u][2 * ks][1]), cvt_pk_bf16(P[u][2 * ks][2], P[u][2 * ks][3]), \
            cvt_pk_bf16(P[u][2 * ks + 1][0], P[u][2 * ks + 1][1]), cvt_pk_bf16(P[u][2 * ks + 1][2], P[u][2 * ks + 1][3])}; pk[ks][u] = *reinterpret_cast<bf16x8*>(&w); } } } while (0)
#define TR7(dst, vb, a, t) asm volatile("ds_read_b64_tr_b16 %0, %1 offset:%2" : "=&v"(dst) : "v"(vb), "i"((a) * 4096 + ((t) >> 1) * 512) : "memory")
#define RD4(E, t) do { if ((t) & 1) { TR7(E[0], vb1_, 0, t); TR7(E[1], vb1_, 1, t); TR7(E[2], vb1_, 2, t); TR7(E[3], vb1_, 3, t); } else { TR7(E[0], vb0_, 0, t); TR7(E[1], vb0_, 1, t); TR7(E[2], vb0_, 2, t); TR7(E[3], vb0_, 3, t); } } while (0)
#define MM4(E, t) do { \
        const bf16x8 v0 = (bf16x8){E[0][0], E[0][1], E[0][2], E[0][3], E[1][0], E[1][1], E[1][2], E[1][3]}, v1 = (bf16x8){E[2][0], E[2][1], E[2][2], E[2][3], E[3][0], E[3][1], E[3][2], E[3][3]}; \
        o[t][0] = MFMA16(v0, pk[0][0], o[t][0]); o[t][1] = MFMA16(v0, pk[0][1], o[t][1]); o[t][0] = MFMA16(v1, pk[1][0], o[t][0]); o[t][1] = MFMA16(v1, pk[1][1], o[t][1]); } while (0)
#define PV7(so) do { const int vb0_ = vbe + (so), vb1_ = vbo + (so); s16x4 ea[4], eb[4]; \
        RD4(ea, 0); \
        RD4(eb, 1); asm volatile("s_waitcnt lgkmcnt(4)" ::: "memory"); SBAR(); MM4(ea, 0); SBAR(); \
        RD4(ea, 2); asm volatile("s_waitcnt lgkmcnt(4)" ::: "memory"); SBAR(); MM4(eb, 1); SBAR(); \
        RD4(eb, 3); asm volatile("s_waitcnt lgkmcnt(4)" ::: "memory"); SBAR(); MM4(ea, 2); SBAR(); \
        RD4(ea, 4); asm volatile("s_waitcnt lgkmcnt(4)" ::: "memory"); SBAR(); MM4(eb, 3); SBAR(); \
        RD4(eb, 5); asm volatile("s_waitcnt lgkmcnt(4)" ::: "memory"); SBAR(); MM4(ea, 4); SBAR(); \
        RD4(ea, 6); asm volatile("s_waitcnt lgkmcnt(4)" ::: "memory"); SBAR(); MM4(eb, 5); SBAR(); \
        RD4(eb, 7); asm volatile("s_waitcnt lgkmcnt(4)" ::: "memory"); SBAR(); MM4(ea, 6); SBAR(); \
        asm volatile("s_waitcnt lgkmcnt(0)" ::: "memory"); SBAR(); MM4(eb, 7); } while (0)
    f32x4_t pA[2][4]; bf16x8 pk[2][2];
    negm[0] = negm[1] = (f32x4_t){0.f, 0.f, 0.f, 0.f};
    int s_prev = 0, s_cur = SLOT, s_next = 2 * SLOT;
    DMA(0, 0); DMA(1, SLOT); TILE_BAR();
    QK7(pA, 0);
#pragma unroll
    for (int u = 0; u < 2; ++u) { float pmax = pA[u][0][0];
#pragma unroll
        for (int a = 0; a < 4; ++a)
#pragma unroll
            for (int r = 0; r < 4; ++r) pmax = fmaxf(pmax, pA[u][a][r]);
        pmax = fmaxf(pmax, XSH(pmax, 16)); pmax = fmaxf(pmax, XSH(pmax, 32));
        const float delta = pmax + ATT_MARGIN; negm[u] = (f32x4_t){-delta, -delta, -delta, -delta};
#pragma unroll
        for (int a = 0; a < 4; ++a)
#pragma unroll
            for (int r = 0; r < 4; ++r) pA[u][a][r] -= delta; }
    EXPH7(pA, 0);
    asm volatile(".p2align 6");
    for (int j = 1; j < NT; ++j) {
        bf16x8 ka[4], kb[4]; s16x4 ea[4], eb[4];
        const int _kn = (int)(uintptr_t)lds + kn0 + s_cur, _kr = (int)(uintptr_t)lds + kr0 + s_cur, vb0_ = vbe + s_prev, vb1_ = vbo + s_prev; auto& P_ = pA;
        KRD4(ka, 0, 4096); KRD4(kb, 1, 4096); SBAR();
        if (j + 1 < NT) DMA(j + 1, s_next); SBAR();
        FIN7(pA); SBAR();
        asm volatile("s_waitcnt lgkmcnt(4)" ::: "memory"); SBAR(); QKM(ka, 0); SBAR();
        KRD4(ka, 2, 4096); asm volatile("s_waitcnt lgkmcnt(4)" ::: "memory"); SBAR(); QKM(kb, 1); SBAR();
        KRD4(kb, 3, 4096); asm volatile("s_waitcnt lgkmcnt(4)" ::: "memory"); SBAR(); QKM(ka, 2); SBAR();
        KRD4(ka, 4, 2048); asm volatile("s_waitcnt lgkmcnt(4)" ::: "memory"); SBAR(); QKM(kb, 3); SBAR();
        KRD4(kb, 5, 2048); asm volatile("s_waitcnt lgkmcnt(4)" ::: "memory"); SBAR(); QKM(ka, 4); SBAR();
        RD4(ea, 0); RD4(eb, 1); asm volatile("s_waitcnt lgkmcnt(8)" ::: "memory"); SBAR(); QKM(kb, 5); SBAR();
        asm volatile("s_waitcnt lgkmcnt(4)" ::: "memory"); SBAR(); MM4(ea, 0); SBAR();
        RD4(ea, 2); asm volatile("s_waitcnt lgkmcnt(4)" ::: "memory"); SBAR(); MM4(eb, 1); SBAR();
        RD4(eb, 3); asm volatile("s_waitcnt lgkmcnt(4)" ::: "memory"); SBAR(); MM4(ea, 2); SBAR();
        RD4(ea, 4); asm volatile("s_waitcnt lgkmcnt(4)" ::: "memory"); SBAR(); MM4(eb, 3); SBAR();
        RD4(eb, 5); asm volatile("s_waitcnt lgkmcnt(4)" ::: "memory"); SBAR(); MM4(ea, 4); SBAR();
        RD4(ea, 6); asm volatile("s_waitcnt lgkmcnt(4)" ::: "memory"); SBAR(); MM4(eb, 5); SBAR();
        RD4(eb, 7); asm volatile("s_waitcnt lgkmcnt(4)" ::: "memory"); SBAR(); MM4(ea, 6); SBAR();
        asm volatile("s_waitcnt lgkmcnt(0)" ::: "memory"); SBAR(); MM4(eb, 7);
        EXPH7(pA, 0); TILE_BAR();
        { const int t = s_prev; s_prev = s_cur; s_cur = s_next; s_next = t; }
    }
    FIN7(pA); SBAR();
    PV7(s_prev);
    float rl[2]; bool okl = true;
#pragma unroll
    for (int u = 0; u < 2; ++u) { float l = l_reg[u]; l += XSH(l, 16); l += XSH(l, 32); okl = okl && (l > 0.f) && (l < 1e30f); rl[u] = __builtin_amdgcn_rcpf(l); }
    { const bool okw = __all(okl); if (lane == 0) ((LAS unsigned*)(lds + LDS2_BYTES))[wid] = okw ? 1u : 0u; }
    asm volatile("s_waitcnt vmcnt(0) lgkmcnt(0)\n\ts_barrier" ::: "memory");
    { constexpr int OP = 272; LAS unsigned char* st = lds + wid * (32 * OP);
      int tid2 = threadIdx.x; asm volatile("" : "+v"(tid2)); const int lane = tid2 & 63, c16 = lane & 15, g = lane >> 4;
#pragma unroll
      for (int u = 0; u < 2; ++u)
#pragma unroll
        for (int t = 0; t < 8; ++t) { u32x2 w; w.x = cvt_pk_bf16(o[t][u][0] * rl[u], o[t][u][1] * rl[u]); w.y = cvt_pk_bf16(o[t][u][2] * rl[u], o[t][u][3] * rl[u]);
            *(LAS u32x2*)(st + (16 * u + c16) * OP + (16 * t + 4 * g) * 2) = w; }
      asm volatile("s_waitcnt lgkmcnt(0)" ::: "memory");
      bf16_t* Ow = U.Ob + (size_t)(wid * QBLK) * D;
#pragma unroll
      for (int i = 0; i < 8; ++i) { const int row = (lane >> 4) + 4 * i, ch = lane & 15;
        const u32x4 w = *(const LAS u32x4*)(st + row * OP + ch * 16); *(u32x4*)(Ow + (size_t)row * D + ch * 8) = w; } }
    TILE_BAR();
#undef KROW
#undef DMA
#undef TILE_BAR
#undef XSH
#undef MFMA16
#undef QK7
#undef KRD
#undef KRD4
#undef QKM
#undef EXPH7
#undef FIN7
#undef PV7
#undef TR7
#undef RD4
#undef MM4
}

#ifndef ATT_FAST_FIRST
#define ATT_FAST_FIRST 1
#endif
#ifndef ATT_FORCE_SAFE
#define ATT_FORCE_SAFE 0
#endif
__device__ __forceinline__ void attn_unit_auto(const Unit& U, const bf16_t* __restrict__ KR, const float* __restrict__ ropetab, LAS unsigned char* lds) {
#if ATT_FAST_FIRST
    attn_unit7(U, KR, ropetab, lds);
    const LAS unsigned* fl = (const LAS unsigned*)(lds + LDS2_BYTES);
    unsigned okc = 0; for (int w = 0; w < NWAVES; ++w) okc += fl[w];
    if (ATT_FORCE_SAFE || __builtin_amdgcn_readfirstlane(okc) != (unsigned)NWAVES) attn_unit6<false>(U, KR, ropetab, lds);
#else
    attn_unit6<false>(U, KR, ropetab, lds);
#endif
}
}
constexpr size_t MiB = 1u << 20;
constexpr int CW_TMO = 0, CW_BAR = 4096;
constexpr int KSPL = 16;
constexpr size_t WS_CTL = 0;
constexpr size_t WS_MOD = 64 * 1024;
constexpr size_t WS_SSQ = 1 * MiB;
constexpr size_t CTL_ZERO_BYTES = 64 * 1024;
constexpr size_t WS_ROPE = 3 * MiB;
constexpr size_t WS_W13 = 4 * MiB;
constexpr size_t WS_W2 = 180 * MiB;
constexpr size_t WS_WPOOL = 268 * MiB;
constexpr size_t WS_WDQKV = 272 * MiB;
constexpr size_t WS_WUP = 282 * MiB;
constexpr size_t WS_WO = 296 * MiB;
constexpr size_t WS_H = 312 * MiB;
constexpr size_t WS_U = 444 * MiB;
constexpr size_t WS_Y = 510 * MiB;
constexpr size_t WS_P = 576 * MiB;
constexpr size_t WS_G = 642 * MiB;
constexpr size_t WS_CQKV = 824 * MiB;
constexpr size_t WS_Q = 866 * MiB;
constexpr size_t WS_KV = 965 * MiB;
constexpr size_t WS_KR = 1097 * MiB;
constexpr size_t WS_YP = 1100 * MiB;
constexpr size_t WS_MODP2 = 1148 * MiB;
constexpr size_t WS_END = 1176 * MiB;
static_assert(WS_W13 + (size_t)4 * 11264 * 2048 * 2 <= WS_W2 && WS_W2 + (size_t)4 * 2048 * 5632 * 2 <= WS_WPOOL && WS_H + (size_t)T * D * 4 <= WS_U && WS_U + (size_t)T * D * 2 <= WS_Y, "ws map");
static_assert(WS_G + (size_t)T * DFF * 2 <= WS_CQKV && WS_CQKV + (size_t)T * NDQKV * 2 <= WS_Q && WS_Q + (size_t)T * NQ * 2 <= WS_KV && WS_KV + (size_t)T * NKV * 2 <= WS_KR && WS_KR + (size_t)T * ROPED * 2 <= WS_YP && WS_YP + (size_t)11 * TC * D * 4 <= WS_MODP2 && WS_MODP2 + (size_t)3 * 64 * 3 * NMOD * 4 <= WS_END, "ws map");
static_assert(WS_MOD + (size_t)4 * 3 * NMOD * 4 <= WS_SSQ && WS_SSQ + (size_t)16 * T * 4 <= WS_ROPE && (CW_BAR + 3456) * 4 <= (int)CTL_ZERO_BYTES, "ctl map");

constexpr int RING_BYTES = 131072, MISC_OFF = RING_BYTES, LDS_BYTES = 147456;
static_assert(att::LDS_BYTES <= RING_BYTES && att::LDS2_BYTES + 64 <= RING_BYTES, "attention LDS");

#define XB_TMO      128
#define XB_XCNT(j)  (256  + 64 * (j))
#define XB_XSUB(j)  (1280 + 64 * (j))
#define XB_XGEN(j)  (2304 + 64 * (j))
#define XB_TOP      3328
#define XB_TOPGEN   3392
#define XCD_BAR_WORDS 3456
#define XB_SPIN_CAP (1u << 22)
__device__ __forceinline__ unsigned xb_ld(unsigned* p)              { return __hip_atomic_load(p, __ATOMIC_RELAXED, __HIP_MEMORY_SCOPE_AGENT); }
__device__ __forceinline__ unsigned xb_add(unsigned* p, unsigned v) { return __hip_atomic_fetch_add(p, v, __ATOMIC_RELAXED, __HIP_MEMORY_SCOPE_AGENT); }
__device__ __forceinline__ unsigned xb_xcc_id() { return (unsigned)__builtin_amdgcn_s_getreg((3 << 11) | 20) & 0xFu; }
#define XB_SPIN(cond, bar) do { unsigned _sp = 0; while (cond) { __builtin_amdgcn_s_sleep(1); \
    if ((++_sp & 255u) == 0u) { if (xb_ld(&(bar)[XB_TMO])) break; if (_sp > XB_SPIN_CAP) { atomicAdd(&(bar)[XB_TMO], 1u); break; } } } } while (0)
struct XcdBarrier { unsigned* bar; unsigned x; volatile LAS unsigned* st; };
__device__ __forceinline__ XcdBarrier xcd_barrier_post(unsigned* bar, volatile LAS unsigned* st) {
    XcdBarrier b; b.bar = bar; b.x = xb_xcc_id(); b.st = st;
    if (threadIdx.x == 0) (void)xb_add(&bar[XB_XCNT(b.x)], 1u);
    return b;
}
__device__ __forceinline__ void xcd_barrier_complete(unsigned* bar, unsigned x, unsigned& nloc, unsigned& nx) {
    const unsigned G = gridDim.x * gridDim.y * gridDim.z;
    unsigned sum, cnt, mine, sp = 0u;
    for (;;) {
        sum = 0u; cnt = 0u; mine = 0u;
#pragma unroll
        for (unsigned j = 0; j < 16; ++j) { const unsigned c = xb_ld(&bar[XB_XCNT(j)]); sum += c; cnt += (c > 0u) ? 1u : 0u; mine = (j == x) ? c : mine; }
        if (sum == G) break;
        __builtin_amdgcn_s_sleep(1);
        if ((++sp & 255u) == 0u) { if (xb_ld(&bar[XB_TMO])) break; if (sp > XB_SPIN_CAP) { atomicAdd(&bar[XB_TMO], 1u); break; } }
    }
    nloc = mine > 0u ? mine : 1u; nx = cnt > 0u ? cnt : 1u;
}
__device__ __forceinline__ void xcd_barrier(const XcdBarrier& b) {
    asm volatile("s_waitcnt vmcnt(0)" ::: "memory");
    __syncthreads();
    if (threadIdx.x == 0) {
        unsigned* bar = b.bar; asm volatile("" : "+s"(bar));
        __builtin_amdgcn_s_waitcnt(0);
        const unsigned bx = xb_xcc_id();
        unsigned nloc = b.st[0], nx = b.st[1];
        if (nloc == 0u) { xcd_barrier_complete(bar, bx, nloc, nx); b.st[0] = nloc; b.st[1] = nx; }
        const unsigned old = xb_add(&bar[XB_XSUB(bx)], 1u);
        const unsigned gen = old / nloc;
        if (old + 1u == (gen + 1u) * nloc) {
            __builtin_amdgcn_fence(__ATOMIC_RELEASE, "agent");
            asm volatile("s_waitcnt vmcnt(0)" ::: "memory");
            const unsigned og = xb_add(&bar[XB_TOP], 1u);
            const unsigned tg = og / nx;
            if (og + 1u == (tg + 1u) * nx) xb_add(&bar[XB_TOPGEN], 1u);
            else XB_SPIN(xb_ld(&bar[XB_TOPGEN]) == tg, bar);
            __builtin_amdgcn_fence(__ATOMIC_ACQUIRE, "agent");
            xb_add(&bar[XB_XGEN(bx)], 1u);
            asm volatile("s_waitcnt vmcnt(0)" ::: "memory");
        } else {
            XB_SPIN(xb_ld(&bar[XB_XGEN(bx)]) == gen, bar);
            __builtin_amdgcn_fence(__ATOMIC_ACQUIRE, "agent");
            asm volatile("s_waitcnt vmcnt(0)" ::: "memory");
        }
    }
    __syncthreads();
}

#define LDS_WAIT() asm volatile("s_waitcnt lgkmcnt(0)" ::: "memory")
struct TrD { const float* W; int ldw, k0, n0; bf16_t* WT; int ldt, drow0; const float* ksc; const float* nsc; float mul; };
__device__ __forceinline__ void tr_load(const TrD& d, float (&v)[32], int lane) {
    const float* wp = d.W + (size_t)(d.k0 + (lane >> 5)) * d.ldw + d.n0 + (lane & 31);
#pragma unroll
    for (int i = 0; i < 32; ++i) v[i] = __builtin_nontemporal_load(wp + (size_t)(2 * i) * d.ldw);
}
__device__ __forceinline__ void tr_finish(const TrD& d, float (&v)[32], LAS float* scr, int lane) {
    const float ns = (d.nsc ? d.nsc[d.n0 + (lane & 31)] : 1.f) * d.mul;
    if (d.ksc) {
#pragma unroll
        for (int i = 0; i < 32; ++i) v[i] *= d.ksc[d.k0 + 2 * i + (lane >> 5)]; }
#pragma unroll
    for (int i = 0; i < 32; ++i) scr[(2 * i + (lane >> 5)) * 33 + (lane & 31)] = v[i] * ns;
    LDS_WAIT(); asm volatile("" ::: "memory");
    const int c = lane & 7;
#pragma unroll
    for (int j = 0; j < 4; ++j) { const int n = (lane >> 3) + 8 * j; const LAS float* s = scr + (8 * c) * 33 + n;
        u32x4 o; o.x = cvt_pk_bf16(s[0 * 33], s[1 * 33]); o.y = cvt_pk_bf16(s[2 * 33], s[3 * 33]); o.z = cvt_pk_bf16(s[4 * 33], s[5 * 33]); o.w = cvt_pk_bf16(s[6 * 33], s[7 * 33]);
        *(u32x4*)(d.WT + (size_t)(d.drow0 + n) * d.ldt + d.k0 + 8 * c) = o; }
    LDS_WAIT(); asm volatile("" ::: "memory");
}
struct In {
    const float *x, *c, *ctx, *c_ctx, *ada_w, *ada_b, *norm_g, *pool_w, *pool_scale, *w_dqkv, *q_norm, *w_uq, *kv_norm, *w_ukv, *w_o, *w1, *w3, *w2;
};
constexpr int I_F = (D / 64) * (DFF / 32);
constexpr int I_P = (512 / 64) * (512 / 32);
constexpr int I_DQ = (D / 64) * (1088 / 32);
constexpr int I_UQ = (QL / 64) * (NQ / 32), I_UKV = (KVL / 64) * (NKV / 32);
constexpr int I_O = (D / 64) * (D / 32);
constexpr int SEG0 = 0;
constexpr int SEG1 = SEG0 + 3 * I_F + 8 * I_P + 2 * I_DQ;
constexpr int SEG2 = SEG1 + 3 * I_F;
constexpr int SEG3 = SEG2 + I_UQ + I_UKV + I_O;
constexpr int SEG4 = SEG3 + 3 * I_F;
constexpr int SEG5 = SEG4 + 2 * I_F;
constexpr int SEG6 = SEG5 + I_UQ + I_UKV + I_O + I_F;
__device__ __forceinline__ TrD d_ffn(const In& I, unsigned char* ws, int l, int which, int item) {
    if (which < 2) { const int nblk = DFF / 32, kb = item / nblk, nb = item % nblk, n0 = nb * 32;
        return TrD{(which ? I.w3 : I.w1) + (size_t)l * D * DFF, DFF, kb * 64, n0, (bf16_t*)(ws + WS_W13) + (size_t)l * 2 * DFF * D, D, 256 * (n0 >> 7) + 128 * which + (n0 & 127), nullptr, nullptr, 1.f}; }
    const int nblk = D / 32, kb = item / nblk, nb = item % nblk;
    return TrD{I.w2 + (size_t)l * DFF * D, D, kb * 64, nb * 32, (bf16_t*)(ws + WS_W2) + (size_t)l * D * DFF, DFF, nb * 32, nullptr, nullptr, 1.f};
}
__device__ __forceinline__ TrD d_pool(const In& I, unsigned char* ws, int r) { const int jg = r / I_P, item = r % I_P, j = jg >> 2, g = jg & 3, nblk = 512 / 32, kb = item / nblk, nb = item % nblk;
    return TrD{I.pool_w + (size_t)jg * 512 * 512, 512, kb * 64, nb * 32, (bf16_t*)(ws + WS_WPOOL) + (size_t)j * D * 512, 512, g * 512 + nb * 32, nullptr, I.pool_scale + j * D + g * 512, 1.f}; }
__device__ __forceinline__ TrD d_dq(const In& I, unsigned char* ws, int j, int item) { const int nblk = 1088 / 32, kb = item / nblk, nb = item % nblk;
    return TrD{I.w_dqkv + (size_t)j * D * 1088, 1088, kb * 64, nb * 32, (bf16_t*)(ws + WS_WDQKV) + (size_t)j * NDQKV * D, D, nb * 32, nullptr, nullptr, 1.f}; }
__device__ __forceinline__ TrD d_uq(const In& I, unsigned char* ws, int j, int item) { const int nblk = NQ / 32, kb = item / nblk, nb = item % nblk;
    return TrD{I.w_uq + (size_t)j * QL * NQ, NQ, kb * 64, nb * 32, (bf16_t*)(ws + WS_WUP) + (size_t)j * NUP * 512, 512, nb * 32, I.q_norm + j * QL, nullptr, att::SCALE * 1.4426950408889634f}; }
__device__ __forceinline__ TrD d_ukv(const In& I, unsigned char* ws, int j, int item) { const int nblk = NKV / 32, kb = item / nblk, nb = item % nblk;
    return TrD{I.w_ukv + (size_t)j * KVL * NKV, NKV, kb * 64, nb * 32, (bf16_t*)(ws + WS_WUP) + (size_t)j * NUP * 512, 512, NQ + nb * 32, I.kv_norm + j * KVL, nullptr, 1.f}; }
__device__ __forceinline__ TrD d_o(const In& I, unsigned char* ws, int j, int item) { const int nblk = D / 32, kb = item / nblk, nb = item % nblk;
    return TrD{I.w_o + (size_t)j * D * D, D, kb * 64, nb * 32, (bf16_t*)(ws + WS_WO) + (size_t)j * D * D, D, nb * 32, nullptr, nullptr, 1.f}; }
__device__ __forceinline__ TrD tr_desc(const In& I, unsigned char* ws, int r) {
#define PIECE(cnt, expr) if (r < (cnt)) return expr; r -= (cnt);
    PIECE(I_F, d_ffn(I, ws, 0, 0, r)) PIECE(I_F, d_ffn(I, ws, 0, 1, r)) PIECE(I_F, d_ffn(I, ws, 0, 2, r)) PIECE(8 * I_P, d_pool(I, ws, r)) PIECE(I_DQ, d_dq(I, ws, 0, r)) PIECE(I_DQ, d_dq(I, ws, 1, r))
    PIECE(I_F, d_ffn(I, ws, 1, 0, r)) PIECE(I_F, d_ffn(I, ws, 1, 1, r)) PIECE(I_F, d_ffn(I, ws, 1, 2, r))
    PIECE(I_UQ, d_uq(I, ws, 0, r)) PIECE(I_UKV, d_ukv(I, ws, 0, r)) PIECE(I_O, d_o(I, ws, 0, r))
    PIECE(I_F, d_ffn(I, ws, 2, 0, r)) PIECE(I_F, d_ffn(I, ws, 2, 1, r)) PIECE(I_F, d_ffn(I, ws, 2, 2, r))
    PIECE(I_F, d_ffn(I, ws, 3, 0, r)) PIECE(I_F, d_ffn(I, ws, 3, 1, r))
    PIECE(I_UQ, d_uq(I, ws, 1, r)) PIECE(I_UKV, d_ukv(I, ws, 1, r)) PIECE(I_O, d_o(I, ws, 1, r))
    return d_ffn(I, ws, 3, 2, r);
#undef PIECE
}
__device__ __forceinline__ void tr_run(const In& I, unsigned char* ws, int seg_lo, int seg_n, int v, int vs, LAS float* scr, int lane) {
    float vA[32], vB[32]; TrD dA, dB; int it = v;
    if (it < seg_n) { dA = tr_desc(I, ws, seg_lo + it); tr_load(dA, vA, lane); }
    while (it < seg_n) {
        int itn = it + vs;
        if (itn < seg_n) { dB = tr_desc(I, ws, seg_lo + itn); tr_load(dB, vB, lane); }
        tr_finish(dA, vA, scr, lane);
        it = itn; if (it >= seg_n) break;
        itn = it + vs;
        if (itn < seg_n) { dA = tr_desc(I, ws, seg_lo + itn); tr_load(dA, vA, lane); }
        tr_finish(dB, vB, scr, lane);
        it = itn;
    }
}
#ifndef GEMV_DEFER
#define GEMV_DEFER 0
#endif
constexpr int KSPL2 = 64;
template <int KLEN>
__device__ __forceinline__ void gemv_task(const In& I, float* outp, int l, int st, int k0, int lane) {
    constexpr int NHALF = (KLEN + 63) / 64, HL = KLEN < 64 ? KLEN : 64;
    float sv[3][NHALF];
#pragma unroll
    for (int h = 0; h < NHALF; ++h) { const int k = k0 + h * 64 + (lane % HL); const float c0 = I.c[k], c1 = I.c[D + k], c2 = I.c_ctx[k];
        sv[0][h] = c0 / (1.f + __expf(-c0)); sv[1][h] = c1 / (1.f + __expf(-c1)); sv[2][h] = c2 / (1.f + __expf(-c2)); }
    const float* wp = I.ada_w + ((size_t)l * D + k0) * NMOD + st * 256 + lane * 4;
    f32x4 a0 = {0.f, 0.f, 0.f, 0.f}, a1 = a0, a2 = a0;
#pragma unroll
    for (int h = 0; h < NHALF; ++h)
#pragma unroll (KLEN < 64 ? 16 : 8)
        for (int kk = 0; kk < HL; ++kk) { const f32x4 w = __builtin_nontemporal_load((const f32x4*)(wp + (size_t)(h * 64 + kk) * NMOD));
            a0 += w * __int_as_float(__builtin_amdgcn_readlane(__float_as_int(sv[0][h]), kk)); a1 += w * __int_as_float(__builtin_amdgcn_readlane(__float_as_int(sv[1][h]), kk)); a2 += w * __int_as_float(__builtin_amdgcn_readlane(__float_as_int(sv[2][h]), kk)); }
    float* mp = outp + st * 256 + lane * 4;
    *(f32x4*)mp = a0; *(f32x4*)(mp + NMOD) = a1; *(f32x4*)(mp + 2 * NMOD) = a2;
}
__device__ __forceinline__ void filler(const In& I, unsigned char* ws, int gl, int seg_lo, int seg_n, int fi, int fn, LAS float* scr, int lane) {
    int v = fi;
    if (gl > 0) { constexpr int NG2 = (NMOD / 256) * KSPL2; float* mp2 = (float*)(ws + WS_MODP2) + (size_t)(gl - 1) * KSPL2 * 3 * NMOD;
#if GEMV_TWICE
        if (gl == 2) for (int v2 = fi; v2 < NG2; v2 += fn) { const int ks = v2 % KSPL2, st = v2 / KSPL2; gemv_task<D / KSPL2>(I, mp2 + (size_t)ks * 3 * NMOD, gl, st, ks * (D / KSPL2), lane); }
#endif
        for (; v < NG2; v += fn) { const int ks = v % KSPL2, st = v / KSPL2; gemv_task<D / KSPL2>(I, mp2 + (size_t)ks * 3 * NMOD, gl, st, ks * (D / KSPL2), lane); }
        v -= NG2; }
    tr_run(I, ws, seg_lo, seg_n, v, fn, scr, lane);
}

__device__ __forceinline__ void prologue(const In& I, unsigned char* ws, LAS unsigned char* lds, int gw, int ngw, int wave, int lane, int gtid, int ngt) {
    LAS float* scr = (LAS float*)(lds + wave * 16384);
    bf16_t* WDQKV = (bf16_t*)(ws + WS_WDQKV);
    tr_run(I, ws, SEG0, SEG1 - SEG0, gw, ngw, scr, lane);
    { constexpr int PER = (NDQKV - 1088) * D / 8;
        for (int i = gtid; i < 2 * PER; i += ngt) { const int j = i / PER, q = i % PER; *(u32x4*)(WDQKV + (size_t)j * NDQKV * D + (size_t)1088 * D + (size_t)q * 8) = (u32x4){0u, 0u, 0u, 0u}; } }
    if (gtid < 128 * 16) { const int pos = gtid >> 4, f = gtid & 15; const float inv = powf(10000.f, -(float)(2 * f) / 32.f), ang = (float)pos * inv;
        float* tab = (float*)(ws + WS_ROPE); tab[gtid * 2] = cosf(ang); tab[gtid * 2 + 1] = sinf(ang); }
    { float* MODP = (float*)(ws + WS_G); constexpr int NSTRIP = NMOD / 256, KLEN = D / KSPL;
        for (int task = gw; task < (GEMV_DEFER ? 2 : 4) * NSTRIP * KSPL; task += ngw) { const int ks = task % KSPL, st = (task / KSPL) % NSTRIP, l = task / (KSPL * NSTRIP);
            gemv_task<KLEN>(I, MODP + (size_t)ks * 12 * NMOD + (size_t)l * 3 * NMOD, l, st, ks * KLEN, lane); } }
}

struct RN { const float* xin_lat; const float* xin_ctx; const bf16_t* hin; const bf16_t* Y; const float* Yp; int nparts; const float* gate; const float* gY; bf16_t* hout; float* fout;
            const float* gN; const float* shift; const float* scale; bf16_t* U; int nrows; const float* modp; const float* bias; float* mod_out; };
template <bool HAS_Y, bool WRITE_U, bool HIN_F32, bool HOUT_F32, bool MODP_IN = false, bool POOLY = false>
__device__ __forceinline__ void resid_norm(const RN& a, LAS unsigned char* lds, int gw, int ngw, int tid) {
    asm volatile("" : "+v"(tid)); const int lane = tid & 63;
    typedef const GAS char* gcp; typedef GAS char* gp;
    if (MODP_IN) {
        for (int i = (gw * 64 + lane); i < (GEMV_DEFER ? 6 : 12) * NMOD / 4; i += ngw * 64) { f32x4 acc = *(const GAS f32x4*)((gcp)a.bias + 16 * ((size_t)(i / (3 * NMOD / 4)) * (NMOD / 4) + i % (NMOD / 4)));
            for (int p = 0; p < KSPL; ++p) acc += *(const GAS f32x4*)((gcp)a.modp + ((size_t)p * 12 * NMOD + (size_t)i * 4) * 4);
            *(GAS f32x4*)((gp)a.mod_out + (size_t)i * 16) = acc; } }
    for (int i = tid; i < 3 * (D / 4); i += NTHREADS) { const int s = i / (D / 4), c4 = i % (D / 4); LAS f32x4* t = (LAS f32x4*)(lds + s * 24576) + c4;
        if (HAS_Y) t[0] = *(const GAS f32x4*)((gcp)(a.gate + (size_t)s * NMOD) + 16 * c4) * *(const GAS f32x4*)((gcp)a.gY + 16 * c4);
        if (WRITE_U) { f32x4 sc, sh;
            if (MODP_IN) { sh = *(const GAS f32x4*)((gcp)a.bias + 16 * c4); sc = *(const GAS f32x4*)((gcp)a.bias + 16 * (D / 4 + c4));
                for (int p = 0; p < KSPL; ++p) { const float* mp = a.modp + (size_t)p * 12 * NMOD + (size_t)s * NMOD; sh += *(const GAS f32x4*)((gcp)mp + 16 * c4); sc += *(const GAS f32x4*)((gcp)mp + 16 * (D / 4 + c4)); } }
            else { sc = *(const GAS f32x4*)((gcp)(a.scale + (size_t)s * NMOD) + 16 * c4); sh = *(const GAS f32x4*)((gcp)(a.shift + (size_t)s * NMOD) + 16 * c4); }
            t[D / 4] = *(const GAS f32x4*)((gcp)a.gN + 16 * c4) * (sc + 1.f); t[2 * (D / 4)] = sh; } }
    __syncthreads();
    const unsigned l16 = (unsigned)lane * 16u, l8 = (unsigned)lane * 8u;
    const int nrows = a.nrows, nparts = a.nparts;
#define LDF4(base, j) (*(const GAS f32x4*)((gcp)(base) + l16 + 1024u * (j)))
#define LDB4(base, j) (*(const GAS u32x2*)((gcp)(base) + l8 + 512u * (j)))
#define UNPK(w) ((f32x4){bf_lo((w).x), bf_hi((w).x), bf_lo((w).y), bf_hi((w).y)})
#define RN_LOAD(hf, hw, yw, r) do { \
        if (HIN_F32) { const float* hp_ = (r) < TL ? a.xin_lat + (size_t)(r) * D : a.xin_ctx + (size_t)((r) - TL) * D; _Pragma("unroll") for (int j = 0; j < 8; ++j) hf[j] = LDF4(hp_, j); } \
        else { const bf16_t* hp_ = a.hin + (size_t)(r) * D; _Pragma("unroll") for (int j = 0; j < 8; ++j) hw[j] = LDB4(hp_, j); } \
        if (HAS_Y && !POOLY && !((r) >= TL && nparts > 0)) { const bf16_t* yr_ = a.Y + (size_t)(r) * D; _Pragma("unroll") for (int j = 0; j < 8; ++j) yw[j] = LDB4(yr_, j); } } while (0)
#define RN_PROC(hf, hw, yw, r) do { const int s_ = (r) < SEQ ? 0 : ((r) < TL ? 1 : 2); const LAS f32x4* tb_ = (const LAS f32x4*)(lds + s_ * 24576) + lane; f32x4 h[8]; \
        _Pragma("unroll") for (int j = 0; j < 8; ++j) h[j] = HIN_F32 ? hf[j] : UNPK(hw[j]); \
        if (HAS_Y) { f32x4 y[8]; float sy = 0.f; \
            if (POOLY) {   \
                int sb_, L_; if ((r) < TL) { sb_ = ((r) / SEQ) * SEQ; L_ = SEQ; } else { sb_ = TL + (((r) - TL) / CTXL) * CTXL; L_ = CTXL; } const int t_ = (r) - sb_; const bf16_t* zs_ = a.Y + (size_t)sb_ * D; \
                _Pragma("unroll") for (int g = 0; g < 4; ++g) { const int w2_ = 1 << g, lo_ = max(t_ - w2_, 0), hi_ = min(t_ + w2_, L_); const float inv_ = 1.f / (float)(hi_ - lo_); \
                    f32x4 s0_ = {0.f, 0.f, 0.f, 0.f}, s1_ = s0_; \
                    _Pragma("unroll") for (int i = 0; i < 2 * w2_; ++i) { const int q_ = t_ - w2_ + i; const bool ok_ = q_ >= 0 && q_ < L_; const bf16_t* zr_ = zs_ + (size_t)(ok_ ? q_ : t_) * D; \
                        const u32x2 wa_ = LDB4(zr_, 2 * g), wb_ = LDB4(zr_, 2 * g + 1); const float m_ = ok_ ? 1.f : 0.f; s0_ += UNPK(wa_) * m_; s1_ += UNPK(wb_) * m_; } \
                    const bf16_t* zc_ = zs_ + (size_t)t_ * D; const u32x2 ca_ = LDB4(zc_, 2 * g), cb_ = LDB4(zc_, 2 * g + 1); y[2 * g] = s0_ * inv_ - UNPK(ca_); y[2 * g + 1] = s1_ * inv_ - UNPK(cb_); } } \
            else if ((r) >= TL && nparts > 0) { _Pragma("unroll") for (int j = 0; j < 8; ++j) y[j] = (f32x4){0.f, 0.f, 0.f, 0.f}; \
                for (int p = 0; p < nparts; ++p) { const float* yp_ = a.Yp + ((size_t)p * TC + ((r) - TL)) * D; _Pragma("unroll") for (int j = 0; j < 8; ++j) y[j] += LDF4(yp_, j); } } \
            else { _Pragma("unroll") for (int j = 0; j < 8; ++j) y[j] = UNPK(yw[j]); } \
            _Pragma("unroll") for (int j = 0; j < 8; ++j) sy += (y[j][0] * y[j][0] + y[j][1] * y[j][1]) + (y[j][2] * y[j][2] + y[j][3] * y[j][3]); \
            const float rs_ = __builtin_amdgcn_rsqf(wave_sum(sy) * (1.f / D) + RMS_EPS); \
            _Pragma("unroll") for (int j = 0; j < 8; ++j) h[j] += tb_[64 * j] * (y[j] * rs_); } \
        if (HOUT_F32) { float* op_ = a.fout + (size_t)(r) * D; _Pragma("unroll") for (int j = 0; j < 8; ++j) __builtin_nontemporal_store(h[j], (GAS f32x4*)((gp)op_ + l16 + 1024u * j)); } \
        else if (a.hout) { bf16_t* op_ = a.hout + (size_t)(r) * D; _Pragma("unroll") for (int j = 0; j < 8; ++j) { u32x2 w; w.x = cvt_pk_bf16(h[j][0], h[j][1]); w.y = cvt_pk_bf16(h[j][2], h[j][3]); *(GAS u32x2*)((gp)op_ + l8 + 512u * j) = w; } } \
        if (WRITE_U) { float ss = 0.f; \
            _Pragma("unroll") for (int j = 0; j < 8; ++j) ss += (h[j][0] * h[j][0] + h[j][1] * h[j][1]) + (h[j][2] * h[j][2] + h[j][3] * h[j][3]); \
            const float rstd_ = __builtin_amdgcn_rsqf(wave_sum(ss) * (1.f / D) + RMS_EPS); bf16_t* ur_ = a.U + (size_t)(r) * D; \
            _Pragma("unroll") for (int j = 0; j < 8; ++j) { const f32x4 u = (h[j] * rstd_) * tb_[D / 4 + 64 * j] + tb_[2 * (D / 4) + 64 * j]; u32x2 w; w.x = cvt_pk_bf16(u[0], u[1]); w.y = cvt_pk_bf16(u[2], u[3]); \
                *(GAS u32x2*)((gp)ur_ + l8 + 512u * j) = w; } } } while (0)
    f32x4 hfA[8], hfB[8], hfC[8]; u32x2 hwA[8], hwB[8], hwC[8], ywA[8], ywB[8], ywC[8];
    int r = POOLY ? gw : (gw % NWAVES) * (ngw / NWAVES) + gw / NWAVES;
    if (r < nrows) RN_LOAD(hfA, hwA, ywA, r);
    if (r + ngw < nrows) RN_LOAD(hfB, hwB, ywB, r + ngw);
    while (r < nrows) {
        if (r + 2 * ngw < nrows) RN_LOAD(hfC, hwC, ywC, r + 2 * ngw);
        RN_PROC(hfA, hwA, ywA, r);
        r += ngw; if (r >= nrows) break;
        if (r + 2 * ngw < nrows) RN_LOAD(hfA, hwA, ywA, r + 2 * ngw);
        RN_PROC(hfB, hwB, ywB, r);
        r += ngw; if (r >= nrows) break;
        if (r + 2 * ngw < nrows) RN_LOAD(hfB, hwB, ywB, r + 2 * ngw);
        RN_PROC(hfC, hwC, ywC, r);
        r += ngw;
    }
#undef LDF4
#undef LDB4
#undef UNPK
#undef RN_LOAD
#undef RN_PROC
    __syncthreads();
}

__device__ __forceinline__ void krope_phase(const bf16_t* __restrict__ CQKV, bf16_t* __restrict__ KR, const float* __restrict__ tab, int gtid, int ngt) {
    asm volatile("" : "+v"(gtid));
    for (int i = gtid; i < T * 32; i += ngt) { const int r = i >> 5, ax = (i >> 4) & 1, f = i & 15;
        const bf16_t* src = CQKV + (size_t)r * NDQKV + 1024 + ax * 32 + f; const float x1 = bf_lo((unsigned)src[0]), x2 = bf_lo((unsigned)src[16]); float o1 = x1, o2 = x2;
        if (r < TL) { const int t = r & (SEQ - 1), pos = ax ? (t & 63) : (t >> 6); const float c = tab[(pos * 16 + f) * 2], s = tab[(pos * 16 + f) * 2 + 1]; o1 = x1 * c - x2 * s; o2 = x2 * c + x1 * s; }
        bf16_t* dst = KR + (size_t)r * ROPED + ax * 32 + f; dst[0] = (bf16_t)(cvt_pk_bf16(o1, 0.f) & 0xffffu); dst[16] = (bf16_t)(cvt_pk_bf16(o2, 0.f) & 0xffffu); }
}

#ifndef EN_P0
#define EN_P0 1
#endif
#ifndef EN_P1
#define EN_P1 1
#endif
#ifndef EN_S0
#define EN_S0 1
#endif
#ifndef EN_S1
#define EN_S1 1
#endif
#ifndef EN_S2
#define EN_S2 1
#endif
#ifndef EN_S3
#define EN_S3 1
#endif
#ifndef EN_S4
#define EN_S4 1
#endif
#ifndef EN_S5
#define EN_S5 1
#endif
#ifndef EN_S6
#define EN_S6 1
#endif
#ifndef EN_S7
#define EN_S7 1
#endif
struct Args { const float* in[18]; float* out; unsigned char* ws; int ph_lo, ph_hi; };
constexpr int N_PHASES = 34;
constexpr int SPLIT_POOL = 2, SPLIT_WO = 8, SPLIT_FFN2 = 11;

__global__ void __launch_bounds__(NTHREADS, 2) mk_fwd(Args args) {
    extern __shared__ __attribute__((aligned(16))) unsigned char lds_raw[];
    LAS unsigned char* lds = (LAS unsigned char*)lds_raw;
    volatile LAS unsigned* MISC = (volatile LAS unsigned*)(lds + MISC_OFF);
    const int G0 = gridDim.x, bid0 = blockIdx.x;
    unsigned char* ws = args.ws;
    for (int u = threadIdx.x; u < (LDS_BYTES - MISC_OFF) / 4; u += NTHREADS) ((LAS unsigned*)(lds + MISC_OFF))[u] = 0u;
    __syncthreads();
#if MK_PER_PHASE
    const int lo = args.ph_lo, hi = args.ph_hi;
#else
    constexpr int lo = 0, hi = N_PHASES;
#endif
    const bool use_bar = (hi - lo) > 1;
    XcdBarrier bar; bar.bar = (unsigned*)(ws + WS_CTL) + CW_BAR; bar.x = 0; bar.st = MISC + 8;
    if (use_bar) bar = xcd_barrier_post((unsigned*)(ws + WS_CTL) + CW_BAR, MISC + 8);
#define IN(k) (lo <= (k) && (k) < hi)
#define PHASE_END(k) do { if (hi > (k) + 1) xcd_barrier(bar); } while (0)
#define SITE() int tid = threadIdx.x, G = G0, bid = bid0; asm volatile("" : "+v"(tid), "+s"(G), "+s"(bid)); const int lane = tid & 63, wave = __builtin_amdgcn_readfirstlane(tid >> 6), gw = bid * NWAVES + wave, gtid = bid * NTHREADS + tid, ngw = G * NWAVES, ngt = G * NTHREADS; \
               (void)lane; (void)gw; (void)gtid; (void)ngw; (void)ngt; const __attribute__((address_space(4))) char* kp_ = (const __attribute__((address_space(4))) char*)__builtin_amdgcn_kernarg_segment_ptr(); asm volatile("" : "+s"(kp_)); \
               unsigned char* wsl = *(unsigned char* const __attribute__((address_space(4)))*)(kp_ + 19 * 8); asm volatile("" : "+s"(wsl))
#define KIN(k) (*(const float* const __attribute__((address_space(4)))*)(kp_ + (k) * 8))
#define KOUT() (*(float* const __attribute__((address_space(4)))*)(kp_ + 18 * 8))
#define WP(type, off) ((type*)(wsl + (off)))
#define MKIN() In I; I.x = KIN(0); I.c = KIN(1); I.ctx = KIN(2); I.c_ctx = KIN(3); I.ada_w = KIN(4); I.ada_b = KIN(5); I.norm_g = KIN(6); I.pool_w = KIN(7); \
               I.pool_scale = KIN(8); I.w_dqkv = KIN(9); I.q_norm = KIN(10); I.w_uq = KIN(11); I.kv_norm = KIN(12); I.w_ukv = KIN(13); I.w_o = KIN(14); I.w1 = KIN(15); I.w3 = KIN(16); I.w2 = KIN(17)
#define FILL_TAIL(gl, seg_lo, seg_hi) do { const int nshort_ = S.nwg % G; if (bid >= nshort_) { __syncthreads(); MKIN();   \
               filler(I, wsl, (gl), (seg_lo), (seg_hi) - (seg_lo), (bid - nshort_) * NWAVES + wave, (G - nshort_) * NWAVES, (LAS float*)(lds + wave * 16384), lane); } } while (0)

    if (EN_P0 && IN(0)) { SITE();
        MKIN();
        prologue(I, wsl, lds, gw, ngw, wave, lane, gtid, ngt); PHASE_END(0); }
    if (EN_P1 && IN(1)) { SITE();
        RN a; a.xin_lat = KIN(0); a.xin_ctx = KIN(2); a.hin = nullptr; a.Y = nullptr; a.Yp = nullptr; a.nparts = 0; a.gate = nullptr; a.gY = nullptr; a.hout = nullptr; a.fout = nullptr;
        a.gN = KIN(6); a.shift = nullptr; a.scale = nullptr; a.U = WP(bf16_t, WS_U); a.nrows = T; a.modp = WP(const float, WS_G); a.bias = KIN(5); a.mod_out = WP(float, WS_MOD);
        resid_norm<false, true, true, false, true>(a, lds, gw, ngw, tid); PHASE_END(1); }

    for (int L = 0; L < 4; ++L) {
        const int base = 2 + 8 * L, j = L >> 1; const bool pool = (L & 1) == 0;
        const int Mrows = (L == 3) ? TL : T;
        if (EN_S0 && !pool && IN(base + 0)) { SITE(); float* SSQ = WP(float, WS_SSQ);
            pg8::Gemm g{WP(const bf16_t, WS_U), WP(const bf16_t, WS_WDQKV) + (size_t)j * NDQKV * D, T, NDQKV, D, D, D}; pg8::StaticOrder S; S.init(T, NDQKV, D, G, bid);
            pg8::EpiStore E{WP(bf16_t, WS_CQKV), NDQKV, SSQ, SSQ + (size_t)8 * T, 2, 4, 0, 0};
            pg8::gemm_phase<pg8::EpiStore, pg8::StaticOrder>(lds, g, S, E);
            { const int lo_ = L == 1 ? SEG2 : SEG5, hi_ = L == 1 ? SEG3 : SEG6; FILL_TAIL(GEMV_DEFER && L == 1 ? 2 : 0, lo_, hi_); }
            PHASE_END(base + 0); }
        if (EN_S1 && !pool && IN(base + 1)) { SITE(); float* SSQ = WP(float, WS_SSQ);
            krope_phase(WP(const bf16_t, WS_CQKV), WP(bf16_t, WS_KR), WP(const float, WS_ROPE), gtid, ngt);
            pg8::Gemm g{WP(const bf16_t, WS_CQKV), WP(const bf16_t, WS_WUP) + (size_t)j * NUP * 512, T, NUP, 512, NDQKV, 512}; pg8::StaticOrder S; S.init(T, NUP, 512, G, bid);
            pg8::EpiUp E{WP(bf16_t, WS_Q), WP(bf16_t, WS_KV), SSQ, SSQ + (size_t)8 * T};
            pg8::gemm_phase<pg8::EpiUp, pg8::StaticOrder>(lds, g, S, E);
            PHASE_END(base + 1); }
        if (EN_S2 && !pool && IN(base + 2)) { SITE();
            const bf16_t* Qb = WP(const bf16_t, WS_Q); const bf16_t* KV = WP(const bf16_t, WS_KV); bf16_t* P = WP(bf16_t, WS_P);
            const int nlat = NB * NH * (SEQ / 256), nunits = nlat + (L == 1 ? NB * NH : 0);
            for (int u = bid; u < nunits; u += G) {
                att::Unit A;
                if (u < nlat) { const int pair = (u >> 8) * 8 + (u & 7), qb = (u & 255) >> 3, b = pair >> 4, h = pair & 15; const int row0 = b * SEQ + qb * 256;
                    A.Qb = Qb + (size_t)row0 * NQ + h * QKD; A.KVh = KV + h * 256; A.Ob = P + (size_t)row0 * D + h * VD; A.kb_lat = b * SEQ; A.nt_lat = SEQ / 64; A.kb_ctx = TL + b * CTXL; A.NT = SEQ / 64 + CTXL / 64; A.qpos0 = qb * 256; }
                else { const int v = u - nlat, b = v >> 4, h = v & 15; const int row0 = TL + b * CTXL;
                    A.Qb = Qb + (size_t)row0 * NQ + h * QKD; A.KVh = KV + h * 256; A.Ob = P + (size_t)row0 * D + h * VD; A.kb_lat = 0; A.nt_lat = 0; A.kb_ctx = row0; A.NT = CTXL / 64; A.qpos0 = -1; }
                att::attn_unit_auto(A, WP(const bf16_t, WS_KR), WP(const float, WS_ROPE), lds);
            }
            PHASE_END(base + 2); }
        if (EN_S3 && IN(base + 3)) { SITE();
            pg8::Gemm g; pg8::EpiY E{WP(bf16_t, WS_Y), WP(float, WS_YP), D, TL, TC, 0, 0}; pg8::HybridOrder S;
            if (pool) { g = pg8::Gemm{WP(const bf16_t, WS_U), WP(const bf16_t, WS_WPOOL) + (size_t)j * D * 512, Mrows, D, 512, D, 512}; E.a_grp_tiles = 2; E.a_grp_off = 512; S.init(Mrows, Mrows, D, 512, G, bid, 1); }
            else { g = pg8::Gemm{WP(const bf16_t, WS_P), WP(const bf16_t, WS_WO) + (size_t)j * D * D, Mrows, D, D, D, D}; S.init(TL, Mrows, D, D, G, bid, SPLIT_WO); }
            pg8::gemm_phase<pg8::EpiY, pg8::HybridOrder>(lds, g, S, E);
            PHASE_END(base + 3); }
        if (EN_S4 && IN(base + 4)) { SITE(); const float* modL = WP(const float, WS_MOD) + (size_t)L * 3 * NMOD; const float* gL = KIN(6) + (size_t)L * 4 * D;
            RN a; a.xin_lat = KIN(0); a.xin_ctx = KIN(2); a.hin = WP(const bf16_t, WS_H); a.Y = WP(const bf16_t, WS_Y); a.Yp = WP(const float, WS_YP); a.nparts = (!pool && Mrows > TL) ? SPLIT_WO : 0; a.gate = modL + 2 * D; a.gY = gL + D;
            a.hout = WP(bf16_t, WS_H); a.fout = nullptr; a.gN = gL + 2 * D; a.shift = modL + 3 * D; a.scale = modL + 4 * D; a.U = WP(bf16_t, WS_U); a.nrows = Mrows; a.modp = nullptr; a.bias = nullptr; a.mod_out = nullptr;
            if (L == 0) resid_norm<true, true, true, false, false, true>(a, lds, gw, ngw, tid); else if (pool) resid_norm<true, true, false, false, false, true>(a, lds, gw, ngw, tid); else resid_norm<true, true, false, false>(a, lds, gw, ngw, tid);
            PHASE_END(base + 4); }
        if (EN_S5 && IN(base + 5)) { SITE(); pg8::Gemm g{WP(const bf16_t, WS_U), WP(const bf16_t, WS_W13) + (size_t)L * 2 * DFF * D, Mrows, 2 * DFF, D, D, D}; pg8::StaticOrder S; S.init(Mrows, 2 * DFF, D, G, bid);
            pg8::EpiSwiGLU E{WP(bf16_t, WS_G), DFF};
            pg8::gemm_phase<pg8::EpiSwiGLU, pg8::StaticOrder>(lds, g, S, E);
            if (L < 3) { const int lo_ = L == 0 ? SEG1 : L == 1 ? SEG3 : SEG4, hi_ = L == 0 ? SEG2 : L == 1 ? SEG4 : SEG5; FILL_TAIL(GEMV_DEFER && L == 2 ? 3 : 0, lo_, hi_); }
            PHASE_END(base + 5); }
        if (EN_S6 && IN(base + 6)) { SITE();
            pg8::Gemm g{WP(const bf16_t, WS_G), WP(const bf16_t, WS_W2) + (size_t)L * D * DFF, Mrows, D, DFF, DFF, DFF}; pg8::HybridOrder S; S.init(TL, Mrows, D, DFF, G, bid, SPLIT_FFN2);
            pg8::EpiY E{WP(bf16_t, WS_Y), WP(float, WS_YP), D, TL, TC, 0, 0};
            pg8::gemm_phase<pg8::EpiY, pg8::HybridOrder>(lds, g, S, E);
            if (GEMV_DEFER && (L == 1 || L == 2)) { const float* mp2 = WP(const float, WS_MODP2) + (size_t)L * KSPL2 * 3 * NMOD; const float* bias = KIN(5) + (size_t)(L + 1) * NMOD; float* mo = WP(float, WS_MOD) + (size_t)(L + 1) * 3 * NMOD;
                for (int o = gtid; o < 3 * NMOD; o += ngt) { float acc = bias[o % NMOD];
#pragma unroll 16
                    for (int p = 0; p < KSPL2; ++p) acc += mp2[(size_t)p * 3 * NMOD + o];
                    mo[o] = acc; } }
            PHASE_END(base + 6); }
        if (EN_S7 && IN(base + 7)) { SITE(); const float* modL = WP(const float, WS_MOD) + (size_t)L * 3 * NMOD; const float* gL = KIN(6) + (size_t)L * 4 * D;
            RN a; a.xin_lat = nullptr; a.xin_ctx = nullptr; a.hin = WP(const bf16_t, WS_H); a.Y = WP(const bf16_t, WS_Y); a.Yp = WP(const float, WS_YP); a.nparts = L < 3 ? SPLIT_FFN2 : 0; a.gate = modL + 5 * D; a.gY = gL + 3 * D; a.modp = nullptr; a.bias = nullptr; a.mod_out = nullptr;
            if (L < 3) { a.hout = WP(bf16_t, WS_H); a.fout = nullptr; a.gN = gL + 4 * D; a.shift = modL + 3 * NMOD; a.scale = modL + 3 * NMOD + D; a.U = WP(bf16_t, WS_U); a.nrows = T;
                resid_norm<true, true, false, false>(a, lds, gw, ngw, tid); }
            else { a.hout = nullptr; a.fout = KOUT(); a.gN = nullptr; a.shift = nullptr; a.scale = nullptr; a.U = nullptr; a.nrows = TL;
                resid_norm<true, false, false, true>(a, lds, gw, ngw, tid); }
            PHASE_END(base + 7); }
    }
#undef IN
#undef PHASE_END
}

extern "C" void kernel_launch(void* const* d_in, const int* in_sizes, int n_in, void* d_out, int out_size, void* d_ws, size_t ws_size, hipStream_t stream) {
    static int grid = 0;
    if (grid == 0) {
        if (n_in != 18 || in_sizes[0] != TL * D || out_size != TL * D || ws_size < WS_END) { fprintf(stderr, "kernel_launch: unexpected shapes (n_in %d, in0 %d, out %d, ws %zu); nothing launched\n", n_in, n_in > 0 ? in_sizes[0] : -1, out_size, ws_size); grid = -1; return; }
        int dev = 0, cus = 0, per_cu = 0;
        if (hipGetDevice(&dev) != hipSuccess || hipDeviceGetAttribute(&cus, hipDeviceAttributeMultiprocessorCount, dev) != hipSuccess) { grid = -1; return; }
        if (hipFuncSetAttribute((const void*)mk_fwd, hipFuncAttributeMaxDynamicSharedMemorySize, LDS_BYTES) != hipSuccess) { fprintf(stderr, "kernel_launch: hipFuncSetAttribute failed\n"); grid = -1; return; }
        if (hipOccupancyMaxActiveBlocksPerMultiprocessor(&per_cu, (const void*)mk_fwd, NTHREADS, LDS_BYTES) != hipSuccess || per_cu < 1) { fprintf(stderr, "kernel_launch: occupancy query says %d blocks per CU\n", per_cu); }
        (void)hipGetLastError();
        grid = cus;
    }
    if (grid < 0) return;
    if (hipMemsetAsync((char*)d_ws + WS_CTL, 0, CTL_ZERO_BYTES, stream) != hipSuccess) return;
    Args a{};
    for (int i = 0; i < 18; ++i) a.in[i] = (const float*)d_in[i];
    a.out = (float*)d_out; a.ws = (unsigned char*)d_ws;
#if MK_PER_PHASE
    for (int p = 0; p < N_PHASES; ++p) { const int k = p - 2, L = k >> 3, s = k & 7; if (p >= 2 && (L & 1) == 0 && s <= 2) continue;
        a.ph_lo = p; a.ph_hi = p + 1; hipLaunchKernelGGL(mk_fwd, dim3(grid), dim3(NTHREADS), LDS_BYTES, stream, a); }
#else
    a.ph_lo = 0; a.ph_hi = N_PHASES; hipLaunchKernelGGL(mk_fwd, dim3(grid), dim3(NTHREADS), LDS_BYTES, stream, a);
#endif
    const hipError_t le = hipPeekAtLastError();
    if (le != hipSuccess) fprintf(stderr, "kernel_launch: launch failed: %s\n", hipGetErrorName(le));
}
```
